# Optimizing an MI355X kernel written in HIP

```python
import math
import jax, jax.numpy as jnp
from jax import lax
import numpy as np

D_MODEL = 1024
BATCH = 4
SEQ = 4096
DEPTH = 2

N_MIXERS = 4
HEAD_DIM = 64
GROUP_WIDTH = D_MODEL // N_MIXERS
GROUP_HEADS = GROUP_WIDTH // HEAD_DIM
EPS = 1e-6
ATTN_PATTERNS = ((128, 1), (512, 4), (2048, 16))
ROPE_THETA = 10000.0
SSM_STATE = 128
SSM_GROUPS = 2
SSM_CONV = 4
SSM_CHUNK = 128
SSM_XBC = GROUP_WIDTH + 2 * SSM_GROUPS * SSM_STATE
RET_CHUNK = 128
CONF_KERNEL = 31
D_FF = 4 * D_MODEL
PLE_DIM = 256
A_COLS = 3 * GROUP_WIDTH
B_COLS = GROUP_WIDTH + SSM_XBC + GROUP_HEADS
C_COLS = 4 * GROUP_WIDTH
D_COLS = 2 * GROUP_WIDTH
IN_COLS = A_COLS + B_COLS + C_COLS + D_COLS

kernel_name = 'hybrid_parallel_heads_dilated_ssd_retention_conformer'


def _rmsnorm(x, g):
    xf = x.astype(jnp.float32)
    y = xf * lax.rsqrt(jnp.mean(xf * xf, axis=-1, keepdims=True) + EPS) * g.astype(jnp.float32)
    return y.astype(x.dtype)


def _rms_f32(x, g=None):
    y = x * lax.rsqrt(jnp.mean(x * x, axis=-1, keepdims=True) + EPS)
    return y if g is None else y * g.astype(jnp.float32)


def _layernorm_f32(x, g, b):
    mu = jnp.mean(x, axis=-1, keepdims=True)
    xc = x - mu
    var = jnp.mean(xc * xc, axis=-1, keepdims=True)
    return xc * lax.rsqrt(var + EPS) * g.astype(jnp.float32) + b.astype(jnp.float32)


def _rotary(x, angles):
    seq = x.shape[1]
    half = x.shape[-1] // 2
    pos = jnp.arange(seq, dtype=jnp.float32)
    ang = pos[:, None] * angles[None, :]
    cos = jnp.cos(ang)[None, :, None, :]
    sin = jnp.sin(ang)[None, :, None, :]
    x1, x2 = x[..., :half], x[..., half:]
    return jnp.concatenate([x1 * cos - x2 * sin, x2 * cos + x1 * sin], axis=-1)


def _causal_dwconv(x, w, b):
    k = w.shape[0]
    y = lax.conv_general_dilated(
        x, w[:, None, :].astype(x.dtype), window_strides=(1,), padding=((k - 1, 0),),
        dimension_numbers=('NWC', 'WIO', 'NWC'), feature_group_count=x.shape[-1])
    return y + b.astype(y.dtype)


def _dilated_pattern(q, k, v, window, dil):
    bsz, seq, h, d = q.shape
    blk = window // dil
    length = seq // dil
    nb = -(-length // blk)
    lp = nb * blk

    def to_blocks(t):
        t = t.reshape(bsz, length, dil, h, d).transpose(0, 2, 1, 3, 4)
        t = jnp.pad(t, ((0, 0), (0, 0), (0, lp - length), (0, 0), (0, 0)))
        return t.reshape(bsz, dil, nb, blk, h, d)

    def with_prev(t):
        prev = jnp.pad(t, ((0, 0), (0, 0), (1, 0), (0, 0), (0, 0), (0, 0)))[:, :, :-1]
        return jnp.concatenate([prev, t], axis=3)

    qb = to_blocks(q)
    kw = with_prev(to_blocks(k))
    vw = with_prev(to_blocks(v))
    s = jnp.einsum('brnqhd,brnkhd->brnhqk', qb, kw)
    qi = jnp.arange(blk)[:, None]
    ki = jnp.arange(2 * blk)[None, :]
    band = (ki >= qi) & (ki <= qi + blk)
    has_prev = (jnp.arange(nb)[:, None, None] > 0) | (ki[None] >= blk)
    mask = band[None] & has_prev
    s = jnp.where(mask[:, None], s, -jnp.inf)
    m = jnp.max(s, axis=-1, keepdims=True)
    e = jnp.exp(s - m)
    den = jnp.sum(e, axis=-1, keepdims=True)
    o = jnp.einsum('brnhqk,brnkhd->brnqhd', e, vw)
    o = o / jnp.swapaxes(den, 3, 4)
    lse = jnp.swapaxes((m + jnp.log(den))[..., 0], 3, 4)

    def from_blocks(t):
        t = t.reshape((bsz, dil, lp) + t.shape[4:])[:, :, :length]
        t = jnp.swapaxes(t, 1, 2)
        return t.reshape((bsz, seq) + t.shape[3:])

    return from_blocks(o), from_blocks(lse)


def _attention_mixer(qkv, q_gain, k_gain):
    bsz, seq, _ = qkv.shape
    q, k, v = jnp.split(qkv.astype(jnp.float32), 3, axis=-1)
    q = q.reshape(bsz, seq, GROUP_HEADS, HEAD_DIM)
    k = k.reshape(bsz, seq, GROUP_HEADS, HEAD_DIM)
    v = v.reshape(bsz, seq, GROUP_HEADS, HEAD_DIM)
    angles = ROPE_THETA ** (-jnp.arange(0, HEAD_DIM, 2, dtype=jnp.float32) / HEAD_DIM)
    q = _rotary(_rms_f32(q, q_gain), angles) * (HEAD_DIM ** -0.5)
    k = _rotary(_rms_f32(k, k_gain), angles)
    outs, lses = [], []
    for window, dil in ATTN_PATTERNS:
        o, lse = _dilated_pattern(q, k, v, window, dil)
        outs.append(o)
        lses.append(lse)
    w = jax.nn.softmax(jnp.stack(lses, axis=0), axis=0)
    o = jnp.sum(w[..., None] * jnp.stack(outs, axis=0), axis=0)
    return o.reshape(bsz, seq, GROUP_WIDTH)


def _ssd_scan(x, dt, a, bm, cm):
    bsz, seq, h, pdim = x.shape
    n = bm.shape[-1]
    q = SSM_CHUNK
    nc = seq // q
    xc = x.reshape(bsz, nc, q, h, pdim)
    dtc = dt.reshape(bsz, nc, q, h)
    bc = bm.reshape(bsz, nc, q, h, n)
    cc = cm.reshape(bsz, nc, q, h, n)
    a_cum = jnp.cumsum(dtc * a, axis=2)
    causal = jnp.tril(jnp.ones((q, q), dtype=bool))
    diff = a_cum[:, :, :, None, :] - a_cum[:, :, None, :, :]
    lmat = jnp.exp(jnp.where(causal[None, None, :, :, None], diff, -jnp.inf))
    cb = jnp.einsum('bcihn,bcjhn->bcijh', cc, bc)
    y_diag = jnp.einsum('bcijh,bcjh,bcjhp->bcihp', cb * lmat, dtc, xc)
    decay_states = jnp.exp(a_cum[:, :, -1:, :] - a_cum)
    states = jnp.einsum('bcjhn,bcjh,bcjhp->bchpn', bc, decay_states * dtc, xc)
    chunk_decay = jnp.exp(a_cum[:, :, -1, :])

    def step(hs, inp):
        st, dec = inp
        return dec[:, :, None, None] * hs + st, hs

    h0 = jnp.zeros((bsz, h, pdim, n), dtype=jnp.float32)
    _, prev = lax.scan(step, h0, (jnp.moveaxis(states, 1, 0), jnp.moveaxis(chunk_decay, 1, 0)))
    prev = jnp.moveaxis(prev, 0, 1)
    y_off = jnp.einsum('bcihn,bchpn,bcih->bcihp', cc, prev, jnp.exp(a_cum))
    return (y_diag + y_off).reshape(bsz, seq, h, pdim)


def _ssd_mixer(u, conv_w, conv_b, dt_bias, a_log, d_skip, norm_g):
    bsz, seq, _ = u.shape
    z, xbc, dt = jnp.split(u, [GROUP_WIDTH, GROUP_WIDTH + SSM_XBC], axis=-1)
    xbc = jax.nn.silu(_causal_dwconv(xbc, conv_w, conv_b).astype(jnp.float32))
    xs, bm, cm = jnp.split(xbc, [GROUP_WIDTH, GROUP_WIDTH + SSM_GROUPS * SSM_STATE], axis=-1)
    xs = xs.reshape(bsz, seq, GROUP_HEADS, HEAD_DIM)
    rep = GROUP_HEADS // SSM_GROUPS
    bm = jnp.repeat(bm.reshape(bsz, seq, SSM_GROUPS, SSM_STATE), rep, axis=2)
    cm = jnp.repeat(cm.reshape(bsz, seq, SSM_GROUPS, SSM_STATE), rep, axis=2)
    dt = jax.nn.softplus(dt.astype(jnp.float32) + dt_bias.astype(jnp.float32))
    a = -jnp.exp(a_log.astype(jnp.float32))
    y = _ssd_scan(xs, dt, a, bm, cm) + d_skip.astype(jnp.float32)[:, None] * xs
    y = y.reshape(bsz, seq, GROUP_WIDTH) * jax.nn.silu(z.astype(jnp.float32))
    y = _rms_f32(y.reshape(bsz, seq, SSM_GROUPS, GROUP_WIDTH // SSM_GROUPS))
    return y.reshape(bsz, seq, GROUP_WIDTH) * norm_g.astype(jnp.float32)


def _retention_mixer(u):
    bsz, seq, _ = u.shape
    q, k, v, g = jnp.split(u.astype(jnp.float32), 4, axis=-1)
    q = q.reshape(bsz, seq, GROUP_HEADS, HEAD_DIM)
    k = k.reshape(bsz, seq, GROUP_HEADS, HEAD_DIM)
    v = v.reshape(bsz, seq, GROUP_HEADS, HEAD_DIM)
    angles = 1.0 / (10000.0 ** jnp.linspace(0.0, 1.0, HEAD_DIM // 2, dtype=jnp.float32))
    q = _rotary(q, angles)
    k = _rotary(k, angles) * (HEAD_DIM ** -0.5)
    log_g = jnp.log(1.0 - 2.0 ** (-5.0 - jnp.arange(GROUP_HEADS, dtype=jnp.float32)))
    cq = RET_CHUNK
    nc = seq // cq
    qc = q.reshape(bsz, nc, cq, GROUP_HEADS, HEAD_DIM)
    kc = k.reshape(bsz, nc, cq, GROUP_HEADS, HEAD_DIM)
    vc = v.reshape(bsz, nc, cq, GROUP_HEADS, HEAD_DIM)
    idx = jnp.arange(cq, dtype=jnp.float32)
    dist = idx[:, None] - idx[None, :]
    dmat = jnp.where((dist >= 0)[..., None], jnp.exp(jnp.maximum(dist, 0.0)[..., None] * log_g), 0.0)
    inner = jnp.einsum('bcihd,bcjhd->bcijh', qc, kc) * dmat
    y_in = jnp.einsum('bcijh,bcjhe->bcihe', inner, vc)
    zeta = jnp.exp((cq - 1 - idx)[:, None] * log_g)
    states = jnp.einsum('bcjhd,jh,bcjhe->bchde', kc, zeta, vc)
    g_chunk = jnp.exp(cq * log_g)

    def step(r, st):
        return g_chunk[:, None, None] * r + st, r

    r0 = jnp.zeros((bsz, GROUP_HEADS, HEAD_DIM, HEAD_DIM), dtype=jnp.float32)
    _, prev = lax.scan(step, r0, jnp.moveaxis(states, 1, 0))
    prev = jnp.moveaxis(prev, 0, 1)
    xi = jnp.exp((idx + 1.0)[:, None] * log_g)
    y_cross = jnp.einsum('bcihd,bchde,ih->bcihe', qc, prev, xi)
    y = _rms_f32((y_in + y_cross).reshape(bsz, seq, GROUP_HEADS, HEAD_DIM))
    return y.reshape(bsz, seq, GROUP_WIDTH) * jax.nn.silu(g)


def _conv_module(u, dw_w, dw_b, ln_g, ln_b):
    val, gate = jnp.split(u, 2, axis=-1)
    hglu = val * jax.nn.sigmoid(gate)
    hc = _causal_dwconv(hglu, dw_w, dw_b).astype(jnp.float32)
    return jax.nn.silu(_layernorm_f32(hc, ln_g, ln_b))


def setup_inputs(seed: int = 0) -> dict:
    key = jax.random.key(seed)
    ks = jax.random.split(key, 24)
    f32 = jnp.float32

    def nrm(k, shape, scale):
        return jax.random.normal(k, shape, f32) * scale

    def gain(k, shape):
        return 1.0 + 0.05 * jax.random.normal(k, shape, f32)

    dt = jnp.exp(jax.random.uniform(ks[8], (DEPTH, GROUP_HEADS), f32,
                                    math.log(0.001), math.log(0.1)))
    return {
        'x': nrm(ks[0], (BATCH, SEQ, D_MODEL), 1.0),
        'p': nrm(ks[1], (DEPTH, BATCH, SEQ, PLE_DIM), 1.0),
        'norm_mix': gain(ks[2], (DEPTH, D_MODEL)),
        'w_in': nrm(ks[3], (DEPTH, D_MODEL, IN_COLS), D_MODEL ** -0.5),
        'attn_q_norm': gain(ks[4], (DEPTH, HEAD_DIM)),
        'attn_k_norm': gain(ks[5], (DEPTH, HEAD_DIM)),
        'ssm_conv_w': nrm(ks[6], (DEPTH, SSM_CONV, SSM_XBC), SSM_CONV ** -0.5),
        'ssm_conv_b': nrm(ks[7], (DEPTH, SSM_XBC), 0.02),
        'ssm_dt_bias': dt + jnp.log(-jnp.expm1(-dt)),
        'ssm_a_log': jnp.log(jax.random.uniform(ks[9], (DEPTH, GROUP_HEADS), f32, 1.0, 16.0)),
        'ssm_d': gain(ks[10], (DEPTH, GROUP_HEADS)),
        'ssm_norm': gain(ks[11], (DEPTH, GROUP_WIDTH)),
        'conv_dw_w': nrm(ks[12], (DEPTH, CONF_KERNEL, GROUP_WIDTH), CONF_KERNEL ** -0.5),
        'conv_dw_b': nrm(ks[13], (DEPTH, GROUP_WIDTH), 0.02),
        'conv_ln_g': gain(ks[14], (DEPTH, GROUP_WIDTH)),
        'conv_ln_b': nrm(ks[15], (DEPTH, GROUP_WIDTH), 0.02),
        'w_out': nrm(ks[16], (DEPTH, D_MODEL, D_MODEL), D_MODEL ** -0.5),
        'norm_ffn': gain(ks[17], (DEPTH, D_MODEL)),
        'w_up': nrm(ks[18], (DEPTH, D_MODEL, D_FF), D_MODEL ** -0.5),
        'w_down': nrm(ks[19], (DEPTH, D_FF, D_MODEL), D_FF ** -0.5),
        'norm_ple': gain(ks[20], (DEPTH, D_MODEL)),
        'w_ple': nrm(ks[21], (DEPTH, PLE_DIM, D_MODEL), PLE_DIM ** -0.5),
        'w_ple_gate': nrm(ks[22], (DEPTH, D_MODEL, D_MODEL), D_MODEL ** -0.5),
    }


def reference(x, p, norm_mix, w_in, attn_q_norm, attn_k_norm, ssm_conv_w, ssm_conv_b,
              ssm_dt_bias, ssm_a_log, ssm_d, ssm_norm, conv_dw_w, conv_dw_b, conv_ln_g,
              conv_ln_b, w_out, norm_ffn, w_up, w_down, norm_ple, w_ple, w_ple_gate):
    for i in range(DEPTH):
        h = _rmsnorm(x, norm_mix[i])
        proj = jnp.einsum('bsd,dc->bsc', h, w_in[i])
        a_in, b_in, c_in, d_in = jnp.split(
            proj, [A_COLS, A_COLS + B_COLS, A_COLS + B_COLS + C_COLS], axis=-1)
        y_a = _attention_mixer(a_in, attn_q_norm[i], attn_k_norm[i])
        y_b = _ssd_mixer(b_in, ssm_conv_w[i], ssm_conv_b[i], ssm_dt_bias[i], ssm_a_log[i],
                         ssm_d[i], ssm_norm[i])
        y_c = _retention_mixer(c_in)
        y_d = _conv_module(d_in, conv_dw_w[i], conv_dw_b[i], conv_ln_g[i], conv_ln_b[i])
        y = jnp.concatenate([y_a, y_b, y_c, y_d], axis=-1).astype(x.dtype)
        x = x + jnp.einsum('bsc,cd->bsd', y, w_out[i])
        hf = _rmsnorm(x, norm_ffn[i])
        up = jax.nn.relu(jnp.einsum('bsd,df->bsf', hf, w_up[i]))
        x = x + jnp.einsum('bsf,fd->bsd', up * up, w_down[i])
        gate = jax.nn.sigmoid(jnp.einsum('bsd,de->bse', _rmsnorm(x, norm_ple[i]), w_ple_gate[i]))
        x = x + jnp.einsum('bsk,kd->bsd', p[i], w_ple[i]) * gate
    return x
```

```cpp
#include <hip/hip_runtime.h>
#include <cstdio>
#include <cstdint>
namespace pg8 {
#define PG8_LAS __attribute__((address_space(3)))
typedef unsigned short bf16_t;
typedef short bf16x8 __attribute__((ext_vector_type(8)));
typedef float f32x4 __attribute__((ext_vector_type(4)));
typedef unsigned u32x4 __attribute__((ext_vector_type(4)));
constexpr int BM = 256, BK = 64, HALF = 128, HTB = HALF * BK * 2  , STAGE_BYTES = 8 * HTB, NXCD = 8, WGM = 8;

__host__ __device__ __forceinline__ int lds_byte(int r, int c) { const int st = (r >> 4) * 2 + (c >> 5), rr = r & 15, cc = c & 31, ob = rr * 64 + cc * 2; return st * 1024 + (ob ^ (((ob >> 9) & 1) << 5)); }
__host__ __device__ __forceinline__ void stage_rc(int b, int& R, int& C) { const int st = b / 1024, sb = b % 1024, swz = sb ^ (((sb >> 9) & 1) << 5); R = (st >> 1) * 16 + swz / 64; C = (st & 1) * 32 + (swz % 64) / 2; }
__host__ __device__ __forceinline__ int perm32(int rho) { const int n = rho >> 4, i = rho & 15; return 8 * (i >> 2) + 4 * n + (i & 3); }

struct Unit { int pm, pn; };
struct Gemm { const bf16_t* A; const bf16_t* Bt; int M, N, K; };

struct StaticOrder {
    int nM, nN, nwg, G, c;
    __host__ __device__ void init(int M, int N, int G_, int c_) { nM = M / BM; nN = N / BM; nwg = nM * nN; G = G_; c = c_; }
    __host__ __device__ bool next(int i, Unit& u) const {
        const long L = (long)i * G + c; if (L >= nwg) return false;
        int wgid = (int)L; { const int q = nwg / NXCD, r = nwg % NXCD, xcd = wgid % NXCD, off = wgid / NXCD; wgid = (xcd < r ? xcd * (q + 1) : r * (q + 1) + (xcd - r) * q) + off; }
        const int nig = WGM * nN, gid = wgid / nig, fm = gid * WGM, gsz = (nM - fm) < WGM ? (nM - fm) : WGM;
        u.pm = fm + ((wgid % nig) % gsz); u.pn = (wgid % nig) / gsz; return true;
    }
    __device__ __forceinline__ void a_ready(const Unit&) const {}
    __device__ __forceinline__ void done(const Unit&) const {}
};

__device__ __forceinline__ unsigned cvt_pk_bf16(float lo, float hi) { unsigned r; asm volatile("v_cvt_pk_bf16_f32 %0, %1, %2" : "=v"(r) : "v"(lo), "v"(hi)); return r; }

typedef unsigned u32x2 __attribute__((ext_vector_type(2)));
constexpr float RMS_EPS = 1e-6f;
template <int ACT> struct EpiScale {
    static constexpr bool PERM = true, AFTER_DRAIN = false;
    bf16_t* O; int ldc; const float* ss;
    __device__ __forceinline__ void operator()(const f32x4 (&acc)[2][2][4][2], const Unit& u, int wr, int wc, int fr, int fq) const {
        const int row0 = u.pm * BM + wr * 64 + fr; const int col0 = u.pn * BM + wc * 32 + 8 * fq;
#pragma unroll
        for (int ai = 0; ai < 2; ++ai)
#pragma unroll
            for (int m = 0; m < 4; ++m) { const int row = row0 + ai * HALF + m * 16; const float r = ss ? rsqrtf(ss[row] * (1.0f / 1024.0f) + RMS_EPS) : 1.0f;
                bf16_t* rowp = O + (size_t)row * ldc + col0;
#pragma unroll
                for (int bj = 0; bj < 2; ++bj) { f32x4 v0 = acc[ai][bj][m][0] * r, v1 = acc[ai][bj][m][1] * r;
                    if (ACT == 1) {
#pragma unroll
                        for (int e = 0; e < 4; ++e) { float a = fmaxf(v0[e], 0.f), b = fmaxf(v1[e], 0.f); v0[e] = a * a; v1[e] = b * b; } }
                    u32x4 w; w.x = cvt_pk_bf16(v0[0], v0[1]); w.y = cvt_pk_bf16(v0[2], v0[3]); w.z = cvt_pk_bf16(v1[0], v1[1]); w.w = cvt_pk_bf16(v1[2], v1[3]);
                    *(u32x4*)(rowp + bj * HALF) = w; }
                asm volatile("" ::: "memory"); }
    }
};
struct EpiPe {
    static constexpr bool PERM = false, AFTER_DRAIN = false;
    bf16_t* O; int ldc;
    __device__ __forceinline__ void operator()(const f32x4 (&acc)[2][2][4][2], const Unit& u, int wr, int wc, int fr, int fq) const {
        const int col0 = u.pn * BM + wc * 32 + 4 * fq;
#pragma unroll
        for (int ai = 0; ai < 2; ++ai)
#pragma unroll
            for (int m = 0; m < 4; ++m) { const size_t off = (size_t)(u.pm * BM + ai * HALF + wr * 64 + m * 16 + fr) * ldc + col0;
#pragma unroll
                for (int bj = 0; bj < 2; ++bj)
#pragma unroll
                    for (int n = 0; n < 2; ++n) { const f32x4 v = acc[ai][bj][m][n]; u32x2 w; w.x = cvt_pk_bf16(v[0], v[1]); w.y = cvt_pk_bf16(v[2], v[3]);
                        *(u32x2*)(O + off + bj * HALF + n * 16) = w; } }
    }
};
template <int GATE> struct EpiRes {
    static constexpr bool PERM = false, AFTER_DRAIN = false;
    const float* base; float* out; bf16_t* xb; float* ssout; int ldc; const bf16_t* pe; const float* ss;
    __device__ __forceinline__ void operator()(const f32x4 (&acc)[2][2][4][2], const Unit& u, int wr, int wc, int fr, int fq) const {
        const int col0 = u.pn * BM + wc * 32 + 4 * fq;
#pragma unroll
        for (int ai = 0; ai < 2; ++ai)
#pragma unroll
            for (int m = 0; m < 4; ++m) { const int row = u.pm * BM + ai * HALF + wr * 64 + m * 16 + fr; const size_t off = (size_t)row * ldc + col0; float s = 0.f;
                float r = 1.f; if (GATE) r = rsqrtf(ss[row] * (1.0f / 1024.0f) + RMS_EPS);
#pragma unroll
                for (int bj = 0; bj < 2; ++bj)
#pragma unroll
                    for (int n = 0; n < 2; ++n) { const size_t o2 = off + bj * HALF + n * 16; const f32x4 bs = *(const f32x4*)(base + o2); f32x4 a = acc[ai][bj][m][n];
                        if (GATE) { const u32x2 pw = *(const u32x2*)(pe + o2);
                            const float p0 = __uint_as_float(pw.x << 16), p1 = __uint_as_float(pw.x & 0xffff0000u), p2 = __uint_as_float(pw.y << 16), p3 = __uint_as_float(pw.y & 0xffff0000u);
                            a[0] = p0 / (1.f + __expf(-a[0] * r)); a[1] = p1 / (1.f + __expf(-a[1] * r)); a[2] = p2 / (1.f + __expf(-a[2] * r)); a[3] = p3 / (1.f + __expf(-a[3] * r)); }
                        const f32x4 o = bs + a; *(f32x4*)(out + o2) = o;
                        u32x2 w; w.x = cvt_pk_bf16(o[0], o[1]); w.y = cvt_pk_bf16(o[2], o[3]); *(u32x2*)(xb + o2) = w;
                        s += (o[0] * o[0] + o[1] * o[1]) + (o[2] * o[2] + o[3] * o[3]); }
                s += __shfl_xor(s, 16); s += __shfl_xor(s, 32);
                if (fq == 0) atomicAdd(ssout + row, s);
                asm volatile("" ::: "memory"); }
    }
};
template <class Epi, class Sched, bool ALIGN_EPI = false, bool SP2 = false>
__device__ __forceinline__ void gemm_phase(PG8_LAS unsigned char* lds, const Gemm g, const Sched& S, const Epi& E, int tid_) {
    const int tid = tid_, wid = __builtin_amdgcn_readfirstlane(tid >> 6), lane = tid & 63, wr = wid >> 2, wc = wid & 3, fr = lane & 15, fq = lane >> 4;
    const int K = g.K, nt = K / BK;
    unsigned voffA[2], voffB[2];
#pragma unroll
    for (int i = 0; i < 2; ++i) { int R, C; stage_rc(tid * 16 + i * 8192, R, C); const int Rb = Epi::PERM ? ((R & ~31) + perm32(R & 31)) : R;
        voffA[i] = (unsigned)(R * K + C) * 2u; voffB[i] = (unsigned)(Rb * K + C) * 2u; }
    const size_t kstep = (size_t)(BK * 2);
    const size_t hstep = (size_t)HALF * K * 2;
    const size_t tstep = 2 * hstep;
    const unsigned ldsw = (unsigned)wid * 1024u;
    const int aoff = lds_byte(wr * 64 + fr, fq * 8), boff = lds_byte(wc * 32 + fr, fq * 8);
#define PG8_SA(b, h) (((b) * 2 + (h)) * HTB)
#define PG8_SB(b, h) ((4 + (b) * 2 + (h)) * HTB)
#define PG8_STAGE(bufoff, gbase, voff) do { _Pragma("unroll") for (int _i = 0; _i < 2; ++_i) \
        __builtin_amdgcn_global_load_lds((const unsigned*)((const char*)(gbase) + (voff)[_i]), (PG8_LAS unsigned*)(lds + (bufoff) + ldsw + _i * 8192), 16, 0, 0); } while (0)
#define PG8_LDA(dst, b, h) do { _Pragma("unroll") for (int m = 0; m < 4; ++m) _Pragma("unroll") for (int k = 0; k < 2; ++k) dst[m][k] = *(const PG8_LAS bf16x8*)(lds + PG8_SA(b, h) + aoff + m * 2048 + k * 1024); } while (0)
#define PG8_LDB(dst, b, h) do { _Pragma("unroll") for (int n = 0; n < 2; ++n) _Pragma("unroll") for (int k = 0; k < 2; ++k) dst[n][k] = *(const PG8_LAS bf16x8*)(lds + PG8_SB(b, h) + boff + n * 2048 + k * 1024); } while (0)
#define PG8_MMA(ai, bj, At, Bt) do { __builtin_amdgcn_s_setprio(1); _Pragma("unroll") for (int m = 0; m < 4; ++m) _Pragma("unroll") for (int n = 0; n < 2; ++n) _Pragma("unroll") for (int k = 0; k < 2; ++k) \
        acc[ai][bj][m][n] = __builtin_amdgcn_mfma_f32_16x16x32_bf16(Bt[n][k], At[m][k], acc[ai][bj][m][n], 0, 0, 0); __builtin_amdgcn_s_setprio(0); } while (0)
#define PG8_WAIT_V(n) asm volatile("s_waitcnt vmcnt(" #n ")" ::: "memory")
#define PG8_WAIT_L(n) asm volatile("s_waitcnt lgkmcnt(" #n ")" ::: "memory")
#define PG8_BAR __builtin_amdgcn_s_barrier()
#define PG8_SCHED __builtin_amdgcn_sched_barrier(0)
    Unit cur, nxt; int ui = 0;
    if (!S.next(0, cur)) return;
    f32x4 acc[2][2][4][2];
#pragma unroll
    for (int a = 0; a < 2; ++a)
#pragma unroll
        for (int b = 0; b < 2; ++b)
#pragma unroll
            for (int m = 0; m < 4; ++m)
#pragma unroll
                for (int n = 0; n < 2; ++n) acc[a][b][m][n] = (f32x4){0.f, 0.f, 0.f, 0.f};
    bf16x8 At[4][2], B0[2][2], B1[2][2];
    const char* cA = (const char*)g.A + (size_t)cur.pm * tstep; const char* cB = (const char*)g.Bt + (size_t)cur.pn * tstep;
    S.a_ready(cur);
    if constexpr (SP2) {
        PG8_STAGE(PG8_SB(0, 0), cB, voffB); PG8_STAGE(PG8_SB(0, 1), cB + hstep, voffB); PG8_STAGE(PG8_SA(0, 0), cA, voffA); PG8_STAGE(PG8_SA(0, 1), cA + hstep, voffA);
        if (wr == 1) PG8_BAR;
        PG8_WAIT_V(2); PG8_BAR;
        PG8_STAGE(PG8_SB(1, 0), cB + kstep, voffB); PG8_STAGE(PG8_SA(1, 0), cA + kstep, voffA); PG8_STAGE(PG8_SB(1, 1), cB + hstep + kstep, voffB);
        PG8_WAIT_V(6); PG8_BAR;
    } else {
        PG8_STAGE(PG8_SB(0, 0), cB, voffB); PG8_STAGE(PG8_SA(0, 0), cA, voffA); PG8_STAGE(PG8_SB(0, 1), cB + hstep, voffB); PG8_STAGE(PG8_SA(0, 1), cA + hstep, voffA);
        if (wr == 1) PG8_BAR;
        PG8_WAIT_V(4); PG8_BAR;
        PG8_STAGE(PG8_SB(1, 0), cB + kstep, voffB); PG8_STAGE(PG8_SA(1, 0), cA + kstep, voffA); PG8_STAGE(PG8_SB(1, 1), cB + hstep + kstep, voffB);
        PG8_WAIT_V(6); PG8_BAR;
    }
    for (;;) {
        const bool has_next = S.next(ui + 1, nxt);
        const char* nA = has_next ? (const char*)g.A + (size_t)nxt.pm * tstep : cA; const char* nB = has_next ? (const char*)g.Bt + (size_t)nxt.pn * tstep : cB;
        for (int t = 0; t < nt; t += 2) {
            const bool last = (t == nt - 2);
            const char* a1 = cA + (size_t)(t + 1) * kstep;
            const char* a2 = last ? nA : cA + (size_t)(t + 2) * kstep; const char* b2 = last ? nB : cB + (size_t)(t + 2) * kstep;
            const char* a3 = a2 + kstep; const char* b3 = b2 + kstep;
            if (last && has_next) S.a_ready(nxt);
            if constexpr (SP2) {
            PG8_LDB(B0, 0, 0); PG8_LDB(B1, 0, 1); PG8_SCHED; PG8_LDA(At, 0, 0); PG8_STAGE(PG8_SA(1, 1), a1 + hstep, voffA);
            PG8_WAIT_V(8); PG8_WAIT_L(0); PG8_BAR; PG8_MMA(0, 0, At, B0); PG8_MMA(0, 1, At, B1); PG8_BAR; PG8_SCHED;
            PG8_LDA(At, 0, 1); PG8_STAGE(PG8_SB(0, 0), b2, voffB); PG8_STAGE(PG8_SB(0, 1), b2 + hstep, voffB); PG8_STAGE(PG8_SA(0, 0), a2, voffA);
            PG8_WAIT_V(8); PG8_WAIT_L(0); PG8_BAR; PG8_MMA(1, 0, At, B0); PG8_MMA(1, 1, At, B1); PG8_BAR; PG8_SCHED;
            PG8_LDB(B0, 1, 0); PG8_LDB(B1, 1, 1); PG8_SCHED; PG8_LDA(At, 1, 0); PG8_STAGE(PG8_SA(0, 1), a2 + hstep, voffA);
            PG8_WAIT_V(8); PG8_WAIT_L(0); PG8_BAR; PG8_MMA(0, 0, At, B0); PG8_MMA(0, 1, At, B1); PG8_BAR; PG8_SCHED;
            PG8_LDA(At, 1, 1); PG8_STAGE(PG8_SB(1, 0), b3, voffB); PG8_STAGE(PG8_SB(1, 1), b3 + hstep, voffB); PG8_STAGE(PG8_SA(1, 0), a3, voffA);
            PG8_WAIT_V(8); PG8_WAIT_L(0); PG8_BAR; PG8_MMA(1, 0, At, B0); PG8_MMA(1, 1, At, B1); PG8_BAR; PG8_SCHED;
            } else {
            PG8_LDB(B0, 0, 0); PG8_SCHED; PG8_LDA(At, 0, 0); PG8_STAGE(PG8_SA(1, 1), a1 + hstep, voffA);
            PG8_WAIT_L(8); PG8_BAR; PG8_WAIT_L(0); PG8_MMA(0, 0, At, B0); PG8_BAR; PG8_SCHED;
            PG8_LDB(B1, 0, 1); PG8_STAGE(PG8_SB(0, 0), b2, voffB);
            PG8_BAR; PG8_WAIT_L(0); PG8_MMA(0, 1, At, B1); PG8_BAR;
            PG8_LDA(At, 0, 1); PG8_STAGE(PG8_SA(0, 0), a2, voffA);
            PG8_BAR; PG8_WAIT_L(0); PG8_MMA(1, 0, At, B0); PG8_BAR; PG8_SCHED;
            PG8_STAGE(PG8_SB(0, 1), b2 + hstep, voffB);
            PG8_WAIT_V(6); PG8_BAR; PG8_MMA(1, 1, At, B1); PG8_BAR;
            PG8_LDB(B0, 1, 0); PG8_SCHED; PG8_LDA(At, 1, 0); PG8_STAGE(PG8_SA(0, 1), a2 + hstep, voffA);
            PG8_WAIT_L(8); PG8_BAR; PG8_WAIT_L(0); PG8_MMA(0, 0, At, B0); PG8_BAR; PG8_SCHED;
            PG8_LDB(B1, 1, 1); PG8_STAGE(PG8_SB(1, 0), b3, voffB);
            PG8_BAR; PG8_WAIT_L(0); PG8_MMA(0, 1, At, B1); PG8_BAR;
            PG8_LDA(At, 1, 1); PG8_STAGE(PG8_SA(1, 0), a3, voffA);
            PG8_BAR; PG8_WAIT_L(0); PG8_MMA(1, 0, At, B0); PG8_BAR; PG8_SCHED;
            PG8_STAGE(PG8_SB(1, 1), b3 + hstep, voffB);
            PG8_WAIT_V(6); PG8_BAR; PG8_MMA(1, 1, At, B1); PG8_BAR;
            }
        }
        if constexpr (ALIGN_EPI) { if (wr == 0) PG8_BAR; }
        if constexpr (!Epi::AFTER_DRAIN) { E(acc, cur, wr, wc, fr, fq); S.done(cur); }
        if (!has_next) break;
#pragma unroll
        for (int a = 0; a < 2; ++a)
#pragma unroll
            for (int b = 0; b < 2; ++b)
#pragma unroll
                for (int m = 0; m < 4; ++m)
#pragma unroll
                    for (int n = 0; n < 2; ++n) acc[a][b][m][n] = (f32x4){0.f, 0.f, 0.f, 0.f};
        cur = nxt; cA = nA; cB = nB; ++ui;
        if constexpr (ALIGN_EPI) { if (wr == 1) PG8_BAR; }
    }
    PG8_WAIT_V(0);
    if constexpr (!ALIGN_EPI) { if (wr == 0) PG8_BAR; }
    PG8_BAR;
    if constexpr (Epi::AFTER_DRAIN) { E.fused(acc, cur, wr, wc, fr, fq, lds, wid, lane); S.done(cur); }
#undef PG8_SA
#undef PG8_SB
#undef PG8_STAGE
#undef PG8_LDA
#undef PG8_LDB
#undef PG8_MMA
#undef PG8_WAIT_V
#undef PG8_WAIT_L
#undef PG8_BAR
#undef PG8_SCHED
}
}

#include <hip/hip_cooperative_groups.h>
namespace cg = cooperative_groups;
#define LAS __attribute__((address_space(3)))
#define DI __device__ __forceinline__
typedef unsigned short bf16_t;
typedef unsigned u32x4 __attribute__((ext_vector_type(4)));
typedef unsigned u32x2 __attribute__((ext_vector_type(2)));
typedef float f32x4 __attribute__((ext_vector_type(4)));

constexpr int SEQ = 4096, NB = 4, M = NB * SEQ, DM = 1024, FF = 4096, PLE = 256;
constexpr int PP = 3584;
constexpr int IN_ORIG = 3332;
constexpr int AQ = 0, AK = 256, AV = 512, BZ = 768, BX = 1024, BDT = 1792, CQ = 2048, CK = 2304, CV = 2560, CG = 2816, DV = 3072, DG = 3328;
constexpr float EPS = 1e-6f;
constexpr int NTHR = 512, NWV = 8;
constexpr int LDS_BYTES = 147456;
constexpr size_t MiB = 1u << 20;
constexpr size_t WS_SS = 0;
constexpr size_t WS_CDEC = 512 * 1024; constexpr size_t WS_BAR = 600 * 1024;
constexpr size_t WS_TAB = 1 * MiB;
constexpr size_t WS_PB0 = 3 * MiB;
constexpr size_t WS_WIN = 11 * MiB, WS_WOUT = 18 * MiB, WS_WUP = 20 * MiB, WS_WDOWN = 28 * MiB, WS_WPLE0 = 36 * MiB, WS_WGATE0 = 37 * MiB;
constexpr size_t WS_XB = 39 * MiB, WS_YCAT = 71 * MiB, WS_PROJ = 103 * MiB, WS_SST = 215 * MiB, WS_RST = 231 * MiB;
constexpr size_t WS_H = 103 * MiB, WS_PE = 103 * MiB;
constexpr size_t WS_WPLE1 = 239 * MiB, WS_WGATE1 = 240 * MiB, WS_PB1 = 242 * MiB, WS_END = 256 * MiB;

struct Params {
    const float* in[23]; float* out; unsigned char* ws;
};

DI float bf2f(bf16_t u) { return __uint_as_float((unsigned)u << 16); }
DI unsigned f2bf(float f) { unsigned u = __float_as_uint(f); return (u + 0x7fffu + ((u >> 16) & 1u)) >> 16; }
DI unsigned pk2(float lo, float hi) { return f2bf(lo) | (f2bf(hi) << 16); }
DI float lo16(unsigned w) { return __uint_as_float(w << 16); }
DI float hi16(unsigned w) { return __uint_as_float(w & 0xffff0000u); }
DI float wave_sum(float v) {
#pragma unroll
    for (int o = 1; o < 64; o <<= 1) v += __shfl_xor(v, o);
    return v;
}
DI float wave_max(float v) {
#pragma unroll
    for (int o = 1; o < 64; o <<= 1) v = fmaxf(v, __shfl_xor(v, o));
    return v;
}
DI float silu_f(float v) { return v / (1.f + __expf(-v)); }
DI float sigm_f(float v) { return 1.f / (1.f + __expf(-v)); }
DI void unpack8(const u32x4 w, float (&f)[8]) { f[0] = lo16(w.x); f[1] = hi16(w.x); f[2] = lo16(w.y); f[3] = hi16(w.y); f[4] = lo16(w.z); f[5] = hi16(w.z); f[6] = lo16(w.w); f[7] = hi16(w.w); }

DI void tr_item(const float* W, int K, int Norig, bf16_t* WT, const float* g, bool gap, LAS float* scr, int item, int nblk, int lane) {
    const int kb = item / nblk, nb = item % nblk, k0 = 64 * kb, n0 = 32 * nb;
    const int n = n0 + (lane & 31);
    int orig = n; if (gap) orig = (n < 1796) ? n : (n < 2048 ? -1 : n - 252);
#pragma unroll 8
    for (int i = 0; i < 32; ++i) { const int kk = 2 * i + (lane >> 5); float v = 0.f;
        if (orig >= 0) { v = W[(size_t)(k0 + kk) * Norig + orig]; if (g) v *= g[k0 + kk]; }
        scr[kk * 33 + (lane & 31)] = v; }
    asm volatile("s_waitcnt lgkmcnt(0)" ::: "memory");
    const int c = lane & 7;
#pragma unroll
    for (int j = 0; j < 4; ++j) { const int nn = (lane >> 3) + 8 * j; const LAS float* s = scr + (8 * c) * 33 + nn;
        u32x4 o; o.x = pk2(s[0 * 33], s[1 * 33]); o.y = pk2(s[2 * 33], s[3 * 33]); o.z = pk2(s[4 * 33], s[5 * 33]); o.w = pk2(s[6 * 33], s[7 * 33]);
        *(u32x4*)(WT + (size_t)(n0 + nn) * K + k0 + 8 * c) = o; }
    asm volatile("s_waitcnt lgkmcnt(0)" ::: "memory");
}
DI void convert_weights(const Params& p, int l, int which, LAS unsigned char* lds, int gw, int NGW, int lane, int wave) {
    LAS float* scr = (LAS float*)(lds + wave * 16384);
    unsigned char* ws = p.ws;
    if (which & 1) {
        constexpr int I_IN = 16 * 112, I_OUT = 16 * 32, I_UP = 16 * 128, I_DN = 64 * 32;
        for (int it = gw; it < I_IN + I_OUT + I_UP + I_DN; it += NGW) {
            int r = it;
            if (r < I_IN) { tr_item(p.in[3] + (size_t)l * DM * IN_ORIG, DM, IN_ORIG, (bf16_t*)(ws + WS_WIN), p.in[2] + l * DM, true, scr, r, 112, lane); continue; } r -= I_IN;
            if (r < I_OUT) { tr_item(p.in[16] + (size_t)l * DM * DM, DM, DM, (bf16_t*)(ws + WS_WOUT), nullptr, false, scr, r, 32, lane); continue; } r -= I_OUT;
            if (r < I_UP) { tr_item(p.in[18] + (size_t)l * DM * FF, DM, FF, (bf16_t*)(ws + WS_WUP), p.in[17] + l * DM, false, scr, r, 128, lane); continue; } r -= I_UP;
            tr_item(p.in[19] + (size_t)l * FF * DM, FF, DM, (bf16_t*)(ws + WS_WDOWN), nullptr, false, scr, r, 32, lane);
        }
    }
    if (which & 2) {
        constexpr int I_PLE = 4 * 32, I_GATE = 16 * 32;
        bf16_t* wple = (bf16_t*)(ws + (l ? WS_WPLE1 : WS_WPLE0)); bf16_t* wgate = (bf16_t*)(ws + (l ? WS_WGATE1 : WS_WGATE0));
        for (int it = gw; it < I_PLE + I_GATE; it += NGW) {
            int r = it;
            if (r < I_PLE) { tr_item(p.in[21] + (size_t)l * PLE * DM, PLE, DM, wple, nullptr, false, scr, r, 32, lane); continue; } r -= I_PLE;
            tr_item(p.in[22] + (size_t)l * DM * DM, DM, DM, wgate, p.in[20] + l * DM, false, scr, r, 32, lane);
        }
        const f32x4* src = (const f32x4*)(p.in[1] + (size_t)l * M * PLE); u32x2* dst = (u32x2*)(ws + (l ? WS_PB1 : WS_PB0));
        const int gt = gw * 64 + lane, NT = NGW * 64;
        for (int i = gt; i < M * PLE / 4; i += NT) { const f32x4 v = src[i]; u32x2 o; o.x = pk2(v[0], v[1]); o.y = pk2(v[2], v[3]); dst[i] = o; }
    }
}

DI void prologue(const Params& p, int gw, int NGW, int lane) {
    unsigned char* ws = p.ws;
    const int gt = gw * 64 + lane, NT = NGW * 64;
    float* ss = (float*)(ws + WS_SS);
    for (int i = gt; i < 6 * M; i += NT) ss[M + i] = 0.f;
    float* tab = (float*)(ws + WS_TAB);
    for (int idx = gt; idx < 2 * SEQ * 32; idx += NT) {
        const int t = idx / (SEQ * 32), e = idx % (SEQ * 32), pos = e >> 5, i = e & 31;
        const double base = t ? 0.7429639507594948 : 0.7498942093324559;
        double a = 1.0;
        for (int k = 0; k < 31; ++k) a = (k < i) ? a * base : a;
        const double ang = (double)pos * a;
        const double kk = rint(ang * 0.15915494309189535);
        const double r = ang - kk * 6.283185307179586477;
        const double r2 = r * r; double s = r, c = 1.0, ts = r, tc = 1.0;
        for (int n = 1; n <= 14; ++n) { tc *= -r2 / (double)((2 * n - 1) * (2 * n)); c += tc; ts *= -r2 / (double)((2 * n) * (2 * n + 1)); s += ts; }
        tab[(size_t)(2 * t) * SEQ * 32 + e] = (float)c; tab[(size_t)(2 * t + 1) * SEQ * 32 + e] = (float)s;
    }
    const float* x = p.in[0]; bf16_t* xb = (bf16_t*)(ws + WS_XB);
    for (int m = gw; m < M; m += NGW) {
        const f32x4* xr = (const f32x4*)(x + (size_t)m * DM) + lane; f32x4 v[4]; float s = 0.f;
#pragma unroll
        for (int j = 0; j < 4; ++j) { v[j] = xr[64 * j]; s += (v[j][0] * v[j][0] + v[j][1] * v[j][1]) + (v[j][2] * v[j][2] + v[j][3] * v[j][3]); }
        s = wave_sum(s);
        if (lane == 0) ss[m] = s;
        u32x2* o = (u32x2*)(xb + (size_t)m * DM) + lane;
#pragma unroll
        for (int j = 0; j < 4; ++j) { u32x2 w; w.x = pk2(v[j][0], v[j][1]); w.y = pk2(v[j][2], v[j][3]); o[64 * j] = w; }
    }
}

DI void e1_prepass(const Params& p, int l, int gw, int NGW, int lane) {
    bf16_t* proj = (bf16_t*)(p.ws + WS_PROJ); const float* tab = (const float*)(p.ws + WS_TAB);
    const int sub = lane >> 5, l5 = lane & 31, which = l5 >> 2, hq = which & 3, isk = which >> 2, i0 = (l5 & 3) * 8;
    const int col = (sub == 0 ? (isk ? AK : AQ) : (isk ? CK : CQ)) + hq * 64;
    const float* gain = (isk ? p.in[5] : p.in[4]) + l * 64;
    const float sc = ((sub == 0 && !isk) || (sub == 1 && isk)) ? 0.125f : 1.0f;
    const float* ct = tab + (size_t)(2 * sub) * SEQ * 32; const float* st = tab + (size_t)(2 * sub + 1) * SEQ * 32;
    for (int tok = gw; tok < M; tok += NGW) {
        const int pos = tok & (SEQ - 1);
        bf16_t* ptr = proj + (size_t)tok * PP + col;
        float x1[8], x2[8];
        unpack8(*(const u32x4*)(ptr + i0), x1); unpack8(*(const u32x4*)(ptr + 32 + i0), x2);
        float s2 = 0.f;
#pragma unroll
        for (int i = 0; i < 8; ++i) s2 += x1[i] * x1[i] + x2[i] * x2[i];
        s2 += __shfl_xor(s2, 1); s2 += __shfl_xor(s2, 2);
        if (sub == 0) { const float r = rsqrtf(s2 * (1.0f / 64.0f) + EPS);
#pragma unroll
            for (int i = 0; i < 8; ++i) { x1[i] *= r * gain[i0 + i]; x2[i] *= r * gain[32 + i0 + i]; } }
        float o1[8], o2[8];
#pragma unroll
        for (int i = 0; i < 8; ++i) { const float c = ct[pos * 32 + i0 + i], s = st[pos * 32 + i0 + i]; o1[i] = (x1[i] * c - x2[i] * s) * sc; o2[i] = (x2[i] * c + x1[i] * s) * sc; }
        u32x4 w1, w2; w1.x = pk2(o1[0], o1[1]); w1.y = pk2(o1[2], o1[3]); w1.z = pk2(o1[4], o1[5]); w1.w = pk2(o1[6], o1[7]);
        w2.x = pk2(o2[0], o2[1]); w2.y = pk2(o2[2], o2[3]); w2.z = pk2(o2[4], o2[5]); w2.w = pk2(o2[6], o2[7]);
        *(u32x4*)(ptr + i0) = w1; *(u32x4*)(ptr + 32 + i0) = w2;
        bf16_t* vp = proj + (size_t)tok * PP + DV + lane * 4; const bf16_t* gp = proj + (size_t)tok * PP + DG + lane * 4;
        const u32x2 vw = *(const u32x2*)vp, gwd = *(const u32x2*)gp;
        u32x2 o; o.x = pk2(lo16(vw.x) * sigm_f(lo16(gwd.x)), hi16(vw.x) * sigm_f(hi16(gwd.x))); o.y = pk2(lo16(vw.y) * sigm_f(lo16(gwd.y)), hi16(vw.y) * sigm_f(hi16(gwd.y)));
        *(u32x2*)vp = o;
    }
}

template <int NC, int K> DI void nt_acc(float (&acc)[NC], const LAS bf16_t* Ap, const LAS bf16_t* Bp, int ldb) {
    for (int k = 0; k < K; k += 8) {
        float a[8]; unpack8(*(const LAS u32x4*)(Ap + k), a);
#pragma unroll
        for (int c = 0; c < NC; ++c) { float b[8]; unpack8(*(const LAS u32x4*)(Bp + c * ldb + k), b);
            acc[c] += (a[0] * b[0] + a[1] * b[1]) + (a[2] * b[2] + a[3] * b[3]) + (a[4] * b[4] + a[5] * b[5]) + (a[6] * b[6] + a[7] * b[7]); }
    }
}
template <int NC> DI void axpy_row(float (&acc)[NC], float coef, const LAS bf16_t* Bp) {
#pragma unroll
    for (int c8 = 0; c8 < NC; c8 += 8) { float b[8]; unpack8(*(const LAS u32x4*)(Bp + c8), b);
#pragma unroll
        for (int e = 0; e < 8; ++e) acc[c8 + e] += coef * b[e]; }
}

DI void ssd_dt_acum(const Params& p, int l, int tok0, int g, LAS float* dts, LAS float* acs, int wave, int lane) {
    if (wave < 2) {
        const int h = 2 * g + wave; const bf16_t* proj = (const bf16_t*)(p.ws + WS_PROJ);
        const float bias = p.in[8][l * 4 + h], a = -__expf(p.in[9][l * 4 + h]);
        float d[2];
#pragma unroll
        for (int e = 0; e < 2; ++e) { const float raw = bf2f(proj[(size_t)(tok0 + 2 * lane + e) * PP + BDT + h]) + bias; d[e] = raw > 20.f ? raw : log1pf(__expf(raw)); }
        const float v0 = d[0] * a, v1 = d[1] * a; float s = v0 + v1;
#pragma unroll
        for (int off = 1; off < 64; off <<= 1) { const float t = __shfl_up(s, off); if (lane >= off) s += t; }
        dts[wave * 128 + 2 * lane] = d[0]; dts[wave * 128 + 2 * lane + 1] = d[1];
        acs[wave * 128 + 2 * lane] = s - v1; acs[wave * 128 + 2 * lane + 1] = s;
    }
}
DI void stage_conv(const Params& p, int l, LAS bf16_t* dst, int ld, int tok0, int seqpos0, int choff, int tid) {
    const bf16_t* src = (const bf16_t*)(p.ws + WS_PROJ) + (size_t)tok0 * PP + BX + choff;
    const float* cw = p.in[6] + (size_t)l * 4 * 768 + choff; const float* cb = p.in[7] + l * 768 + choff;
    for (int e = tid; e < 128 * 128; e += NTHR) { const int j = e >> 7, ch = e & 127;
        float v = cb[ch];
#pragma unroll
        for (int k = 0; k < 4; ++k) { const int s = j - 3 + k; if (seqpos0 + s >= 0) v += cw[k * 768 + ch] * bf2f(src[(long)s * PP + ch]); }
        dst[j * ld + ch] = (bf16_t)f2bf(silu_f(v)); }
}

DI void ssd_states_unit(const Params& p, int l, int b, int c, int g, LAS unsigned char* lds, int tid, int wave, int lane) {
    LAS bf16_t* Xs = (LAS bf16_t*)lds; LAS bf16_t* Bs = Xs + 128 * 136;
    LAS float* dts = (LAS float*)(Bs + 128 * 136); LAS float* acs = dts + 256; LAS float* wsc = acs + 256;
    const int tok0 = b * SEQ + c * 128;
    ssd_dt_acum(p, l, tok0, g, dts, acs, wave, lane);
    stage_conv(p, l, Xs, 136, tok0, c * 128, g * 128, tid);
    stage_conv(p, l, Bs, 136, tok0, c * 128, 256 + g * 128, tid);
    __syncthreads();
    if (tid < 256) { const int hh = tid >> 7, j = tid & 127; wsc[tid] = __expf(acs[hh * 128 + 127] - acs[hh * 128 + j]) * dts[hh * 128 + j]; }
    if (tid < 2) ((float*)(p.ws + WS_CDEC))[(b * 32 + c) * 4 + 2 * g + tid] = __expf(acs[tid * 128 + 127]);
    __syncthreads();
    const int r = tid >> 2, q = tid & 3, hh = r >> 6;
    float acc[32];
#pragma unroll
    for (int i = 0; i < 32; ++i) acc[i] = 0.f;
    for (int j = 0; j < 128; ++j) { const float coef = bf2f(Xs[j * 136 + r]) * wsc[hh * 128 + j]; axpy_row<32>(acc, coef, Bs + j * 136 + q * 32); }
    float* dst = (float*)(p.ws + WS_SST) + ((size_t)((b * 32 + c) * 4 + 2 * g + hh)) * 8192 + (r & 63) * 128 + q * 32;
#pragma unroll
    for (int i = 0; i < 32; i += 4) *(f32x4*)(dst + i) = (f32x4){acc[i], acc[i + 1], acc[i + 2], acc[i + 3]};
    __syncthreads();
}

DI void ret_states_unit(const Params& p, int b, int c, LAS unsigned char* lds, int tid) {
    LAS bf16_t* Ks = (LAS bf16_t*)lds; LAS bf16_t* Vs = Ks + 128 * 264;
    const int tok0 = b * SEQ + c * 128; const bf16_t* proj = (const bf16_t*)(p.ws + WS_PROJ);
    for (int e = tid; e < 128 * 32; e += NTHR) { const int j = e >> 5, c8 = (e & 31) * 8;
        *(LAS u32x4*)(Ks + j * 264 + c8) = *(const u32x4*)(proj + (size_t)(tok0 + j) * PP + CK + c8);
        *(LAS u32x4*)(Vs + j * 264 + c8) = *(const u32x4*)(proj + (size_t)(tok0 + j) * PP + CV + c8); }
    __syncthreads();
    const int h = tid >> 7, d = (tid >> 1) & 63, eh = tid & 1;
    const float lg = log2f(1.0f - exp2f(-5.0f - (float)h));
    float acc[32];
#pragma unroll
    for (int i = 0; i < 32; ++i) acc[i] = 0.f;
    for (int j = 0; j < 128; ++j) { const float coef = bf2f(Ks[j * 264 + h * 64 + d]) * exp2f((float)(127 - j) * lg); axpy_row<32>(acc, coef, Vs + j * 264 + h * 64 + eh * 32); }
    float* dst = (float*)(p.ws + WS_RST) + ((size_t)((b * 32 + c) * 4 + h)) * 4096 + d * 64 + eh * 32;
#pragma unroll
    for (int i = 0; i < 32; i += 4) *(f32x4*)(dst + i) = (f32x4){acc[i], acc[i + 1], acc[i + 2], acc[i + 3]};
    __syncthreads();
}

DI void conv_unit(const Params& p, int l, int b, int s0, LAS unsigned char* lds, int tid, int wave, int lane) {
    LAS bf16_t* Hs = (LAS bf16_t*)lds;
    LAS float* Os = (LAS float*)(lds + 94 * 256 * 2);
    const bf16_t* proj = (const bf16_t*)(p.ws + WS_PROJ);
    for (int e = tid; e < 94 * 32; e += NTHR) { const int r = e >> 5, c8 = (e & 31) * 8; const int s = s0 - 30 + r;
        u32x4 v = (u32x4){0u, 0u, 0u, 0u};
        if (s >= 0) v = *(const u32x4*)(proj + (size_t)(b * SEQ + s) * PP + DV + c8);
        *(LAS u32x4*)(Hs + r * 256 + c8) = v; }
    __syncthreads();
    { const int ch = tid & 255, half = tid >> 8;
      const float* w = p.in[12] + (size_t)l * 31 * 256 + ch; const float bias = p.in[13][l * 256 + ch];
      float wr[31];
#pragma unroll
      for (int k = 0; k < 31; ++k) wr[k] = w[k * 256];
      for (int tt = 0; tt < 32; ++tt) { const int t = half * 32 + tt; float a = bias;
#pragma unroll
          for (int k = 0; k < 31; ++k) a += wr[k] * bf2f(Hs[(t + k) * 256 + ch]);
          Os[t * 256 + ch] = a; } }
    __syncthreads();
    const f32x4 lg = *(const f32x4*)(p.in[14] + l * 256 + lane * 4), lb = *(const f32x4*)(p.in[15] + l * 256 + lane * 4);
    bf16_t* ycat = (bf16_t*)(p.ws + WS_YCAT);
    for (int tt = 0; tt < 8; ++tt) { const int t = wave * 8 + tt; const f32x4 v = *(const LAS f32x4*)(Os + t * 256 + lane * 4);
        const float mean = wave_sum((v[0] + v[1]) + (v[2] + v[3])) * (1.0f / 256.0f);
        const f32x4 d = v - mean; const float var = wave_sum((d[0] * d[0] + d[1] * d[1]) + (d[2] * d[2] + d[3] * d[3])) * (1.0f / 256.0f);
        const float rs = rsqrtf(var + EPS); f32x4 o = d * rs * lg + lb;
        u32x2 w; w.x = pk2(silu_f(o[0]), silu_f(o[1])); w.y = pk2(silu_f(o[2]), silu_f(o[3]));
        *(u32x2*)(ycat + (size_t)(b * SEQ + s0 + t) * DM + 768 + lane * 4) = w; }
    __syncthreads();
}

DI void attn_task(const Params& p, int tok, int hd, int lane, LAS float* qs) {
    const bf16_t* proj = (const bf16_t*)(p.ws + WS_PROJ);
    const int pos = tok & (SEQ - 1); const size_t rowbase = (size_t)(tok - pos);
    qs[lane] = bf2f(proj[(size_t)tok * PP + AQ + hd * 64 + lane]);
    float sc[7];
#pragma unroll
    for (int ps = 0; ps < 7; ++ps) { const int e = ps * 64 + lane; const int pat = e / 129, j = e - pat * 129; const int kp = pos - (j << (2 * pat));
        const bool valid = (e < 387) && (kp >= 0); float s = 0.f;
        if (valid) { const u32x4* kr = (const u32x4*)(proj + (rowbase + kp) * PP + AK + hd * 64);
#pragma unroll
            for (int c = 0; c < 8; ++c) { float kf[8]; unpack8(kr[c], kf); const f32x4 q0 = *(const LAS f32x4*)(qs + c * 8), q1 = *(const LAS f32x4*)(qs + c * 8 + 4);
                s += (q0[0] * kf[0] + q0[1] * kf[1]) + (q0[2] * kf[2] + q0[3] * kf[3]) + (q1[0] * kf[4] + q1[1] * kf[5]) + (q1[2] * kf[6] + q1[3] * kf[7]); } }
        sc[ps] = valid ? s : -INFINITY; }
    float mx = sc[0];
#pragma unroll
    for (int ps = 1; ps < 7; ++ps) mx = fmaxf(mx, sc[ps]);
    mx = wave_max(mx);
    float z = 0.f; int pr[7];
#pragma unroll
    for (int ps = 0; ps < 7; ++ps) { const float e = (sc[ps] == -INFINITY) ? 0.f : __expf(sc[ps] - mx); z += e; pr[ps] = __float_as_int(e); }
    z = wave_sum(z);
    float o = 0.f;
    const bf16_t* vb = proj + rowbase * PP + AV + hd * 64 + lane;
#pragma unroll
    for (int ps = 0; ps < 7; ++ps) {
        const int nl = ps == 6 ? 3 : 64;
#pragma unroll 8
        for (int ln = 0; ln < nl; ++ln) { const int e = ps * 64 + ln; const int pat = e / 129, j = e - pat * 129; int kp = pos - (j << (2 * pat));
            const bool ok = kp >= 0; kp = ok ? kp : pos;
            const float pe = ok ? __int_as_float(__builtin_amdgcn_readlane(pr[ps], ln)) : 0.f;
            o += pe * bf2f(vb[(size_t)kp * PP]); } }
    ((bf16_t*)(p.ws + WS_YCAT))[(size_t)tok * DM + hd * 64 + lane] = (bf16_t)f2bf(o / z);
}

DI void scan_phase(const Params& p, int gt, int NT) {
    float* sst = (float*)(p.ws + WS_SST); const float* cdec = (const float*)(p.ws + WS_CDEC);
    for (int i = gt; i < NB * 4 * 8192; i += NT) { const int b = i >> 15, rem = i & 32767, h = rem >> 13, pn = rem & 8191; float run = 0.f;
#pragma unroll 8
        for (int c = 0; c < 32; ++c) { const size_t idx = ((size_t)((b * 32 + c) * 4 + h)) * 8192 + pn; const float st = sst[idx]; sst[idx] = run; run = cdec[(b * 32 + c) * 4 + h] * run + st; } }
    float* rst = (float*)(p.ws + WS_RST);
    for (int i = gt; i < NB * 4 * 4096; i += NT) { const int b = i >> 14, rem = i & 16383, h = rem >> 12, de = rem & 4095; float run = 0.f;
        const float gc = exp2f(128.0f * log2f(1.0f - exp2f(-5.0f - (float)h)));
#pragma unroll 8
        for (int c = 0; c < 32; ++c) { const size_t idx = ((size_t)((b * 32 + c) * 4 + h)) * 4096 + de; const float st = rst[idx]; rst[idx] = run; run = gc * run + st; } }
}

DI void ssd_y_unit(const Params& p, int l, int b, int c, int g, LAS unsigned char* lds, int tid, int wave, int lane) {
    LAS bf16_t* Cs = (LAS bf16_t*)lds; LAS bf16_t* Bs = Cs + 128 * 136;
    LAS float* CB = (LAS float*)(Bs + 128 * 136); LAS bf16_t* Pv = (LAS bf16_t*)CB;
    LAS float* dts = CB + 128 * 132; LAS float* acs = dts + 256;
    const int tok0 = b * SEQ + c * 128; const bf16_t* proj = (const bf16_t*)(p.ws + WS_PROJ);
    ssd_dt_acum(p, l, tok0, g, dts, acs, wave, lane);
    stage_conv(p, l, Cs, 136, tok0, c * 128, 512 + g * 128, tid);
    { const float* prev = (const float*)(p.ws + WS_SST) + ((size_t)((b * 32 + c) * 4 + 2 * g)) * 8192;
      for (int e = tid; e < 128 * 32; e += NTHR) { const int r = e >> 5, n4 = (e & 31) * 4; const f32x4 v = *(const f32x4*)(prev + r * 128 + n4);
          u32x2 w; w.x = pk2(v[0], v[1]); w.y = pk2(v[2], v[3]); *(LAS u32x2*)(Pv + r * 136 + (r >> 5) * 8 + n4) = w; } }
    __syncthreads();
    const int i = tid >> 2, q = tid & 3, hh = q >> 1;
    float y[32];
#pragma unroll
    for (int cc = 0; cc < 32; ++cc) y[cc] = 0.f;
    nt_acc<32, 128>(y, Cs + i * 136, Pv + (q * 32) * 136 + q * 8, 136);
    { const float ea = __expf(acs[hh * 128 + i]);
#pragma unroll
      for (int cc = 0; cc < 32; ++cc) y[cc] *= ea; }
    __syncthreads();
    stage_conv(p, l, Bs, 136, tok0, c * 128, 256 + g * 128, tid);
    __syncthreads();
    { float cb[32];
#pragma unroll
      for (int cc = 0; cc < 32; ++cc) cb[cc] = 0.f;
      nt_acc<32, 128>(cb, Cs + i * 136, Bs + q * 136, 4 * 136);
#pragma unroll
      for (int cc = 0; cc < 32; ++cc) CB[i * 132 + cc * 4 + q] = cb[cc]; }
    __syncthreads();
    stage_conv(p, l, Bs, 136, tok0, c * 128, g * 128, tid);
    __syncthreads();
    { const float ai = acs[hh * 128 + i]; const int jmax = wave * 16 + 15;
      for (int j = 0; j <= jmax; ++j) { const float m = (j <= i) ? CB[i * 132 + j] * __expf(ai - acs[hh * 128 + j]) * dts[hh * 128 + j] : 0.f; axpy_row<32>(y, m, Bs + j * 136 + q * 32); } }
    { const int head = 2 * g + hh; const float dsk = p.in[10][l * 4 + head]; float xs[32];
#pragma unroll
      for (int c8 = 0; c8 < 32; c8 += 8) { float t8[8]; unpack8(*(const LAS u32x4*)(Bs + i * 136 + q * 32 + c8), t8);
#pragma unroll
          for (int e = 0; e < 8; ++e) xs[c8 + e] = t8[e]; }
      const bf16_t* zp = proj + (size_t)(tok0 + i) * PP + BZ + g * 128 + q * 32; float s2 = 0.f;
#pragma unroll
      for (int c8 = 0; c8 < 32; c8 += 8) { float z8[8]; unpack8(*(const u32x4*)(zp + c8), z8);
#pragma unroll
          for (int e = 0; e < 8; ++e) { const float v = (y[c8 + e] + dsk * xs[c8 + e]) * silu_f(z8[e]); y[c8 + e] = v; s2 += v * v; } }
      s2 += __shfl_xor(s2, 1); s2 += __shfl_xor(s2, 2);
      const float rs = rsqrtf(s2 * (1.0f / 128.0f) + EPS);
      const float* ng = p.in[11] + l * 256 + g * 128 + q * 32;
      bf16_t* yo = (bf16_t*)(p.ws + WS_YCAT) + (size_t)(tok0 + i) * DM + 256 + g * 128 + q * 32;
#pragma unroll
      for (int c8 = 0; c8 < 32; c8 += 8) { u32x4 w; w.x = pk2(y[c8] * rs * ng[c8], y[c8 + 1] * rs * ng[c8 + 1]); w.y = pk2(y[c8 + 2] * rs * ng[c8 + 2], y[c8 + 3] * rs * ng[c8 + 3]);
          w.z = pk2(y[c8 + 4] * rs * ng[c8 + 4], y[c8 + 5] * rs * ng[c8 + 5]); w.w = pk2(y[c8 + 6] * rs * ng[c8 + 6], y[c8 + 7] * rs * ng[c8 + 7]); *(u32x4*)(yo + c8) = w; } }
    __syncthreads();
}

DI void ret_y_unit(const Params& p, int b, int c, int h, LAS unsigned char* lds, int tid, int wave) {
    LAS bf16_t* Qs = (LAS bf16_t*)lds; LAS bf16_t* Ks = Qs + 128 * 72; LAS bf16_t* Vs = Ks + 128 * 72;
    LAS float* Pr = (LAS float*)(Vs + 128 * 72); LAS float* S = Pr + 64 * 64;
    const int tok0 = b * SEQ + c * 128; const bf16_t* proj = (const bf16_t*)(p.ws + WS_PROJ);
    for (int e = tid; e < 128 * 8; e += NTHR) { const int j = e >> 3, c8 = (e & 7) * 8; const bf16_t* rp = proj + (size_t)(tok0 + j) * PP + h * 64 + c8;
        *(LAS u32x4*)(Qs + j * 72 + c8) = *(const u32x4*)(rp + CQ); *(LAS u32x4*)(Ks + j * 72 + c8) = *(const u32x4*)(rp + CK); *(LAS u32x4*)(Vs + j * 72 + c8) = *(const u32x4*)(rp + CV); }
    { const float* prev = (const float*)(p.ws + WS_RST) + ((size_t)((b * 32 + c) * 4 + h)) * 4096;
      for (int e = tid; e < 1024; e += NTHR) *(LAS f32x4*)(Pr + e * 4) = *(const f32x4*)(prev + e * 4); }
    __syncthreads();
    const int i = tid >> 2, q = tid & 3; const float lg = log2f(1.0f - exp2f(-5.0f - (float)h));
    { float s[32];
#pragma unroll
      for (int cc = 0; cc < 32; ++cc) s[cc] = 0.f;
      nt_acc<32, 64>(s, Qs + i * 72, Ks + q * 72, 4 * 72);
#pragma unroll
      for (int cc = 0; cc < 32; ++cc) { const int j = cc * 4 + q; S[i * 132 + j] = (j <= i) ? s[cc] * exp2f((float)(i - j) * lg) : 0.f; } }
    __syncthreads();
    float y[16];
#pragma unroll
    for (int cc = 0; cc < 16; ++cc) y[cc] = 0.f;
    for (int d = 0; d < 64; ++d) { const float qv = bf2f(Qs[i * 72 + d]);
#pragma unroll
        for (int c4 = 0; c4 < 16; c4 += 4) { const f32x4 pv = *(const LAS f32x4*)(Pr + d * 64 + q * 16 + c4); y[c4] += qv * pv[0]; y[c4 + 1] += qv * pv[1]; y[c4 + 2] += qv * pv[2]; y[c4 + 3] += qv * pv[3]; } }
    { const float xi = exp2f((float)(i + 1) * lg);
#pragma unroll
      for (int cc = 0; cc < 16; ++cc) y[cc] *= xi; }
    { const int jmax = wave * 16 + 15;
      for (int j = 0; j <= jmax; ++j) axpy_row<16>(y, S[i * 132 + j], Vs + j * 72 + q * 16); }
    float s2 = 0.f;
#pragma unroll
    for (int cc = 0; cc < 16; ++cc) s2 += y[cc] * y[cc];
    s2 += __shfl_xor(s2, 1); s2 += __shfl_xor(s2, 2);
    const float rs = rsqrtf(s2 * (1.0f / 64.0f) + EPS);
    const bf16_t* gp = proj + (size_t)(tok0 + i) * PP + CG + h * 64 + q * 16;
    bf16_t* yo = (bf16_t*)(p.ws + WS_YCAT) + (size_t)(tok0 + i) * DM + 512 + h * 64 + q * 16;
#pragma unroll
    for (int c8 = 0; c8 < 16; c8 += 8) { float g8[8]; unpack8(*(const u32x4*)(gp + c8), g8); u32x4 w;
        w.x = pk2(y[c8] * rs * silu_f(g8[0]), y[c8 + 1] * rs * silu_f(g8[1])); w.y = pk2(y[c8 + 2] * rs * silu_f(g8[2]), y[c8 + 3] * rs * silu_f(g8[3]));
        w.z = pk2(y[c8 + 4] * rs * silu_f(g8[4]), y[c8 + 5] * rs * silu_f(g8[5])); w.w = pk2(y[c8 + 6] * rs * silu_f(g8[6]), y[c8 + 7] * rs * silu_f(g8[7])); *(u32x4*)(yo + c8) = w; }
    __syncthreads();
}

#define SSB ((float*)(ws + WS_SS))
#define XB ((bf16_t*)(ws + WS_XB))
#define YC ((bf16_t*)(ws + WS_YCAT))
#define PROJ ((bf16_t*)(ws + WS_PROJ))
#define HB ((bf16_t*)(ws + WS_H))
#define PE ((bf16_t*)(ws + WS_PE))

#define CAS4 __attribute__((address_space(4)))
#define RELOAD_P() const CAS4 Params* kp_ = (const CAS4 Params*)__builtin_amdgcn_kernarg_segment_ptr(); asm volatile("" : "+s"(kp_)); const Params& p = *(const Params*)kp_; unsigned char* ws = p.ws; (void)ws
#define FRESH_LANE(v) int v; asm volatile("v_mbcnt_lo_u32_b32 %0, -1, 0\n\tv_mbcnt_hi_u32_b32 %0, -1, %0" : "=v"(v))
#define RELOAD_IDS() RELOAD_P(); FRESH_LANE(lane_); const int lane = lane_, wave = wave_s, tid = wave_s * 64 + lane_; const int gw = blk * NWV + wave, gt = blk * NTHR + tid; (void)gw; (void)gt; (void)lane
#define GEMM_TID() ({ FRESH_LANE(l_); wave_s * 64 + l_; })
#define GBAR() do { ++nbar; asm volatile("s_waitcnt vmcnt(0)" ::: "memory"); __syncthreads(); { FRESH_LANE(l_); if (wave_s == 0 && l_ == 0) { RELOAD_P(); unsigned* ctr = (unsigned*)(ws + WS_BAR); \
        __builtin_amdgcn_fence(__ATOMIC_RELEASE, "agent"); __hip_atomic_fetch_add(ctr, 1u, __ATOMIC_RELAXED, __HIP_MEMORY_SCOPE_AGENT); const unsigned target = nbar * (unsigned)G; \
        while (__hip_atomic_load(ctr, __ATOMIC_RELAXED, __HIP_MEMORY_SCOPE_AGENT) < target) __builtin_amdgcn_s_sleep(2); \
        __builtin_amdgcn_fence(__ATOMIC_ACQUIRE, "agent"); } } __syncthreads(); } while (0)
#define SS_IN (SSB + (l == 0 ? 0 : 3 * M))
#define SSA (SSB + (1 + 3 * l) * M)
#define SSBB (SSB + (2 + 3 * l) * M)
#define SSC (SSB + (3 + 3 * l) * M)
template <int l> DI void run_layer(LAS unsigned char* lds, const int G, const int blk, const int NGW, const int NT, const int wave_s, unsigned& nbar) {

        { RELOAD_P(); pg8::Gemm g{l == 0 ? XB : YC, (const bf16_t*)(ws + WS_WIN), M, PP, DM}; pg8::StaticOrder S; S.init(M, PP, G, blk);
          pg8::EpiScale<0> E{PROJ, PP, SS_IN};
          pg8::gemm_phase<pg8::EpiScale<0>, pg8::StaticOrder, true, true>(lds, g, S, E, GEMM_TID()); }
        GBAR();
        { RELOAD_IDS(); e1_prepass(p, l, gw, NGW, lane); }
        GBAR();
        { RELOAD_IDS(); for (int u = blk; u < 256; u += G) ssd_states_unit(p, l, u >> 6, (u >> 1) & 31, u & 1, lds, tid, wave, lane); }
        { RELOAD_IDS(); for (int u = blk; u < 128; u += G) ret_states_unit(p, u >> 5, u & 31, lds, tid); }
        { RELOAD_IDS(); for (int u = blk; u < 256; u += G) conv_unit(p, l, u >> 6, (u & 63) * 64, lds, tid, wave, lane); }
        { RELOAD_IDS(); for (int tb = blk; tb < 256; tb += G)
            for (int it = 0; it < 32; ++it) attn_task(p, tb * 64 + it * 2 + (wave >> 2), wave & 3, lane, (LAS float*)(lds + wave * 256)); }
        GBAR();
        { RELOAD_IDS(); scan_phase(p, gt, NT); }
        GBAR();
        { RELOAD_IDS(); for (int u = blk; u < 256; u += G) ssd_y_unit(p, l, u >> 6, (u >> 1) & 31, u & 1, lds, tid, wave, lane); }
        { RELOAD_IDS(); for (int u = blk; u < 512; u += G) ret_y_unit(p, u >> 7, (u >> 2) & 31, u & 3, lds, tid, wave); }
        GBAR();
        { RELOAD_P(); pg8::Gemm g{YC, (const bf16_t*)(ws + WS_WOUT), M, DM, DM}; pg8::StaticOrder S; S.init(M, DM, G, blk);
          pg8::EpiRes<0> E{l == 0 ? p.in[0] : p.out, p.out, XB, SSA, DM, nullptr, nullptr};
          pg8::gemm_phase<pg8::EpiRes<0>, pg8::StaticOrder, true, true>(lds, g, S, E, GEMM_TID()); }
        GBAR();
        { RELOAD_P(); pg8::Gemm g{XB, (const bf16_t*)(ws + WS_WUP), M, FF, DM}; pg8::StaticOrder S; S.init(M, FF, G, blk);
          pg8::EpiScale<1> E{HB, FF, SSA};
          pg8::gemm_phase<pg8::EpiScale<1>, pg8::StaticOrder, true, true>(lds, g, S, E, GEMM_TID()); }
        GBAR();
        { RELOAD_P(); pg8::Gemm g{HB, (const bf16_t*)(ws + WS_WDOWN), M, DM, FF}; pg8::StaticOrder S; S.init(M, DM, G, blk);
          pg8::EpiRes<0> E{p.out, p.out, XB, SSBB, DM, nullptr, nullptr};
          pg8::gemm_phase<pg8::EpiRes<0>, pg8::StaticOrder, true, true>(lds, g, S, E, GEMM_TID()); }
        GBAR();
        if (l == 0) { RELOAD_IDS(); convert_weights(p, 1, 1, lds, gw, NGW, lane, wave); __syncthreads(); }
        { RELOAD_P(); pg8::Gemm g{(const bf16_t*)(ws + (l ? WS_PB1 : WS_PB0)), (const bf16_t*)(ws + (l ? WS_WPLE1 : WS_WPLE0)), M, DM, PLE}; pg8::StaticOrder S; S.init(M, DM, G, blk);
          pg8::EpiPe E{PE, DM};
          pg8::gemm_phase<pg8::EpiPe, pg8::StaticOrder, true, true>(lds, g, S, E, GEMM_TID()); }
        { RELOAD_P(); pg8::Gemm g{XB, (const bf16_t*)(ws + (l ? WS_WGATE1 : WS_WGATE0)), M, DM, DM}; pg8::StaticOrder S; S.init(M, DM, G, blk);
          pg8::EpiRes<1> E{p.out, p.out, YC, SSC, DM, PE, SSBB};
          pg8::gemm_phase<pg8::EpiRes<1>, pg8::StaticOrder, true, true>(lds, g, S, E, GEMM_TID()); }
        if (l == 0) GBAR();
    }

__global__ void __launch_bounds__(NTHR, 2) fwd_kernel(Params p_unused) {
    extern __shared__ __attribute__((aligned(16))) unsigned char lds_raw[];
    LAS unsigned char* lds = (LAS unsigned char*)lds_raw;
    cg::grid_group grid = cg::this_grid();
    const int G = gridDim.x, blk = blockIdx.x;
    const int NGW = G * NWV, NT = G * NTHR;
    const int wave_s = __builtin_amdgcn_readfirstlane(threadIdx.x >> 6);
    unsigned nbar = 0;
    { RELOAD_IDS();
    prologue(p, gw, NGW, lane);
    convert_weights(p, 0, 3, lds, gw, NGW, lane, wave);
    convert_weights(p, 1, 2, lds, gw, NGW, lane, wave); }
    grid.sync();

    run_layer<0>(lds, G, blk, NGW, NT, wave_s, nbar);
    run_layer<1>(lds, G, blk, NGW, NT, wave_s, nbar);
}

extern "C" void kernel_launch(void* const* d_in, const int* in_sizes, int n_in, void* d_out, int out_size, void* d_ws, size_t ws_size, hipStream_t stream) {
    static int grid = 0;
    if (grid == 0) {
        int dev = 0, cus = 0, per_cu = 0;
        hipGetDevice(&dev); hipDeviceGetAttribute(&cus, hipDeviceAttributeMultiprocessorCount, dev);
        if (hipFuncSetAttribute((const void*)fwd_kernel, hipFuncAttributeMaxDynamicSharedMemorySize, LDS_BYTES) != hipSuccess) { fprintf(stderr, "kernel_launch: hipFuncSetAttribute failed\n"); }
        if (hipOccupancyMaxActiveBlocksPerMultiprocessor(&per_cu, (const void*)fwd_kernel, NTHR, LDS_BYTES) != hipSuccess || per_cu < 1) { fprintf(stderr, "kernel_launch: occupancy query says %d\n", per_cu); per_cu = 1; }
        (void)hipGetLastError();
        grid = cus * (per_cu > 1 ? 1 : per_cu);
        if (n_in != 23 || ws_size < WS_END) { fprintf(stderr, "kernel_launch: unexpected n_in %d / ws %zu\n", n_in, ws_size); }
    }
    (void)hipMemsetAsync((unsigned char*)d_ws + WS_BAR, 0, 256, stream);
    Params p{};
    for (int i = 0; i < 23; ++i) p.in[i] = (const float*)d_in[i];
    p.out = (float*)d_out; p.ws = (unsigned char*)d_ws;
    void* args[] = {&p};
    hipError_t e = hipLaunchCooperativeKernel((const void*)fwd_kernel, dim3(grid), dim3(NTHR), args, LDS_BYTES, stream);
    if (e != hipSuccess) fprintf(stderr, "cooperative launch failed: %s (grid %d)\n", hipGetErrorString(e), grid);
}
```

```cpp
#include <hip/hip_runtime.h>
#include <cstdio>
#include <cstdint>
namespace pg8 {
#define PG8_LAS __attribute__((address_space(3)))
typedef unsigned short bf16_t;
typedef short bf16x8 __attribute__((ext_vector_type(8)));
typedef float f32x4 __attribute__((ext_vector_type(4)));
typedef unsigned u32x4 __attribute__((ext_vector_type(4)));
constexpr int BM = 256, BK = 64, HALF = 128, HTB = HALF * BK * 2  , STAGE_BYTES = 8 * HTB, NXCD = 8, WGM = 8;

__host__ __device__ __forceinline__ int lds_byte(int r, int c) { const int st = (r >> 4) * 2 + (c >> 5), rr = r & 15, cc = c & 31, ob = rr * 64 + cc * 2; return st * 1024 + (ob ^ (((ob >> 9) & 1) << 5)); }
__host__ __device__ __forceinline__ void stage_rc(int b, int& R, int& C) { const int st = b / 1024, sb = b % 1024, swz = sb ^ (((sb >> 9) & 1) << 5); R = (st >> 1) * 16 + swz / 64; C = (st & 1) * 32 + (swz % 64) / 2; }
__host__ __device__ __forceinline__ int perm32(int rho) { const int n = rho >> 4, i = rho & 15; return 8 * (i >> 2) + 4 * n + (i & 3); }

struct Unit { int pm, pn; };
struct Gemm { const bf16_t* A; const bf16_t* Bt; int M, N, K; };

struct StaticOrder {
    int nM, nN, nwg, G, c;
    __host__ __device__ void init(int M, int N, int G_, int c_) { nM = M / BM; nN = N / BM; nwg = nM * nN; G = G_; c = c_; }
    __host__ __device__ bool next(int i, Unit& u) const {
        const long L = (long)i * G + c; if (L >= nwg) return false;
        int wgid = (int)L; { const int q = nwg / NXCD, r = nwg % NXCD, xcd = wgid % NXCD, off = wgid / NXCD; wgid = (xcd < r ? xcd * (q + 1) : r * (q + 1) + (xcd - r) * q) + off; }
        const int nig = WGM * nN, gid = wgid / nig, fm = gid * WGM, gsz = (nM - fm) < WGM ? (nM - fm) : WGM;
        u.pm = fm + ((wgid % nig) % gsz); u.pn = (wgid % nig) / gsz; return true;
    }
    __device__ __forceinline__ void a_ready(const Unit&) const {}
    __device__ __forceinline__ void done(const Unit&) const {}
};

__device__ __forceinline__ unsigned cvt_pk_bf16(float lo, float hi) { unsigned r; asm volatile("v_cvt_pk_bf16_f32 %0, %1, %2" : "=v"(r) : "v"(lo), "v"(hi)); return r; }

typedef unsigned u32x2 __attribute__((ext_vector_type(2)));
constexpr float RMS_EPS = 1e-6f;
template <int ACT> struct EpiScale {
    static constexpr bool PERM = true, AFTER_DRAIN = false;
    bf16_t* O; int ldc; const float* ss;
    __device__ __forceinline__ void operator()(const f32x4 (&acc)[2][2][4][2], const Unit& u, int wr, int wc, int fr, int fq) const {
        const int row0 = u.pm * BM + wr * 64 + fr; const int col0 = u.pn * BM + wc * 32 + 8 * fq;
#pragma unroll
        for (int ai = 0; ai < 2; ++ai)
#pragma unroll
            for (int m = 0; m < 4; ++m) { const int row = row0 + ai * HALF + m * 16; const float r = ss ? rsqrtf(ss[row] * (1.0f / 1024.0f) + RMS_EPS) : 1.0f;
                bf16_t* rowp = O + (size_t)row * ldc + col0;
#pragma unroll
                for (int bj = 0; bj < 2; ++bj) { f32x4 v0 = acc[ai][bj][m][0] * r, v1 = acc[ai][bj][m][1] * r;
                    if (ACT == 1) {
#pragma unroll
                        for (int e = 0; e < 4; ++e) { float a = fmaxf(v0[e], 0.f), b = fmaxf(v1[e], 0.f); v0[e] = a * a; v1[e] = b * b; } }
                    u32x4 w; w.x = cvt_pk_bf16(v0[0], v0[1]); w.y = cvt_pk_bf16(v0[2], v0[3]); w.z = cvt_pk_bf16(v1[0], v1[1]); w.w = cvt_pk_bf16(v1[2], v1[3]);
                    *(u32x4*)(rowp + bj * HALF) = w; }
                asm volatile("" ::: "memory"); }
    }
};
struct EpiPe {
    static constexpr bool PERM = false, AFTER_DRAIN = false;
    bf16_t* O; int ldc;
    __device__ __forceinline__ void operator()(const f32x4 (&acc)[2][2][4][2], const Unit& u, int wr, int wc, int fr, int fq) const {
        const int col0 = u.pn * BM + wc * 32 + 4 * fq;
#pragma unroll
        for (int ai = 0; ai < 2; ++ai)
#pragma unroll
            for (int m = 0; m < 4; ++m) { const size_t off = (size_t)(u.pm * BM + ai * HALF + wr * 64 + m * 16 + fr) * ldc + col0;
#pragma unroll
                for (int bj = 0; bj < 2; ++bj)
#pragma unroll
                    for (int n = 0; n < 2; ++n) { const f32x4 v = acc[ai][bj][m][n]; u32x2 w; w.x = cvt_pk_bf16(v[0], v[1]); w.y = cvt_pk_bf16(v[2], v[3]);
                        *(u32x2*)(O + off + bj * HALF + n * 16) = w; } }
    }
};
template <int GATE> struct EpiRes {
    static constexpr bool PERM = false, AFTER_DRAIN = false;
    const float* base; float* out; bf16_t* xb; float* ssout; int ldc; const bf16_t* pe; const float* ss;
    __device__ __forceinline__ void operator()(const f32x4 (&acc)[2][2][4][2], const Unit& u, int wr, int wc, int fr, int fq) const {
        const int col0 = u.pn * BM + wc * 32 + 4 * fq;
#pragma unroll
        for (int ai = 0; ai < 2; ++ai)
#pragma unroll
            for (int m = 0; m < 4; ++m) { const int row = u.pm * BM + ai * HALF + wr * 64 + m * 16 + fr; const size_t off = (size_t)row * ldc + col0; float s = 0.f;
                float r = 1.f; if (GATE) r = rsqrtf(ss[row] * (1.0f / 1024.0f) + RMS_EPS);
#pragma unroll
                for (int bj = 0; bj < 2; ++bj)
#pragma unroll
                    for (int n = 0; n < 2; ++n) { const size_t o2 = off + bj * HALF + n * 16; const f32x4 bs = *(const f32x4*)(base + o2); f32x4 a = acc[ai][bj][m][n];
                        if (GATE) { const u32x2 pw = *(const u32x2*)(pe + o2);
                            const float p0 = __uint_as_float(pw.x << 16), p1 = __uint_as_float(pw.x & 0xffff0000u), p2 = __uint_as_float(pw.y << 16), p3 = __uint_as_float(pw.y & 0xffff0000u);
                            a[0] = p0 / (1.f + __expf(-a[0] * r)); a[1] = p1 / (1.f + __expf(-a[1] * r)); a[2] = p2 / (1.f + __expf(-a[2] * r)); a[3] = p3 / (1.f + __expf(-a[3] * r)); }
                        const f32x4 o = bs + a; *(f32x4*)(out + o2) = o;
                        u32x2 w; w.x = cvt_pk_bf16(o[0], o[1]); w.y = cvt_pk_bf16(o[2], o[3]); *(u32x2*)(xb + o2) = w;
                        s += (o[0] * o[0] + o[1] * o[1]) + (o[2] * o[2] + o[3] * o[3]); }
                s += __shfl_xor(s, 16); s += __shfl_xor(s, 32);
                if (fq == 0) atomicAdd(ssout + row, s);
                asm volatile("" ::: "memory"); }
    }
};
template <class Epi, class Sched, bool ALIGN_EPI = false, bool SP2 = false>
__device__ __forceinline__ void gemm_phase(PG8_LAS unsigned char* lds, const Gemm g, const Sched& S, const Epi& E, int tid_) {
    const int tid = tid_, wid = __builtin_amdgcn_readfirstlane(tid >> 6), lane = tid & 63, wr = wid >> 2, wc = wid & 3, fr = lane & 15, fq = lane >> 4;
    const int K = g.K, nt = K / BK;
    unsigned voffA[2], voffB[2];
#pragma unroll
    for (int i = 0; i < 2; ++i) { int R, C; stage_rc(tid * 16 + i * 8192, R, C); const int Rb = Epi::PERM ? ((R & ~31) + perm32(R & 31)) : R;
        voffA[i] = (unsigned)(R * K + C) * 2u; voffB[i] = (unsigned)(Rb * K + C) * 2u; }
    const size_t kstep = (size_t)(BK * 2);
    const size_t hstep = (size_t)HALF * K * 2;
    const size_t tstep = 2 * hstep;
    const unsigned ldsw = (unsigned)wid * 1024u;
    const int aoff = lds_byte(wr * 64 + fr, fq * 8), boff = lds_byte(wc * 32 + fr, fq * 8);
#define PG8_SA(b, h) (((b) * 2 + (h)) * HTB)
#define PG8_SB(b, h) ((4 + (b) * 2 + (h)) * HTB)
#define PG8_STAGE(bufoff, gbase, voff) do { _Pragma("unroll") for (int _i = 0; _i < 2; ++_i) \
        __builtin_amdgcn_global_load_lds((const unsigned*)((const char*)(gbase) + (voff)[_i]), (PG8_LAS unsigned*)(lds + (bufoff) + ldsw + _i * 8192), 16, 0, 0); } while (0)
#define PG8_LDA(dst, b, h) do { _Pragma("unroll") for (int m = 0; m < 4; ++m) _Pragma("unroll") for (int k = 0; k < 2; ++k) dst[m][k] = *(const PG8_LAS bf16x8*)(lds + PG8_SA(b, h) + aoff + m * 2048 + k * 1024); } while (0)
#define PG8_LDB(dst, b, h) do { _Pragma("unroll") for (int n = 0; n < 2; ++n) _Pragma("unroll") for (int k = 0; k < 2; ++k) dst[n][k] = *(const PG8_LAS bf16x8*)(lds + PG8_SB(b, h) + boff + n * 2048 + k * 1024); } while (0)
#define PG8_MMA(ai, bj, At, Bt) do { __builtin_amdgcn_s_setprio(1); _Pragma("unroll") for (int m = 0; m < 4; ++m) _Pragma("unroll") for (int n = 0; n < 2; ++n) _Pragma("unroll") for (int k = 0; k < 2; ++k) \
        acc[ai][bj][m][n] = __builtin_amdgcn_mfma_f32_16x16x32_bf16(Bt[n][k], At[m][k], acc[ai][bj][m][n], 0, 0, 0); __builtin_amdgcn_s_setprio(0); } while (0)
#define PG8_WAIT_V(n) asm volatile("s_waitcnt vmcnt(" #n ")" ::: "memory")
#define PG8_WAIT_L(n) asm volatile("s_waitcnt lgkmcnt(" #n ")" ::: "memory")
#define PG8_BAR __builtin_amdgcn_s_barrier()
#define PG8_SCHED __builtin_amdgcn_sched_barrier(0)
    Unit cur, nxt; int ui = 0;
    if (!S.next(0, cur)) return;
    f32x4 acc[2][2][4][2];
#pragma unroll
    for (int a = 0; a < 2; ++a)
#pragma unroll
        for (int b = 0; b < 2; ++b)
#pragma unroll
            for (int m = 0; m < 4; ++m)
#pragma unroll
                for (int n = 0; n < 2; ++n) acc[a][b][m][n] = (f32x4){0.f, 0.f, 0.f, 0.f};
    bf16x8 At[4][2], B0[2][2], B1[2][2];
    const char* cA = (const char*)g.A + (size_t)cur.pm * tstep; const char* cB = (const char*)g.Bt + (size_t)cur.pn * tstep;
    S.a_ready(cur);
    if constexpr (SP2) {
        PG8_STAGE(PG8_SB(0, 0), cB, voffB); PG8_STAGE(PG8_SB(0, 1), cB + hstep, voffB); PG8_STAGE(PG8_SA(0, 0), cA, voffA); PG8_STAGE(PG8_SA(0, 1), cA + hstep, voffA);
        if (wr == 1) PG8_BAR;
        PG8_WAIT_V(2); PG8_BAR;
        PG8_STAGE(PG8_SB(1, 0), cB + kstep, voffB); PG8_STAGE(PG8_SA(1, 0), cA + kstep, voffA); PG8_STAGE(PG8_SB(1, 1), cB + hstep + kstep, voffB);
        PG8_WAIT_V(6); PG8_BAR;
    } else {
        PG8_STAGE(PG8_SB(0, 0), cB, voffB); PG8_STAGE(PG8_SA(0, 0), cA, voffA); PG8_STAGE(PG8_SB(0, 1), cB + hstep, voffB); PG8_STAGE(PG8_SA(0, 1), cA + hstep, voffA);
        if (wr == 1) PG8_BAR;
        PG8_WAIT_V(4); PG8_BAR;
        PG8_STAGE(PG8_SB(1, 0), cB + kstep, voffB); PG8_STAGE(PG8_SA(1, 0), cA + kstep, voffA); PG8_STAGE(PG8_SB(1, 1), cB + hstep + kstep, voffB);
        PG8_WAIT_V(6); PG8_BAR;
    }
    for (;;) {
        const bool has_next = S.next(ui + 1, nxt);
        const char* nA = has_next ? (const char*)g.A + (size_t)nxt.pm * tstep : cA; const char* nB = has_next ? (const char*)g.Bt + (size_t)nxt.pn * tstep : cB;
        for (int t = 0; t < nt; t += 2) {
            const bool last = (t == nt - 2);
            const char* a1 = cA + (size_t)(t + 1) * kstep;
            const char* a2 = last ? nA : cA + (size_t)(t + 2) * kstep; const char* b2 = last ? nB : cB + (size_t)(t + 2) * kstep;
            const char* a3 = a2 + kstep; const char* b3 = b2 + kstep;
            if (last && has_next) S.a_ready(nxt);
            if constexpr (SP2) {
            PG8_LDB(B0, 0, 0); PG8_LDB(B1, 0, 1); PG8_SCHED; PG8_LDA(At, 0, 0); PG8_STAGE(PG8_SA(1, 1), a1 + hstep, voffA);
            PG8_WAIT_V(8); PG8_WAIT_L(0); PG8_BAR; PG8_MMA(0, 0, At, B0); PG8_MMA(0, 1, At, B1); PG8_BAR; PG8_SCHED;
            PG8_LDA(At, 0, 1); PG8_STAGE(PG8_SB(0, 0), b2, voffB); PG8_STAGE(PG8_SB(0, 1), b2 + hstep, voffB); PG8_STAGE(PG8_SA(0, 0), a2, voffA);
            PG8_WAIT_V(8); PG8_WAIT_L(0); PG8_BAR; PG8_MMA(1, 0, At, B0); PG8_MMA(1, 1, At, B1); PG8_BAR; PG8_SCHED;
            PG8_LDB(B0, 1, 0); PG8_LDB(B1, 1, 1); PG8_SCHED; PG8_LDA(At, 1, 0); PG8_STAGE(PG8_SA(0, 1), a2 + hstep, voffA);
            PG8_WAIT_V(8); PG8_WAIT_L(0); PG8_BAR; PG8_MMA(0, 0, At, B0); PG8_MMA(0, 1, At, B1); PG8_BAR; PG8_SCHED;
            PG8_LDA(At, 1, 1); PG8_STAGE(PG8_SB(1, 0), b3, voffB); PG8_STAGE(PG8_SB(1, 1), b3 + hstep, voffB); PG8_STAGE(PG8_SA(1, 0), a3, voffA);
            PG8_WAIT_V(8); PG8_WAIT_L(0); PG8_BAR; PG8_MMA(1, 0, At, B0); PG8_MMA(1, 1, At, B1); PG8_BAR; PG8_SCHED;
            } else {
            PG8_LDB(B0, 0, 0); PG8_SCHED; PG8_LDA(At, 0, 0); PG8_STAGE(PG8_SA(1, 1), a1 + hstep, voffA);
            PG8_WAIT_L(8); PG8_BAR; PG8_WAIT_L(0); PG8_MMA(0, 0, At, B0); PG8_BAR; PG8_SCHED;
            PG8_LDB(B1, 0, 1); PG8_STAGE(PG8_SB(0, 0), b2, voffB);
            PG8_BAR; PG8_WAIT_L(0); PG8_MMA(0, 1, At, B1); PG8_BAR;
            PG8_LDA(At, 0, 1); PG8_STAGE(PG8_SA(0, 0), a2, voffA);
            PG8_BAR; PG8_WAIT_L(0); PG8_MMA(1, 0, At, B0); PG8_BAR; PG8_SCHED;
            PG8_STAGE(PG8_SB(0, 1), b2 + hstep, voffB);
            PG8_WAIT_V(6); PG8_BAR; PG8_MMA(1, 1, At, B1); PG8_BAR;
            PG8_LDB(B0, 1, 0); PG8_SCHED; PG8_LDA(At, 1, 0); PG8_STAGE(PG8_SA(0, 1), a2 + hstep, voffA);
            PG8_WAIT_L(8); PG8_BAR; PG8_WAIT_L(0); PG8_MMA(0, 0, At, B0); PG8_BAR; PG8_SCHED;
            PG8_LDB(B1, 1, 1); PG8_STAGE(PG8_SB(1, 0), b3, voffB);
            PG8_BAR; PG8_WAIT_L(0); PG8_MMA(0, 1, At, B1); PG8_BAR;
            PG8_LDA(At, 1, 1); PG8_STAGE(PG8_SA(1, 0), a3, voffA);
            PG8_BAR; PG8_WAIT_L(0); PG8_MMA(1, 0, At, B0); PG8_BAR; PG8_SCHED;
            PG8_STAGE(PG8_SB(1, 1), b3 + hstep, voffB);
            PG8_WAIT_V(6); PG8_BAR; PG8_MMA(1, 1, At, B1); PG8_BAR;
            }
        }
        if constexpr (ALIGN_EPI) { if (wr == 0) PG8_BAR; }
        if constexpr (!Epi::AFTER_DRAIN) { E(acc, cur, wr, wc, fr, fq); S.done(cur); }
        if (!has_next) break;
#pragma unroll
        for (int a = 0; a < 2; ++a)
#pragma unroll
            for (int b = 0; b < 2; ++b)
#pragma unroll
                for (int m = 0; m < 4; ++m)
#pragma unroll
                    for (int n = 0; n < 2; ++n) acc[a][b][m][n] = (f32x4){0.f, 0.f, 0.f, 0.f};
        cur = nxt; cA = nA; cB = nB; ++ui;
        if constexpr (ALIGN_EPI) { if (wr == 1) PG8_BAR; }
    }
    PG8_WAIT_V(0);
    if constexpr (!ALIGN_EPI) { if (wr == 0) PG8_BAR; }
    PG8_BAR;
    if constexpr (Epi::AFTER_DRAIN) { E.fused(acc, cur, wr, wc, fr, fq, lds, wid, lane); S.done(cur); }
#undef PG8_SA
#undef PG8_SB
#undef PG8_STAGE
#undef PG8_LDA
#undef PG8_LDB
#undef PG8_MMA
#undef PG8_WAIT_V
#undef PG8_WAIT_L
#undef PG8_BAR
#undef PG8_SCHED
}
}

#include <hip/hip_cooperative_groups.h>
namespace cg = cooperative_groups;
#define LAS __attribute__((address_space(3)))
#define DI __device__ __forceinline__
typedef unsigned short bf16_t;
typedef unsigned u32x4 __attribute__((ext_vector_type(4)));
typedef unsigned u32x2 __attribute__((ext_vector_type(2)));
typedef float f32x4 __attribute__((ext_vector_type(4)));

constexpr int SEQ = 4096, NB = 4, M = NB * SEQ, DM = 1024, FF = 4096, PLE = 256;
constexpr int PP = 3584;
constexpr int IN_ORIG = 3332;
constexpr int AQ = 0, AK = 256, AV = 512, BZ = 768, BX = 1024, BDT = 1792, CQ = 2048, CK = 2304, CV = 2560, CG = 2816, DV = 3072, DG = 3328;
constexpr float EPS = 1e-6f;
constexpr int NTHR = 512, NWV = 8;
constexpr int LDS_BYTES = 147456;
constexpr size_t MiB = 1u << 20;
constexpr size_t WS_SS = 0;
constexpr size_t WS_CDEC = 512 * 1024; constexpr size_t WS_BAR = 600 * 1024;
constexpr size_t WS_TAB = 1 * MiB;
constexpr size_t WS_PB0 = 3 * MiB;
constexpr size_t WS_WIN = 11 * MiB, WS_WOUT = 18 * MiB, WS_WUP = 20 * MiB, WS_WDOWN = 28 * MiB, WS_WPLE0 = 36 * MiB, WS_WGATE0 = 37 * MiB;
constexpr size_t WS_XB = 39 * MiB, WS_YCAT = 71 * MiB, WS_PROJ = 103 * MiB, WS_SST = 215 * MiB, WS_RST = 231 * MiB;
constexpr size_t WS_H = 103 * MiB, WS_PE = 103 * MiB;
constexpr size_t WS_VT = 39 * MiB;
constexpr size_t WS_LSE = 250 * MiB;
constexpr size_t WS_WPLE1 = 239 * MiB, WS_WGATE1 = 240 * MiB, WS_PB1 = 242 * MiB, WS_END = 256 * MiB;

struct Params {
    const float* in[23]; float* out; unsigned char* ws;
};

DI float bf2f(bf16_t u) { return __uint_as_float((unsigned)u << 16); }
DI unsigned f2bf(float f) { unsigned u = __float_as_uint(f); return (u + 0x7fffu + ((u >> 16) & 1u)) >> 16; }
DI unsigned pk2(float lo, float hi) { return f2bf(lo) | (f2bf(hi) << 16); }
DI float lo16(unsigned w) { return __uint_as_float(w << 16); }
DI float hi16(unsigned w) { return __uint_as_float(w & 0xffff0000u); }
DI float wave_sum(float v) {
#pragma unroll
    for (int o = 1; o < 64; o <<= 1) v += __shfl_xor(v, o);
    return v;
}
DI float wave_max(float v) {
#pragma unroll
    for (int o = 1; o < 64; o <<= 1) v = fmaxf(v, __shfl_xor(v, o));
    return v;
}
DI float silu_f(float v) { return v / (1.f + __expf(-v)); }
DI float sigm_f(float v) { return 1.f / (1.f + __expf(-v)); }
DI void unpack8(const u32x4 w, float (&f)[8]) { f[0] = lo16(w.x); f[1] = hi16(w.x); f[2] = lo16(w.y); f[3] = hi16(w.y); f[4] = lo16(w.z); f[5] = hi16(w.z); f[6] = lo16(w.w); f[7] = hi16(w.w); }

DI void tr_item(const float* W, int K, int Norig, bf16_t* WT, const float* g, bool gap, LAS float* scr, int item, int nblk, int lane) {
    const int kb = item / nblk, nb = item % nblk, k0 = 64 * kb, n0 = 32 * nb;
    const int n = n0 + (lane & 31);
    int orig = n; if (gap) orig = (n < 1796) ? n : (n < 2048 ? -1 : n - 252);
#pragma unroll 8
    for (int i = 0; i < 32; ++i) { const int kk = 2 * i + (lane >> 5); float v = 0.f;
        if (orig >= 0) { v = W[(size_t)(k0 + kk) * Norig + orig]; if (g) v *= g[k0 + kk]; }
        scr[kk * 33 + (lane & 31)] = v; }
    asm volatile("s_waitcnt lgkmcnt(0)" ::: "memory");
    const int c = lane & 7;
#pragma unroll
    for (int j = 0; j < 4; ++j) { const int nn = (lane >> 3) + 8 * j; const LAS float* s = scr + (8 * c) * 33 + nn;
        u32x4 o; o.x = pk2(s[0 * 33], s[1 * 33]); o.y = pk2(s[2 * 33], s[3 * 33]); o.z = pk2(s[4 * 33], s[5 * 33]); o.w = pk2(s[6 * 33], s[7 * 33]);
        *(u32x4*)(WT + (size_t)(n0 + nn) * K + k0 + 8 * c) = o; }
    asm volatile("s_waitcnt lgkmcnt(0)" ::: "memory");
}
DI void convert_weights(const Params& p, int l, int which, LAS unsigned char* lds, int gw, int NGW, int lane, int wave) {
    LAS float* scr = (LAS float*)(lds + wave * 16384);
    unsigned char* ws = p.ws;
    if (which & 1) {
        constexpr int I_IN = 16 * 112, I_OUT = 16 * 32, I_UP = 16 * 128, I_DN = 64 * 32;
        for (int it = gw; it < I_IN + I_OUT + I_UP + I_DN; it += NGW) {
            int r = it;
            if (r < I_IN) { tr_item(p.in[3] + (size_t)l * DM * IN_ORIG, DM, IN_ORIG, (bf16_t*)(ws + WS_WIN), p.in[2] + l * DM, true, scr, r, 112, lane); continue; } r -= I_IN;
            if (r < I_OUT) { tr_item(p.in[16] + (size_t)l * DM * DM, DM, DM, (bf16_t*)(ws + WS_WOUT), nullptr, false, scr, r, 32, lane); continue; } r -= I_OUT;
            if (r < I_UP) { tr_item(p.in[18] + (size_t)l * DM * FF, DM, FF, (bf16_t*)(ws + WS_WUP), p.in[17] + l * DM, false, scr, r, 128, lane); continue; } r -= I_UP;
            tr_item(p.in[19] + (size_t)l * FF * DM, FF, DM, (bf16_t*)(ws + WS_WDOWN), nullptr, false, scr, r, 32, lane);
        }
    }
    if (which & 2) {
        constexpr int I_PLE = 4 * 32, I_GATE = 16 * 32;
        bf16_t* wple = (bf16_t*)(ws + (l ? WS_WPLE1 : WS_WPLE0)); bf16_t* wgate = (bf16_t*)(ws + (l ? WS_WGATE1 : WS_WGATE0));
        for (int it = gw; it < I_PLE + I_GATE; it += NGW) {
            int r = it;
            if (r < I_PLE) { tr_item(p.in[21] + (size_t)l * PLE * DM, PLE, DM, wple, nullptr, false, scr, r, 32, lane); continue; } r -= I_PLE;
            tr_item(p.in[22] + (size_t)l * DM * DM, DM, DM, wgate, p.in[20] + l * DM, false, scr, r, 32, lane);
        }
        const f32x4* src = (const f32x4*)(p.in[1] + (size_t)l * M * PLE); u32x2* dst = (u32x2*)(ws + (l ? WS_PB1 : WS_PB0));
        const int gt = gw * 64 + lane, NT = NGW * 64;
        for (int i = gt; i < M * PLE / 4; i += NT) { const f32x4 v = src[i]; u32x2 o; o.x = pk2(v[0], v[1]); o.y = pk2(v[2], v[3]); dst[i] = o; }
    }
}

DI void prologue(const Params& p, int gw, int NGW, int lane) {
    unsigned char* ws = p.ws;
    const int gt = gw * 64 + lane, NT = NGW * 64;
    float* ss = (float*)(ws + WS_SS);
    for (int i = gt; i < 6 * M; i += NT) ss[M + i] = 0.f;
    float* tab = (float*)(ws + WS_TAB);
    for (int idx = gt; idx < 2 * SEQ * 32; idx += NT) {
        const int t = idx / (SEQ * 32), e = idx % (SEQ * 32), pos = e >> 5, i = e & 31;
        const double base = t ? 0.7429639507594948 : 0.7498942093324559;
        double a = 1.0;
        for (int k = 0; k < 31; ++k) a = (k < i) ? a * base : a;
        const double ang = (double)pos * a;
        const double kk = rint(ang * 0.15915494309189535);
        const double r = ang - kk * 6.283185307179586477;
        const double r2 = r * r; double s = r, c = 1.0, ts = r, tc = 1.0;
        for (int n = 1; n <= 14; ++n) { tc *= -r2 / (double)((2 * n - 1) * (2 * n)); c += tc; ts *= -r2 / (double)((2 * n) * (2 * n + 1)); s += ts; }
        tab[(size_t)(2 * t) * SEQ * 32 + e] = (float)c; tab[(size_t)(2 * t + 1) * SEQ * 32 + e] = (float)s;
    }
    const float* x = p.in[0]; bf16_t* xb = (bf16_t*)(ws + WS_XB);
    for (int m = gw; m < M; m += NGW) {
        const f32x4* xr = (const f32x4*)(x + (size_t)m * DM) + lane; f32x4 v[4]; float s = 0.f;
#pragma unroll
        for (int j = 0; j < 4; ++j) { v[j] = xr[64 * j]; s += (v[j][0] * v[j][0] + v[j][1] * v[j][1]) + (v[j][2] * v[j][2] + v[j][3] * v[j][3]); }
        s = wave_sum(s);
        if (lane == 0) ss[m] = s;
        u32x2* o = (u32x2*)(xb + (size_t)m * DM) + lane;
#pragma unroll
        for (int j = 0; j < 4; ++j) { u32x2 w; w.x = pk2(v[j][0], v[j][1]); w.y = pk2(v[j][2], v[j][3]); o[64 * j] = w; }
    }
}

DI void e1_tokens(const Params& p, int l, int tok_lo, int tok_hi, int lane) {
    bf16_t* proj = (bf16_t*)(p.ws + WS_PROJ); const float* tab = (const float*)(p.ws + WS_TAB);
    const int sub = lane >> 5, l5 = lane & 31, which = l5 >> 2, hq = which & 3, isk = which >> 2, i0 = (l5 & 3) * 8;
    const int col = (sub == 0 ? (isk ? AK : AQ) : (isk ? CK : CQ)) + hq * 64;
    const float* gain = (isk ? p.in[5] : p.in[4]) + l * 64;
    const float sc = ((sub == 0 && !isk) || (sub == 1 && isk)) ? 0.125f : 1.0f;
    const float* ct = tab + (size_t)(2 * sub) * SEQ * 32; const float* st = tab + (size_t)(2 * sub + 1) * SEQ * 32;
    for (int tok = tok_lo; tok < tok_hi; ++tok) {
        const int pos = tok & (SEQ - 1);
        bf16_t* ptr = proj + (size_t)tok * PP + col;
        float x1[8], x2[8];
        unpack8(*(const u32x4*)(ptr + i0), x1); unpack8(*(const u32x4*)(ptr + 32 + i0), x2);
        float s2 = 0.f;
#pragma unroll
        for (int i = 0; i < 8; ++i) s2 += x1[i] * x1[i] + x2[i] * x2[i];
        s2 += __shfl_xor(s2, 1); s2 += __shfl_xor(s2, 2);
        if (sub == 0) { const float r = rsqrtf(s2 * (1.0f / 64.0f) + EPS);
#pragma unroll
            for (int i = 0; i < 8; ++i) { x1[i] *= r * gain[i0 + i]; x2[i] *= r * gain[32 + i0 + i]; } }
        float o1[8], o2[8];
#pragma unroll
        for (int i = 0; i < 8; ++i) { const float c = ct[pos * 32 + i0 + i], s = st[pos * 32 + i0 + i]; o1[i] = (x1[i] * c - x2[i] * s) * sc; o2[i] = (x2[i] * c + x1[i] * s) * sc; }
        u32x4 w1, w2; w1.x = pk2(o1[0], o1[1]); w1.y = pk2(o1[2], o1[3]); w1.z = pk2(o1[4], o1[5]); w1.w = pk2(o1[6], o1[7]);
        w2.x = pk2(o2[0], o2[1]); w2.y = pk2(o2[2], o2[3]); w2.z = pk2(o2[4], o2[5]); w2.w = pk2(o2[6], o2[7]);
        *(u32x4*)(ptr + i0) = w1; *(u32x4*)(ptr + 32 + i0) = w2;
        bf16_t* vp = proj + (size_t)tok * PP + DV + lane * 4; const bf16_t* gp = proj + (size_t)tok * PP + DG + lane * 4;
        const u32x2 vw = *(const u32x2*)vp, gwd = *(const u32x2*)gp;
        u32x2 o; o.x = pk2(lo16(vw.x) * sigm_f(lo16(gwd.x)), hi16(vw.x) * sigm_f(hi16(gwd.x))); o.y = pk2(lo16(vw.y) * sigm_f(lo16(gwd.y)), hi16(vw.y) * sigm_f(hi16(gwd.y)));
        *(u32x2*)vp = o;
    }
}


DI void e1_tile(const Params& p, int l, int tile, LAS unsigned char* lds, int tid, int wave, int lane) {
    const int T0 = tile * 64; const int b = T0 >> 12, s0 = T0 & (SEQ - 1);
    LAS bf16_t* Vs = (LAS bf16_t*)lds;
    const bf16_t* proj = (const bf16_t*)(p.ws + WS_PROJ);
    for (int e = tid; e < 64 * 32; e += NTHR) { const int j = e >> 5, c8 = (e & 31) * 8;
        *(LAS u32x4*)(Vs + j * 264 + c8) = *(const u32x4*)(proj + (size_t)(T0 + j) * PP + AV + c8); }
    e1_tokens(p, l, T0 + wave * 8, T0 + wave * 8 + 8, lane);
    __syncthreads();
    bf16_t* vt = (bf16_t*)(p.ws + WS_VT);
    const int col = tid & 255, half = tid >> 8, h = col >> 6, dim = col & 63;
    {
      bf16_t* dst = vt + ((size_t)((b * 4 + h) * 64 + dim)) * SEQ + s0 + half * 32;
#pragma unroll
      for (int c8 = 0; c8 < 32; c8 += 8) { u32x4 w; const LAS bf16_t* s = Vs + (half * 32 + c8) * 264 + col;
          w.x = (unsigned)s[0] | ((unsigned)s[264] << 16); w.y = (unsigned)s[2 * 264] | ((unsigned)s[3 * 264] << 16); w.z = (unsigned)s[4 * 264] | ((unsigned)s[5 * 264] << 16); w.w = (unsigned)s[6 * 264] | ((unsigned)s[7 * 264] << 16);
          *(u32x4*)(dst + c8) = w; } }
    {
      bf16_t* base = vt + (size_t)4 * 1024 * 1024;
#pragma unroll
      for (int r = 0; r < 4; ++r) { const LAS bf16_t* s = Vs + (half * 32 + r) * 264 + col; u32x4 w;
          w.x = (unsigned)s[0] | ((unsigned)s[4 * 264] << 16); w.y = (unsigned)s[8 * 264] | ((unsigned)s[12 * 264] << 16); w.z = (unsigned)s[16 * 264] | ((unsigned)s[20 * 264] << 16); w.w = (unsigned)s[24 * 264] | ((unsigned)s[28 * 264] << 16);
          *(u32x4*)(base + ((size_t)(((b * 4 + h) * 4 + r) * 64 + dim)) * 1024 + (s0 >> 2) + half * 8) = w; } }
    {
      bf16_t* base = vt + (size_t)8 * 1024 * 1024;
#pragma unroll
      for (int r = 0; r < 16; ++r) { const LAS bf16_t* s = Vs + (half * 32 + r) * 264 + col;
          const unsigned w = (unsigned)s[0] | ((unsigned)s[16 * 264] << 16);
          *(unsigned*)(base + ((size_t)(((b * 4 + h) * 16 + r) * 64 + dim)) * 256 + (s0 >> 4) + half * 2) = w; } }
    __syncthreads();
}

typedef short bf16x8_t __attribute__((ext_vector_type(8)));
DI void attn_tile(const Params& p, int b, int h, int pat, int r, int i0, int lane) {
    const int dsh = 2 * pat, L = SEQ >> dsh;
    const int fr = lane & 15, quad = lane >> 4;
    const bf16_t* projb = (const bf16_t*)(p.ws + WS_PROJ) + (size_t)(b * SEQ) * PP + h * 64 + quad * 8;
    const int tq = ((i0 + fr) << dsh) + r;
    bf16x8_t qf[2];
    qf[0] = *(const bf16x8_t*)(projb + (size_t)tq * PP + AQ); qf[1] = *(const bf16x8_t*)(projb + (size_t)tq * PP + AQ + 32);
    f32x4 acc[5][2];
#pragma unroll
    for (int s = 0; s < 5; ++s)
#pragma unroll
        for (int u = 0; u < 2; ++u) {
            const int krel = 32 * s + 8 * (fr >> 2) + 4 * u + (fr & 3);
            int kap = i0 - 128 + krel; kap = kap < 0 ? 0 : (kap > L - 1 ? L - 1 : kap);
            const bf16_t* kp = projb + (size_t)((kap << dsh) + r) * PP + AK;
            const bf16x8_t k0 = *(const bf16x8_t*)kp, k1 = *(const bf16x8_t*)(kp + 32);
            f32x4 a = (f32x4){0.f, 0.f, 0.f, 0.f};
            a = __builtin_amdgcn_mfma_f32_16x16x32_bf16(k0, qf[0], a, 0, 0, 0);
            a = __builtin_amdgcn_mfma_f32_16x16x32_bf16(k1, qf[1], a, 0, 0, 0);
            acc[s][u] = a; }
    float mx = -INFINITY;
#pragma unroll
    for (int s = 0; s < 5; ++s)
#pragma unroll
        for (int u = 0; u < 2; ++u)
#pragma unroll
            for (int j = 0; j < 4; ++j) { const int k = 32 * s + 8 * quad + 4 * u + j; const bool valid = (k >= fr) && (k <= 128 + fr) && (i0 - 128 + k >= 0);
                const float v = valid ? acc[s][u][j] : -INFINITY; acc[s][u][j] = v; mx = fmaxf(mx, v); }
    mx = fmaxf(mx, __shfl_xor(mx, 16)); mx = fmaxf(mx, __shfl_xor(mx, 32));
    float sum = 0.f; bf16x8_t pb[5];
#pragma unroll
    for (int s = 0; s < 5; ++s) { float e[8];
#pragma unroll
        for (int u = 0; u < 2; ++u)
#pragma unroll
            for (int j = 0; j < 4; ++j) { const float v = acc[s][u][j]; const float ev = (v == -INFINITY) ? 0.f : __expf(v - mx); e[u * 4 + j] = ev; sum += ev; }
        u32x4 w; w.x = pk2(e[0], e[1]); w.y = pk2(e[2], e[3]); w.z = pk2(e[4], e[5]); w.w = pk2(e[6], e[7]); pb[s] = __builtin_bit_cast(bf16x8_t, w); }
    sum += __shfl_xor(sum, 16); sum += __shfl_xor(sum, 32);
    const bf16_t* vtb = (const bf16_t*)(p.ws + WS_VT) + (size_t)pat * 4 * 1024 * 1024 + ((size_t)((((b * 4 + h) << dsh) + r) * 64 + fr)) * L;
    f32x4 o[4];
#pragma unroll
    for (int dt = 0; dt < 4; ++dt) o[dt] = (f32x4){0.f, 0.f, 0.f, 0.f};
#pragma unroll
    for (int s = 0; s < 5; ++s) { int st = i0 - 128 + 32 * s + 8 * quad; st = st < 0 ? 0 : (st > L - 8 ? L - 8 : st);
#pragma unroll
        for (int dt = 0; dt < 4; ++dt) { const bf16x8_t vf = *(const bf16x8_t*)(vtb + (size_t)(dt * 16) * L + st);
            o[dt] = __builtin_amdgcn_mfma_f32_16x16x32_bf16(vf, pb[s], o[dt], 0, 0, 0); } }
    const float inv = 1.0f / sum; const size_t tok = (size_t)(b * SEQ + tq);
    bf16_t* yo = (bf16_t*)(p.ws + WS_YCAT) + tok * DM + pat * 256 + h * 64 + quad * 4;
#pragma unroll
    for (int dt = 0; dt < 4; ++dt) { u32x2 w; w.x = pk2(o[dt][0] * inv, o[dt][1] * inv); w.y = pk2(o[dt][2] * inv, o[dt][3] * inv); *(u32x2*)(yo + dt * 16) = w; }
    if (quad == 0) ((float*)(p.ws + WS_LSE))[((size_t)pat * M + tok) * 4 + h] = mx + __logf(sum);
}
DI void attn_combine(const Params& p, int gt, int NT) {
    bf16_t* yc = (bf16_t*)(p.ws + WS_YCAT); const float* lse = (const float*)(p.ws + WS_LSE);
    for (int i = gt; i < M * 32; i += NT) { const int tok = i >> 5, c8 = (i & 31) * 8, h = c8 >> 6;
        const float l0 = lse[((size_t)0 * M + tok) * 4 + h], l1 = lse[((size_t)1 * M + tok) * 4 + h], l2 = lse[((size_t)2 * M + tok) * 4 + h];
        const float mm = fmaxf(l0, fmaxf(l1, l2)); float w0 = __expf(l0 - mm), w1 = __expf(l1 - mm), w2 = __expf(l2 - mm); const float iz = 1.0f / (w0 + w1 + w2); w0 *= iz; w1 *= iz; w2 *= iz;
        bf16_t* pp = yc + (size_t)tok * DM + c8; float a[8], bq[8], c[8];
        unpack8(*(const u32x4*)pp, a); unpack8(*(const u32x4*)(pp + 256), bq); unpack8(*(const u32x4*)(pp + 512), c);
        u32x4 w; w.x = pk2(w0 * a[0] + w1 * bq[0] + w2 * c[0], w0 * a[1] + w1 * bq[1] + w2 * c[1]); w.y = pk2(w0 * a[2] + w1 * bq[2] + w2 * c[2], w0 * a[3] + w1 * bq[3] + w2 * c[3]);
        w.z = pk2(w0 * a[4] + w1 * bq[4] + w2 * c[4], w0 * a[5] + w1 * bq[5] + w2 * c[5]); w.w = pk2(w0 * a[6] + w1 * bq[6] + w2 * c[6], w0 * a[7] + w1 * bq[7] + w2 * c[7]);
        *(u32x4*)pp = w; }
}

template <int NC, int K> DI void nt_acc(float (&acc)[NC], const LAS bf16_t* Ap, const LAS bf16_t* Bp, int ldb) {
    for (int k = 0; k < K; k += 8) {
        float a[8]; unpack8(*(const LAS u32x4*)(Ap + k), a);
#pragma unroll
        for (int c = 0; c < NC; ++c) { float b[8]; unpack8(*(const LAS u32x4*)(Bp + c * ldb + k), b);
            acc[c] += (a[0] * b[0] + a[1] * b[1]) + (a[2] * b[2] + a[3] * b[3]) + (a[4] * b[4] + a[5] * b[5]) + (a[6] * b[6] + a[7] * b[7]); }
    }
}
template <int NC> DI void axpy_row(float (&acc)[NC], float coef, const LAS bf16_t* Bp) {
#pragma unroll
    for (int c8 = 0; c8 < NC; c8 += 8) { float b[8]; unpack8(*(const LAS u32x4*)(Bp + c8), b);
#pragma unroll
        for (int e = 0; e < 8; ++e) acc[c8 + e] += coef * b[e]; }
}

DI void ssd_dt_acum(const Params& p, int l, int tok0, int g, LAS float* dts, LAS float* acs, int wave, int lane) {
    if (wave < 2) {
        const int h = 2 * g + wave; const bf16_t* proj = (const bf16_t*)(p.ws + WS_PROJ);
        const float bias = p.in[8][l * 4 + h], a = -__expf(p.in[9][l * 4 + h]);
        float d[2];
#pragma unroll
        for (int e = 0; e < 2; ++e) { const float raw = bf2f(proj[(size_t)(tok0 + 2 * lane + e) * PP + BDT + h]) + bias; d[e] = raw > 20.f ? raw : log1pf(__expf(raw)); }
        const float v0 = d[0] * a, v1 = d[1] * a; float s = v0 + v1;
#pragma unroll
        for (int off = 1; off < 64; off <<= 1) { const float t = __shfl_up(s, off); if (lane >= off) s += t; }
        dts[wave * 128 + 2 * lane] = d[0]; dts[wave * 128 + 2 * lane + 1] = d[1];
        acs[wave * 128 + 2 * lane] = s - v1; acs[wave * 128 + 2 * lane + 1] = s;
    }
}
DI void stage_conv(const Params& p, int l, LAS bf16_t* dst, int ld, int tok0, int seqpos0, int choff, int tid) {
    const bf16_t* src = (const bf16_t*)(p.ws + WS_PROJ) + (size_t)tok0 * PP + BX + choff;
    const float* cw = p.in[6] + (size_t)l * 4 * 768 + choff; const float* cb = p.in[7] + l * 768 + choff;
    for (int e = tid; e < 128 * 128; e += NTHR) { const int j = e >> 7, ch = e & 127;
        float v = cb[ch];
#pragma unroll
        for (int k = 0; k < 4; ++k) { const int s = j - 3 + k; if (seqpos0 + s >= 0) v += cw[k * 768 + ch] * bf2f(src[(long)s * PP + ch]); }
        dst[j * ld + ch] = (bf16_t)f2bf(silu_f(v)); }
}

DI void ssd_states_unit(const Params& p, int l, int b, int c, int g, LAS unsigned char* lds, int tid, int wave, int lane) {
    LAS bf16_t* Xs = (LAS bf16_t*)lds; LAS bf16_t* Bs = Xs + 128 * 136;
    LAS float* dts = (LAS float*)(Bs + 128 * 136); LAS float* acs = dts + 256; LAS float* wsc = acs + 256;
    const int tok0 = b * SEQ + c * 128;
    ssd_dt_acum(p, l, tok0, g, dts, acs, wave, lane);
    stage_conv(p, l, Xs, 136, tok0, c * 128, g * 128, tid);
    stage_conv(p, l, Bs, 136, tok0, c * 128, 256 + g * 128, tid);
    __syncthreads();
    if (tid < 256) { const int hh = tid >> 7, j = tid & 127; wsc[tid] = __expf(acs[hh * 128 + 127] - acs[hh * 128 + j]) * dts[hh * 128 + j]; }
    if (tid < 2) ((float*)(p.ws + WS_CDEC))[(b * 32 + c) * 4 + 2 * g + tid] = __expf(acs[tid * 128 + 127]);
    __syncthreads();
    const int r = tid >> 2, q = tid & 3, hh = r >> 6;
    float acc[32];
#pragma unroll
    for (int i = 0; i < 32; ++i) acc[i] = 0.f;
    for (int j = 0; j < 128; ++j) { const float coef = bf2f(Xs[j * 136 + r]) * wsc[hh * 128 + j]; axpy_row<32>(acc, coef, Bs + j * 136 + q * 32); }
    float* dst = (float*)(p.ws + WS_SST) + ((size_t)((b * 32 + c) * 4 + 2 * g + hh)) * 8192 + (r & 63) * 128 + q * 32;
#pragma unroll
    for (int i = 0; i < 32; i += 4) *(f32x4*)(dst + i) = (f32x4){acc[i], acc[i + 1], acc[i + 2], acc[i + 3]};
    __syncthreads();
}

DI void ret_states_unit(const Params& p, int b, int c, LAS unsigned char* lds, int tid) {
    LAS bf16_t* Ks = (LAS bf16_t*)lds; LAS bf16_t* Vs = Ks + 128 * 264;
    const int tok0 = b * SEQ + c * 128; const bf16_t* proj = (const bf16_t*)(p.ws + WS_PROJ);
    for (int e = tid; e < 128 * 32; e += NTHR) { const int j = e >> 5, c8 = (e & 31) * 8;
        *(LAS u32x4*)(Ks + j * 264 + c8) = *(const u32x4*)(proj + (size_t)(tok0 + j) * PP + CK + c8);
        *(LAS u32x4*)(Vs + j * 264 + c8) = *(const u32x4*)(proj + (size_t)(tok0 + j) * PP + CV + c8); }
    __syncthreads();
    const int h = tid >> 7, d = (tid >> 1) & 63, eh = tid & 1;
    const float lg = log2f(1.0f - exp2f(-5.0f - (float)h));
    float acc[32];
#pragma unroll
    for (int i = 0; i < 32; ++i) acc[i] = 0.f;
    for (int j = 0; j < 128; ++j) { const float coef = bf2f(Ks[j * 264 + h * 64 + d]) * exp2f((float)(127 - j) * lg); axpy_row<32>(acc, coef, Vs + j * 264 + h * 64 + eh * 32); }
    float* dst = (float*)(p.ws + WS_RST) + ((size_t)((b * 32 + c) * 4 + h)) * 4096 + d * 64 + eh * 32;
#pragma unroll
    for (int i = 0; i < 32; i += 4) *(f32x4*)(dst + i) = (f32x4){acc[i], acc[i + 1], acc[i + 2], acc[i + 3]};
    __syncthreads();
}

DI void conv_unit(const Params& p, int l, int b, int s0, LAS unsigned char* lds, int tid, int wave, int lane) {
    LAS bf16_t* Hs = (LAS bf16_t*)lds;
    LAS float* Os = (LAS float*)(lds + 94 * 256 * 2);
    const bf16_t* proj = (const bf16_t*)(p.ws + WS_PROJ);
    for (int e = tid; e < 94 * 32; e += NTHR) { const int r = e >> 5, c8 = (e & 31) * 8; const int s = s0 - 30 + r;
        u32x4 v = (u32x4){0u, 0u, 0u, 0u};
        if (s >= 0) v = *(const u32x4*)(proj + (size_t)(b * SEQ + s) * PP + DV + c8);
        *(LAS u32x4*)(Hs + r * 256 + c8) = v; }
    __syncthreads();
    { const int ch = tid & 255, half = tid >> 8;
      const float* w = p.in[12] + (size_t)l * 31 * 256 + ch; const float bias = p.in[13][l * 256 + ch];
      float wr[31];
#pragma unroll
      for (int k = 0; k < 31; ++k) wr[k] = w[k * 256];
      for (int tt = 0; tt < 32; ++tt) { const int t = half * 32 + tt; float a = bias;
#pragma unroll
          for (int k = 0; k < 31; ++k) a += wr[k] * bf2f(Hs[(t + k) * 256 + ch]);
          Os[t * 256 + ch] = a; } }
    __syncthreads();
    const f32x4 lg = *(const f32x4*)(p.in[14] + l * 256 + lane * 4), lb = *(const f32x4*)(p.in[15] + l * 256 + lane * 4);
    bf16_t* ycat = (bf16_t*)(p.ws + WS_YCAT);
    for (int tt = 0; tt < 8; ++tt) { const int t = wave * 8 + tt; const f32x4 v = *(const LAS f32x4*)(Os + t * 256 + lane * 4);
        const float mean = wave_sum((v[0] + v[1]) + (v[2] + v[3])) * (1.0f / 256.0f);
        const f32x4 d = v - mean; const float var = wave_sum((d[0] * d[0] + d[1] * d[1]) + (d[2] * d[2] + d[3] * d[3])) * (1.0f / 256.0f);
        const float rs = rsqrtf(var + EPS); f32x4 o = d * rs * lg + lb;
        u32x2 w; w.x = pk2(silu_f(o[0]), silu_f(o[1])); w.y = pk2(silu_f(o[2]), silu_f(o[3]));
        *(u32x2*)(ycat + (size_t)(b * SEQ + s0 + t) * DM + 768 + lane * 4) = w; }
    __syncthreads();
}

DI void attn_task(const Params& p, int tok, int hd, int lane, LAS float* qs) {
    const bf16_t* proj = (const bf16_t*)(p.ws + WS_PROJ);
    const int pos = tok & (SEQ - 1); const size_t rowbase = (size_t)(tok - pos);
    qs[lane] = bf2f(proj[(size_t)tok * PP + AQ + hd * 64 + lane]);
    float sc[7];
#pragma unroll
    for (int ps = 0; ps < 7; ++ps) { const int e = ps * 64 + lane; const int pat = e / 129, j = e - pat * 129; const int kp = pos - (j << (2 * pat));
        const bool valid = (e < 387) && (kp >= 0); float s = 0.f;
        if (valid) { const u32x4* kr = (const u32x4*)(proj + (rowbase + kp) * PP + AK + hd * 64);
#pragma unroll
            for (int c = 0; c < 8; ++c) { float kf[8]; unpack8(kr[c], kf); const f32x4 q0 = *(const LAS f32x4*)(qs + c * 8), q1 = *(const LAS f32x4*)(qs + c * 8 + 4);
                s += (q0[0] * kf[0] + q0[1] * kf[1]) + (q0[2] * kf[2] + q0[3] * kf[3]) + (q1[0] * kf[4] + q1[1] * kf[5]) + (q1[2] * kf[6] + q1[3] * kf[7]); } }
        sc[ps] = valid ? s : -INFINITY; }
    float mx = sc[0];
#pragma unroll
    for (int ps = 1; ps < 7; ++ps) mx = fmaxf(mx, sc[ps]);
    mx = wave_max(mx);
    float z = 0.f; int pr[7];
#pragma unroll
    for (int ps = 0; ps < 7; ++ps) { const float e = (sc[ps] == -INFINITY) ? 0.f : __expf(sc[ps] - mx); z += e; pr[ps] = __float_as_int(e); }
    z = wave_sum(z);
    float o = 0.f;
    const bf16_t* vb = proj + rowbase * PP + AV + hd * 64 + lane;
#pragma unroll
    for (int ps = 0; ps < 7; ++ps) {
        const int nl = ps == 6 ? 3 : 64;
#pragma unroll 8
        for (int ln = 0; ln < nl; ++ln) { const int e = ps * 64 + ln; const int pat = e / 129, j = e - pat * 129; int kp = pos - (j << (2 * pat));
            const bool ok = kp >= 0; kp = ok ? kp : pos;
            const float pe = ok ? __int_as_float(__builtin_amdgcn_readlane(pr[ps], ln)) : 0.f;
            o += pe * bf2f(vb[(size_t)kp * PP]); } }
    ((bf16_t*)(p.ws + WS_YCAT))[(size_t)tok * DM + hd * 64 + lane] = (bf16_t)f2bf(o / z);
}

DI void scan_phase(const Params& p, int gt, int NT) {
    float* sst = (float*)(p.ws + WS_SST); const float* cdec = (const float*)(p.ws + WS_CDEC);
    for (int i = gt; i < NB * 4 * 8192; i += NT) { const int b = i >> 15, rem = i & 32767, h = rem >> 13, pn = rem & 8191; float run = 0.f;
#pragma unroll 8
        for (int c = 0; c < 32; ++c) { const size_t idx = ((size_t)((b * 32 + c) * 4 + h)) * 8192 + pn; const float st = sst[idx]; sst[idx] = run; run = cdec[(b * 32 + c) * 4 + h] * run + st; } }
    float* rst = (float*)(p.ws + WS_RST);
    for (int i = gt; i < NB * 4 * 4096; i += NT) { const int b = i >> 14, rem = i & 16383, h = rem >> 12, de = rem & 4095; float run = 0.f;
        const float gc = exp2f(128.0f * log2f(1.0f - exp2f(-5.0f - (float)h)));
#pragma unroll 8
        for (int c = 0; c < 32; ++c) { const size_t idx = ((size_t)((b * 32 + c) * 4 + h)) * 4096 + de; const float st = rst[idx]; rst[idx] = run; run = gc * run + st; } }
}

DI void ssd_y_unit(const Params& p, int l, int b, int c, int g, LAS unsigned char* lds, int tid, int wave, int lane) {
    LAS bf16_t* Cs = (LAS bf16_t*)lds; LAS bf16_t* Bs = Cs + 128 * 136;
    LAS float* CB = (LAS float*)(Bs + 128 * 136); LAS bf16_t* Pv = (LAS bf16_t*)CB;
    LAS float* dts = CB + 128 * 132; LAS float* acs = dts + 256;
    const int tok0 = b * SEQ + c * 128; const bf16_t* proj = (const bf16_t*)(p.ws + WS_PROJ);
    ssd_dt_acum(p, l, tok0, g, dts, acs, wave, lane);
    stage_conv(p, l, Cs, 136, tok0, c * 128, 512 + g * 128, tid);
    { const float* prev = (const float*)(p.ws + WS_SST) + ((size_t)((b * 32 + c) * 4 + 2 * g)) * 8192;
      for (int e = tid; e < 128 * 32; e += NTHR) { const int r = e >> 5, n4 = (e & 31) * 4; const f32x4 v = *(const f32x4*)(prev + r * 128 + n4);
          u32x2 w; w.x = pk2(v[0], v[1]); w.y = pk2(v[2], v[3]); *(LAS u32x2*)(Pv + r * 136 + (r >> 5) * 8 + n4) = w; } }
    __syncthreads();
    const int i = tid >> 2, q = tid & 3, hh = q >> 1;
    float y[32];
#pragma unroll
    for (int cc = 0; cc < 32; ++cc) y[cc] = 0.f;
    nt_acc<32, 128>(y, Cs + i * 136, Pv + (q * 32) * 136 + q * 8, 136);
    { const float ea = __expf(acs[hh * 128 + i]);
#pragma unroll
      for (int cc = 0; cc < 32; ++cc) y[cc] *= ea; }
    __syncthreads();
    stage_conv(p, l, Bs, 136, tok0, c * 128, 256 + g * 128, tid);
    __syncthreads();
    { float cb[32];
#pragma unroll
      for (int cc = 0; cc < 32; ++cc) cb[cc] = 0.f;
      nt_acc<32, 128>(cb, Cs + i * 136, Bs + q * 136, 4 * 136);
#pragma unroll
      for (int cc = 0; cc < 32; ++cc) CB[i * 132 + cc * 4 + q] = cb[cc]; }
    __syncthreads();
    stage_conv(p, l, Bs, 136, tok0, c * 128, g * 128, tid);
    __syncthreads();
    { const float ai = acs[hh * 128 + i]; const int jmax = wave * 16 + 15;
      for (int j = 0; j <= jmax; ++j) { const float m = (j <= i) ? CB[i * 132 + j] * __expf(ai - acs[hh * 128 + j]) * dts[hh * 128 + j] : 0.f; axpy_row<32>(y, m, Bs + j * 136 + q * 32); } }
    { const int head = 2 * g + hh; const float dsk = p.in[10][l * 4 + head]; float xs[32];
#pragma unroll
      for (int c8 = 0; c8 < 32; c8 += 8) { float t8[8]; unpack8(*(const LAS u32x4*)(Bs + i * 136 + q * 32 + c8), t8);
#pragma unroll
          for (int e = 0; e < 8; ++e) xs[c8 + e] = t8[e]; }
      const bf16_t* zp = proj + (size_t)(tok0 + i) * PP + BZ + g * 128 + q * 32; float s2 = 0.f;
#pragma unroll
      for (int c8 = 0; c8 < 32; c8 += 8) { float z8[8]; unpack8(*(const u32x4*)(zp + c8), z8);
#pragma unroll
          for (int e = 0; e < 8; ++e) { const float v = (y[c8 + e] + dsk * xs[c8 + e]) * silu_f(z8[e]); y[c8 + e] = v; s2 += v * v; } }
      s2 += __shfl_xor(s2, 1); s2 += __shfl_xor(s2, 2);
      const float rs = rsqrtf(s2 * (1.0f / 128.0f) + EPS);
      const float* ng = p.in[11] + l * 256 + g * 128 + q * 32;
      bf16_t* yo = (bf16_t*)(p.ws + WS_YCAT) + (size_t)(tok0 + i) * DM + 256 + g * 128 + q * 32;
#pragma unroll
      for (int c8 = 0; c8 < 32; c8 += 8) { u32x4 w; w.x = pk2(y[c8] * rs * ng[c8], y[c8 + 1] * rs * ng[c8 + 1]); w.y = pk2(y[c8 + 2] * rs * ng[c8 + 2], y[c8 + 3] * rs * ng[c8 + 3]);
          w.z = pk2(y[c8 + 4] * rs * ng[c8 + 4], y[c8 + 5] * rs * ng[c8 + 5]); w.w = pk2(y[c8 + 6] * rs * ng[c8 + 6], y[c8 + 7] * rs * ng[c8 + 7]); *(u32x4*)(yo + c8) = w; } }
    __syncthreads();
}

DI void ret_y_unit(const Params& p, int b, int c, int h, LAS unsigned char* lds, int tid, int wave) {
    LAS bf16_t* Qs = (LAS bf16_t*)lds; LAS bf16_t* Ks = Qs + 128 * 72; LAS bf16_t* Vs = Ks + 128 * 72;
    LAS float* Pr = (LAS float*)(Vs + 128 * 72); LAS float* S = Pr + 64 * 64;
    const int tok0 = b * SEQ + c * 128; const bf16_t* proj = (const bf16_t*)(p.ws + WS_PROJ);
    for (int e = tid; e < 128 * 8; e += NTHR) { const int j = e >> 3, c8 = (e & 7) * 8; const bf16_t* rp = proj + (size_t)(tok0 + j) * PP + h * 64 + c8;
        *(LAS u32x4*)(Qs + j * 72 + c8) = *(const u32x4*)(rp + CQ); *(LAS u32x4*)(Ks + j * 72 + c8) = *(const u32x4*)(rp + CK); *(LAS u32x4*)(Vs + j * 72 + c8) = *(const u32x4*)(rp + CV); }
    { const float* prev = (const float*)(p.ws + WS_RST) + ((size_t)((b * 32 + c) * 4 + h)) * 4096;
      for (int e = tid; e < 1024; e += NTHR) *(LAS f32x4*)(Pr + e * 4) = *(const f32x4*)(prev + e * 4); }
    __syncthreads();
    const int i = tid >> 2, q = tid & 3; const float lg = log2f(1.0f - exp2f(-5.0f - (float)h));
    { float s[32];
#pragma unroll
      for (int cc = 0; cc < 32; ++cc) s[cc] = 0.f;
      nt_acc<32, 64>(s, Qs + i * 72, Ks + q * 72, 4 * 72);
#pragma unroll
      for (int cc = 0; cc < 32; ++cc) { const int j = cc * 4 + q; S[i * 132 + j] = (j <= i) ? s[cc] * exp2f((float)(i - j) * lg) : 0.f; } }
    __syncthreads();
    float y[16];
#pragma unroll
    for (int cc = 0; cc < 16; ++cc) y[cc] = 0.f;
    for (int d = 0; d < 64; ++d) { const float qv = bf2f(Qs[i * 72 + d]);
#pragma unroll
        for (int c4 = 0; c4 < 16; c4 += 4) { const f32x4 pv = *(const LAS f32x4*)(Pr + d * 64 + q * 16 + c4); y[c4] += qv * pv[0]; y[c4 + 1] += qv * pv[1]; y[c4 + 2] += qv * pv[2]; y[c4 + 3] += qv * pv[3]; } }
    { const float xi = exp2f((float)(i + 1) * lg);
#pragma unroll
      for (int cc = 0; cc < 16; ++cc) y[cc] *= xi; }
    { const int jmax = wave * 16 + 15;
      for (int j = 0; j <= jmax; ++j) axpy_row<16>(y, S[i * 132 + j], Vs + j * 72 + q * 16); }
    float s2 = 0.f;
#pragma unroll
    for (int cc = 0; cc < 16; ++cc) s2 += y[cc] * y[cc];
    s2 += __shfl_xor(s2, 1); s2 += __shfl_xor(s2, 2);
    const float rs = rsqrtf(s2 * (1.0f / 64.0f) + EPS);
    const bf16_t* gp = proj + (size_t)(tok0 + i) * PP + CG + h * 64 + q * 16;
    bf16_t* yo = (bf16_t*)(p.ws + WS_YCAT) + (size_t)(tok0 + i) * DM + 512 + h * 64 + q * 16;
#pragma unroll
    for (int c8 = 0; c8 < 16; c8 += 8) { float g8[8]; unpack8(*(const u32x4*)(gp + c8), g8); u32x4 w;
        w.x = pk2(y[c8] * rs * silu_f(g8[0]), y[c8 + 1] * rs * silu_f(g8[1])); w.y = pk2(y[c8 + 2] * rs * silu_f(g8[2]), y[c8 + 3] * rs * silu_f(g8[3]));
        w.z = pk2(y[c8 + 4] * rs * silu_f(g8[4]), y[c8 + 5] * rs * silu_f(g8[5])); w.w = pk2(y[c8 + 6] * rs * silu_f(g8[6]), y[c8 + 7] * rs * silu_f(g8[7])); *(u32x4*)(yo + c8) = w; }
    __syncthreads();
}

#define SSB ((float*)(ws + WS_SS))
#define XB ((bf16_t*)(ws + WS_XB))
#define YC ((bf16_t*)(ws + WS_YCAT))
#define PROJ ((bf16_t*)(ws + WS_PROJ))
#define HB ((bf16_t*)(ws + WS_H))
#define PE ((bf16_t*)(ws + WS_PE))

#define CAS4 __attribute__((address_space(4)))
#define RELOAD_P() const CAS4 Params* kp_ = (const CAS4 Params*)__builtin_amdgcn_kernarg_segment_ptr(); asm volatile("" : "+s"(kp_)); const Params& p = *(const Params*)kp_; unsigned char* ws = p.ws; (void)ws
#define FRESH_LANE(v) int v; asm volatile("v_mbcnt_lo_u32_b32 %0, -1, 0\n\tv_mbcnt_hi_u32_b32 %0, -1, %0" : "=v"(v))
#define RELOAD_IDS() RELOAD_P(); FRESH_LANE(lane_); const int lane = lane_, wave = wave_s, tid = wave_s * 64 + lane_; const int gw = blk * NWV + wave, gt = blk * NTHR + tid; (void)gw; (void)gt; (void)lane
#define GEMM_TID() ({ FRESH_LANE(l_); wave_s * 64 + l_; })
#define GBAR() do { ++nbar; asm volatile("s_waitcnt vmcnt(0)" ::: "memory"); __syncthreads(); { FRESH_LANE(l_); if (wave_s == 0 && l_ == 0) { RELOAD_P(); unsigned* ctr = (unsigned*)(ws + WS_BAR); \
        __builtin_amdgcn_fence(__ATOMIC_RELEASE, "agent"); __hip_atomic_fetch_add(ctr, 1u, __ATOMIC_RELAXED, __HIP_MEMORY_SCOPE_AGENT); const unsigned target = nbar * (unsigned)G; \
        while (__hip_atomic_load(ctr, __ATOMIC_RELAXED, __HIP_MEMORY_SCOPE_AGENT) < target) __builtin_amdgcn_s_sleep(2); \
        __builtin_amdgcn_fence(__ATOMIC_ACQUIRE, "agent"); } } __syncthreads(); } while (0)
#define SS_IN (SSB + (l == 0 ? 0 : 3 * M))
#define SSA (SSB + (1 + 3 * l) * M)
#define SSBB (SSB + (2 + 3 * l) * M)
#define SSC (SSB + (3 + 3 * l) * M)
template <int l> DI void run_layer(LAS unsigned char* lds, const int G, const int blk, const int NGW, const int NT, const int wave_s, unsigned& nbar) {

        { RELOAD_P(); pg8::Gemm g{l == 0 ? XB : YC, (const bf16_t*)(ws + WS_WIN), M, PP, DM}; pg8::StaticOrder S; S.init(M, PP, G, blk);
          pg8::EpiScale<0> E{PROJ, PP, SS_IN};
          pg8::gemm_phase<pg8::EpiScale<0>, pg8::StaticOrder, true, true>(lds, g, S, E, GEMM_TID()); }
        GBAR();
        { RELOAD_IDS(); for (int t = blk; t < 256; t += G) e1_tile(p, l, t, lds, tid, wave, lane); }
        GBAR();
        { RELOAD_IDS(); for (int u = blk; u < 256; u += G) ssd_states_unit(p, l, u >> 6, (u >> 1) & 31, u & 1, lds, tid, wave, lane); }
        { RELOAD_IDS(); for (int u = blk; u < 128; u += G) ret_states_unit(p, u >> 5, u & 31, lds, tid); }
        { RELOAD_IDS(); for (int u = blk; u < 256; u += G) conv_unit(p, l, u >> 6, (u & 63) * 64, lds, tid, wave, lane); }
        { RELOAD_IDS(); for (int ub = blk; ub < 256; ub += G) { const int bh = ub >> 4, seg = ub & 15;
            for (int it = 0; it < 6; ++it) { const int task = it * 8 + wave, pat = task >> 4, k = task & 15;
                const int r = pat == 0 ? 0 : (pat == 1 ? (k >> 2) : k); const int i0 = pat == 0 ? seg * 256 + k * 16 : (pat == 1 ? seg * 64 + (k & 3) * 16 : seg * 16);
                attn_tile(p, bh >> 2, bh & 3, pat, r, i0, lane); } } }
        GBAR();
        { RELOAD_IDS(); scan_phase(p, gt, NT); attn_combine(p, gt, NT); }
        GBAR();
        { RELOAD_IDS(); for (int u = blk; u < 256; u += G) ssd_y_unit(p, l, u >> 6, (u >> 1) & 31, u & 1, lds, tid, wave, lane); }
        { RELOAD_IDS(); for (int u = blk; u < 512; u += G) ret_y_unit(p, u >> 7, (u >> 2) & 31, u & 3, lds, tid, wave); }
        GBAR();
        { RELOAD_P(); pg8::Gemm g{YC, (const bf16_t*)(ws + WS_WOUT), M, DM, DM}; pg8::StaticOrder S; S.init(M, DM, G, blk);
          pg8::EpiRes<0> E{l == 0 ? p.in[0] : p.out, p.out, XB, SSA, DM, nullptr, nullptr};
          pg8::gemm_phase<pg8::EpiRes<0>, pg8::StaticOrder, true, true>(lds, g, S, E, GEMM_TID()); }
        GBAR();
        { RELOAD_P(); pg8::Gemm g{XB, (const bf16_t*)(ws + WS_WUP), M, FF, DM}; pg8::StaticOrder S; S.init(M, FF, G, blk);
          pg8::EpiScale<1> E{HB, FF, SSA};
          pg8::gemm_phase<pg8::EpiScale<1>, pg8::StaticOrder, true, true>(lds, g, S, E, GEMM_TID()); }
        GBAR();
        { RELOAD_P(); pg8::Gemm g{HB, (const bf16_t*)(ws + WS_WDOWN), M, DM, FF}; pg8::StaticOrder S; S.init(M, DM, G, blk);
          pg8::EpiRes<0> E{p.out, p.out, XB, SSBB, DM, nullptr, nullptr};
          pg8::gemm_phase<pg8::EpiRes<0>, pg8::StaticOrder, true, true>(lds, g, S, E, GEMM_TID()); }
        GBAR();
        if (l == 0) { RELOAD_IDS(); convert_weights(p, 1, 1, lds, gw, NGW, lane, wave); __syncthreads(); }
        { RELOAD_P(); pg8::Gemm g{(const bf16_t*)(ws + (l ? WS_PB1 : WS_PB0)), (const bf16_t*)(ws + (l ? WS_WPLE1 : WS_WPLE0)), M, DM, PLE}; pg8::StaticOrder S; S.init(M, DM, G, blk);
          pg8::EpiPe E{PE, DM};
          pg8::gemm_phase<pg8::EpiPe, pg8::StaticOrder, true, true>(lds, g, S, E, GEMM_TID()); }
        { RELOAD_P(); pg8::Gemm g{XB, (const bf16_t*)(ws + (l ? WS_WGATE1 : WS_WGATE0)), M, DM, DM}; pg8::StaticOrder S; S.init(M, DM, G, blk);
          pg8::EpiRes<1> E{p.out, p.out, YC, SSC, DM, PE, SSBB};
          pg8::gemm_phase<pg8::EpiRes<1>, pg8::StaticOrder, true, true>(lds, g, S, E, GEMM_TID()); }
        if (l == 0) GBAR();
    }

__global__ void __launch_bounds__(NTHR, 2) fwd_kernel(Params p_unused) {
    extern __shared__ __attribute__((aligned(16))) unsigned char lds_raw[];
    LAS unsigned char* lds = (LAS unsigned char*)lds_raw;
    cg::grid_group grid = cg::this_grid();
    const int G = gridDim.x, blk = blockIdx.x;
    const int NGW = G * NWV, NT = G * NTHR;
    const int wave_s = __builtin_amdgcn_readfirstlane(threadIdx.x >> 6);
    unsigned nbar = 0;
    { RELOAD_IDS();
    prologue(p, gw, NGW, lane);
    convert_weights(p, 0, 3, lds, gw, NGW, lane, wave);
    convert_weights(p, 1, 2, lds, gw, NGW, lane, wave); }
    grid.sync();

    run_layer<0>(lds, G, blk, NGW, NT, wave_s, nbar);
    run_layer<1>(lds, G, blk, NGW, NT, wave_s, nbar);
}

extern "C" void kernel_launch(void* const* d_in, const int* in_sizes, int n_in, void* d_out, int out_size, void* d_ws, size_t ws_size, hipStream_t stream) {
    static int grid = 0;
    if (grid == 0) {
        int dev = 0, cus = 0, per_cu = 0;
        hipGetDevice(&dev); hipDeviceGetAttribute(&cus, hipDeviceAttributeMultiprocessorCount, dev);
        if (hipFuncSetAttribute((const void*)fwd_kernel, hipFuncAttributeMaxDynamicSharedMemorySize, LDS_BYTES) != hipSuccess) { fprintf(stderr, "kernel_launch: hipFuncSetAttribute failed\n"); }
        if (hipOccupancyMaxActiveBlocksPerMultiprocessor(&per_cu, (const void*)fwd_kernel, NTHR, LDS_BYTES) != hipSuccess || per_cu < 1) { fprintf(stderr, "kernel_launch: occupancy query says %d\n", per_cu); per_cu = 1; }
        (void)hipGetLastError();
        grid = cus * (per_cu > 1 ? 1 : per_cu);
        if (n_in != 23 || ws_size < WS_END) { fprintf(stderr, "kernel_launch: unexpected n_in %d / ws %zu\n", n_in, ws_size); }
    }
    (void)hipMemsetAsync((unsigned char*)d_ws + WS_BAR, 0, 256, stream);
    Params p{};
    for (int i = 0; i < 23; ++i) p.in[i] = (const float*)d_in[i];
    p.out = (float*)d_out; p.ws = (unsigned char*)d_ws;
    void* args[] = {&p};
    hipError_t e = hipLaunchCooperativeKernel((const void*)fwd_kernel, dim3(grid), dim3(NTHR), args, LDS_BYTES, stream);
    if (e != hipSuccess) fprintf(stderr, "cooperative launch failed: %s (grid %d)\n", hipGetErrorString(e), grid);
}
```

```cpp
#include <hip/hip_runtime.h>
#include <cstdio>
#include <cstdint>
namespace pg8 {
#define PG8_LAS __attribute__((address_space(3)))
typedef unsigned short bf16_t;
typedef short bf16x8 __attribute__((ext_vector_type(8)));
typedef float f32x4 __attribute__((ext_vector_type(4)));
typedef unsigned u32x4 __attribute__((ext_vector_type(4)));
constexpr int BM = 256, BK = 64, HALF = 128, HTB = HALF * BK * 2  , STAGE_BYTES = 8 * HTB, NXCD = 8, WGM = 8;

__host__ __device__ __forceinline__ int lds_byte(int r, int c) { const int st = (r >> 4) * 2 + (c >> 5), rr = r & 15, cc = c & 31, ob = rr * 64 + cc * 2; return st * 1024 + (ob ^ (((ob >> 9) & 1) << 5)); }
__host__ __device__ __forceinline__ void stage_rc(int b, int& R, int& C) { const int st = b / 1024, sb = b % 1024, swz = sb ^ (((sb >> 9) & 1) << 5); R = (st >> 1) * 16 + swz / 64; C = (st & 1) * 32 + (swz % 64) / 2; }
__host__ __device__ __forceinline__ int perm32(int rho) { const int n = rho >> 4, i = rho & 15; return 8 * (i >> 2) + 4 * n + (i & 3); }

struct Unit { int pm, pn; };
struct Gemm { const bf16_t* A; const bf16_t* Bt; int M, N, K; };

struct StaticOrder {
    int nM, nN, nwg, G, c;
    __host__ __device__ void init(int M, int N, int G_, int c_) { nM = M / BM; nN = N / BM; nwg = nM * nN; G = G_; c = c_; }
    __host__ __device__ bool next(int i, Unit& u) const {
        const long L = (long)i * G + c; if (L >= nwg) return false;
        int wgid = (int)L; { const int q = nwg / NXCD, r = nwg % NXCD, xcd = wgid % NXCD, off = wgid / NXCD; wgid = (xcd < r ? xcd * (q + 1) : r * (q + 1) + (xcd - r) * q) + off; }
        const int nig = WGM * nN, gid = wgid / nig, fm = gid * WGM, gsz = (nM - fm) < WGM ? (nM - fm) : WGM;
        u.pm = fm + ((wgid % nig) % gsz); u.pn = (wgid % nig) / gsz; return true;
    }
    __device__ __forceinline__ void a_ready(const Unit&) const {}
    __device__ __forceinline__ void done(const Unit&) const {}
};

__device__ __forceinline__ unsigned cvt_pk_bf16(float lo, float hi) { unsigned r; asm volatile("v_cvt_pk_bf16_f32 %0, %1, %2" : "=v"(r) : "v"(lo), "v"(hi)); return r; }

typedef unsigned u32x2 __attribute__((ext_vector_type(2)));
constexpr float RMS_EPS = 1e-6f;
template <int ACT> struct EpiScale {
    static constexpr bool PERM = true, AFTER_DRAIN = false;
    bf16_t* O; int ldc; const float* ss;
    __device__ __forceinline__ void operator()(const f32x4 (&acc)[2][2][4][2], const Unit& u, int wr, int wc, int fr, int fq) const {
        const int row0 = u.pm * BM + wr * 64 + fr; const int col0 = u.pn * BM + wc * 32 + 8 * fq;
#pragma unroll
        for (int ai = 0; ai < 2; ++ai)
#pragma unroll
            for (int m = 0; m < 4; ++m) { const int row = row0 + ai * HALF + m * 16; const float r = ss ? rsqrtf(ss[row] * (1.0f / 1024.0f) + RMS_EPS) : 1.0f;
                bf16_t* rowp = O + (size_t)row * ldc + col0;
#pragma unroll
                for (int bj = 0; bj < 2; ++bj) { f32x4 v0 = acc[ai][bj][m][0] * r, v1 = acc[ai][bj][m][1] * r;
                    if (ACT == 1) {
#pragma unroll
                        for (int e = 0; e < 4; ++e) { float a = fmaxf(v0[e], 0.f), b = fmaxf(v1[e], 0.f); v0[e] = a * a; v1[e] = b * b; } }
                    u32x4 w; w.x = cvt_pk_bf16(v0[0], v0[1]); w.y = cvt_pk_bf16(v0[2], v0[3]); w.z = cvt_pk_bf16(v1[0], v1[1]); w.w = cvt_pk_bf16(v1[2], v1[3]);
                    *(u32x4*)(rowp + bj * HALF) = w; }
                asm volatile("" ::: "memory"); }
    }
};
struct EpiPe {
    static constexpr bool PERM = false, AFTER_DRAIN = false;
    bf16_t* O; int ldc;
    __device__ __forceinline__ void operator()(const f32x4 (&acc)[2][2][4][2], const Unit& u, int wr, int wc, int fr, int fq) const {
        const int col0 = u.pn * BM + wc * 32 + 4 * fq;
#pragma unroll
        for (int ai = 0; ai < 2; ++ai)
#pragma unroll
            for (int m = 0; m < 4; ++m) { const size_t off = (size_t)(u.pm * BM + ai * HALF + wr * 64 + m * 16 + fr) * ldc + col0;
#pragma unroll
                for (int bj = 0; bj < 2; ++bj)
#pragma unroll
                    for (int n = 0; n < 2; ++n) { const f32x4 v = acc[ai][bj][m][n]; u32x2 w; w.x = cvt_pk_bf16(v[0], v[1]); w.y = cvt_pk_bf16(v[2], v[3]);
                        *(u32x2*)(O + off + bj * HALF + n * 16) = w; } }
    }
};
template <int GATE> struct EpiRes {
    static constexpr bool PERM = false, AFTER_DRAIN = false;
    const float* base; float* out; bf16_t* xb; float* ssout; int ldc; const bf16_t* pe; const float* ss;
    __device__ __forceinline__ void operator()(const f32x4 (&acc)[2][2][4][2], const Unit& u, int wr, int wc, int fr, int fq) const {
        const int col0 = u.pn * BM + wc * 32 + 4 * fq;
#pragma unroll
        for (int ai = 0; ai < 2; ++ai)
#pragma unroll
            for (int m = 0; m < 4; ++m) { const int row = u.pm * BM + ai * HALF + wr * 64 + m * 16 + fr; const size_t off = (size_t)row * ldc + col0; float s = 0.f;
                float r = 1.f; if (GATE) r = rsqrtf(ss[row] * (1.0f / 1024.0f) + RMS_EPS);
#pragma unroll
                for (int bj = 0; bj < 2; ++bj)
#pragma unroll
                    for (int n = 0; n < 2; ++n) { const size_t o2 = off + bj * HALF + n * 16; const f32x4 bs = *(const f32x4*)(base + o2); f32x4 a = acc[ai][bj][m][n];
                        if (GATE) { const u32x2 pw = *(const u32x2*)(pe + o2);
                            const float p0 = __uint_as_float(pw.x << 16), p1 = __uint_as_float(pw.x & 0xffff0000u), p2 = __uint_as_float(pw.y << 16), p3 = __uint_as_float(pw.y & 0xffff0000u);
                            a[0] = p0 / (1.f + __expf(-a[0] * r)); a[1] = p1 / (1.f + __expf(-a[1] * r)); a[2] = p2 / (1.f + __expf(-a[2] * r)); a[3] = p3 / (1.f + __expf(-a[3] * r)); }
                        const f32x4 o = bs + a; *(f32x4*)(out + o2) = o;
                        u32x2 w; w.x = cvt_pk_bf16(o[0], o[1]); w.y = cvt_pk_bf16(o[2], o[3]); *(u32x2*)(xb + o2) = w;
                        s += (o[0] * o[0] + o[1] * o[1]) + (o[2] * o[2] + o[3] * o[3]); }
                s += __shfl_xor(s, 16); s += __shfl_xor(s, 32);
                if (fq == 0) atomicAdd(ssout + row, s);
                asm volatile("" ::: "memory"); }
    }
};
template <class Epi, class Sched, bool ALIGN_EPI = false, bool SP2 = false>
__device__ __forceinline__ void gemm_phase(PG8_LAS unsigned char* lds, const Gemm g, const Sched& S, const Epi& E, int tid_) {
    const int tid = tid_, wid = __builtin_amdgcn_readfirstlane(tid >> 6), lane = tid & 63, wr = wid >> 2, wc = wid & 3, fr = lane & 15, fq = lane >> 4;
    const int K = g.K, nt = K / BK;
    unsigned voffA[2], voffB[2];
#pragma unroll
    for (int i = 0; i < 2; ++i) { int R, C; stage_rc(tid * 16 + i * 8192, R, C); const int Rb = Epi::PERM ? ((R & ~31) + perm32(R & 31)) : R;
        voffA[i] = (unsigned)(R * K + C) * 2u; voffB[i] = (unsigned)(Rb * K + C) * 2u; }
    const size_t kstep = (size_t)(BK * 2);
    const size_t hstep = (size_t)HALF * K * 2;
    const size_t tstep = 2 * hstep;
    const unsigned ldsw = (unsigned)wid * 1024u;
    const int aoff = lds_byte(wr * 64 + fr, fq * 8), boff = lds_byte(wc * 32 + fr, fq * 8);
#define PG8_SA(b, h) (((b) * 2 + (h)) * HTB)
#define PG8_SB(b, h) ((4 + (b) * 2 + (h)) * HTB)
#define PG8_STAGE(bufoff, gbase, voff) do { _Pragma("unroll") for (int _i = 0; _i < 2; ++_i) \
        __builtin_amdgcn_global_load_lds((const unsigned*)((const char*)(gbase) + (voff)[_i]), (PG8_LAS unsigned*)(lds + (bufoff) + ldsw + _i * 8192), 16, 0, 0); } while (0)
#define PG8_LDA(dst, b, h) do { _Pragma("unroll") for (int m = 0; m < 4; ++m) _Pragma("unroll") for (int k = 0; k < 2; ++k) dst[m][k] = *(const PG8_LAS bf16x8*)(lds + PG8_SA(b, h) + aoff + m * 2048 + k * 1024); } while (0)
#define PG8_LDB(dst, b, h) do { _Pragma("unroll") for (int n = 0; n < 2; ++n) _Pragma("unroll") for (int k = 0; k < 2; ++k) dst[n][k] = *(const PG8_LAS bf16x8*)(lds + PG8_SB(b, h) + boff + n * 2048 + k * 1024); } while (0)
#define PG8_MMA(ai, bj, At, Bt) do { __builtin_amdgcn_s_setprio(1); _Pragma("unroll") for (int m = 0; m < 4; ++m) _Pragma("unroll") for (int n = 0; n < 2; ++n) _Pragma("unroll") for (int k = 0; k < 2; ++k) \
        acc[ai][bj][m][n] = __builtin_amdgcn_mfma_f32_16x16x32_bf16(Bt[n][k], At[m][k], acc[ai][bj][m][n], 0, 0, 0); __builtin_amdgcn_s_setprio(0); } while (0)
#define PG8_WAIT_V(n) asm volatile("s_waitcnt vmcnt(" #n ")" ::: "memory")
#define PG8_WAIT_L(n) asm volatile("s_waitcnt lgkmcnt(" #n ")" ::: "memory")
#define PG8_BAR __builtin_amdgcn_s_barrier()
#define PG8_SCHED __builtin_amdgcn_sched_barrier(0)
    Unit cur, nxt; int ui = 0;
    if (!S.next(0, cur)) return;
    f32x4 acc[2][2][4][2];
#pragma unroll
    for (int a = 0; a < 2; ++a)
#pragma unroll
        for (int b = 0; b < 2; ++b)
#pragma unroll
            for (int m = 0; m < 4; ++m)
#pragma unroll
                for (int n = 0; n < 2; ++n) acc[a][b][m][n] = (f32x4){0.f, 0.f, 0.f, 0.f};
    bf16x8 At[4][2], B0[2][2], B1[2][2];
    const char* cA = (const char*)g.A + (size_t)cur.pm * tstep; const char* cB = (const char*)g.Bt + (size_t)cur.pn * tstep;
    S.a_ready(cur);
    if constexpr (SP2) {
        PG8_STAGE(PG8_SB(0, 0), cB, voffB); PG8_STAGE(PG8_SB(0, 1), cB + hstep, voffB); PG8_STAGE(PG8_SA(0, 0), cA, voffA); PG8_STAGE(PG8_SA(0, 1), cA + hstep, voffA);
        if (wr == 1) PG8_BAR;
        PG8_WAIT_V(2); PG8_BAR;
        PG8_STAGE(PG8_SB(1, 0), cB + kstep, voffB); PG8_STAGE(PG8_SA(1, 0), cA + kstep, voffA); PG8_STAGE(PG8_SB(1, 1), cB + hstep + kstep, voffB);
        PG8_WAIT_V(6); PG8_BAR;
    } else {
        PG8_STAGE(PG8_SB(0, 0), cB, voffB); PG8_STAGE(PG8_SA(0, 0), cA, voffA); PG8_STAGE(PG8_SB(0, 1), cB + hstep, voffB); PG8_STAGE(PG8_SA(0, 1), cA + hstep, voffA);
        if (wr == 1) PG8_BAR;
        PG8_WAIT_V(4); PG8_BAR;
        PG8_STAGE(PG8_SB(1, 0), cB + kstep, voffB); PG8_STAGE(PG8_SA(1, 0), cA + kstep, voffA); PG8_STAGE(PG8_SB(1, 1), cB + hstep + kstep, voffB);
        PG8_WAIT_V(6); PG8_BAR;
    }
    for (;;) {
        const bool has_next = S.next(ui + 1, nxt);
        const char* nA = has_next ? (const char*)g.A + (size_t)nxt.pm * tstep : cA; const char* nB = has_next ? (const char*)g.Bt + (size_t)nxt.pn * tstep : cB;
        for (int t = 0; t < nt; t += 2) {
            const bool last = (t == nt - 2);
            const char* a1 = cA + (size_t)(t + 1) * kstep;
            const char* a2 = last ? nA : cA + (size_t)(t + 2) * kstep; const char* b2 = last ? nB : cB + (size_t)(t + 2) * kstep;
            const char* a3 = a2 + kstep; const char* b3 = b2 + kstep;
            if (last && has_next) S.a_ready(nxt);
            if constexpr (SP2) {
            PG8_LDB(B0, 0, 0); PG8_LDB(B1, 0, 1); PG8_SCHED; PG8_LDA(At, 0, 0); PG8_STAGE(PG8_SA(1, 1), a1 + hstep, voffA);
            PG8_WAIT_V(8); PG8_WAIT_L(0); PG8_BAR; PG8_MMA(0, 0, At, B0); PG8_MMA(0, 1, At, B1); PG8_BAR; PG8_SCHED;
            PG8_LDA(At, 0, 1); PG8_STAGE(PG8_SB(0, 0), b2, voffB); PG8_STAGE(PG8_SB(0, 1), b2 + hstep, voffB); PG8_STAGE(PG8_SA(0, 0), a2, voffA);
            PG8_WAIT_V(8); PG8_WAIT_L(0); PG8_BAR; PG8_MMA(1, 0, At, B0); PG8_MMA(1, 1, At, B1); PG8_BAR; PG8_SCHED;
            PG8_LDB(B0, 1, 0); PG8_LDB(B1, 1, 1); PG8_SCHED; PG8_LDA(At, 1, 0); PG8_STAGE(PG8_SA(0, 1), a2 + hstep, voffA);
            PG8_WAIT_V(8); PG8_WAIT_L(0); PG8_BAR; PG8_MMA(0, 0, At, B0); PG8_MMA(0, 1, At, B1); PG8_BAR; PG8_SCHED;
            PG8_LDA(At, 1, 1); PG8_STAGE(PG8_SB(1, 0), b3, voffB); PG8_STAGE(PG8_SB(1, 1), b3 + hstep, voffB); PG8_STAGE(PG8_SA(1, 0), a3, voffA);
            PG8_WAIT_V(8); PG8_WAIT_L(0); PG8_BAR; PG8_MMA(1, 0, At, B0); PG8_MMA(1, 1, At, B1); PG8_BAR; PG8_SCHED;
            } else {
            PG8_LDB(B0, 0, 0); PG8_SCHED; PG8_LDA(At, 0, 0); PG8_STAGE(PG8_SA(1, 1), a1 + hstep, voffA);
            PG8_WAIT_L(8); PG8_BAR; PG8_WAIT_L(0); PG8_MMA(0, 0, At, B0); PG8_BAR; PG8_SCHED;
            PG8_LDB(B1, 0, 1); PG8_STAGE(PG8_SB(0, 0), b2, voffB);
            PG8_BAR; PG8_WAIT_L(0); PG8_MMA(0, 1, At, B1); PG8_BAR;
            PG8_LDA(At, 0, 1); PG8_STAGE(PG8_SA(0, 0), a2, voffA);
            PG8_BAR; PG8_WAIT_L(0); PG8_MMA(1, 0, At, B0); PG8_BAR; PG8_SCHED;
            PG8_STAGE(PG8_SB(0, 1), b2 + hstep, voffB);
            PG8_WAIT_V(6); PG8_BAR; PG8_MMA(1, 1, At, B1); PG8_BAR;
            PG8_LDB(B0, 1, 0); PG8_SCHED; PG8_LDA(At, 1, 0); PG8_STAGE(PG8_SA(0, 1), a2 + hstep, voffA);
            PG8_WAIT_L(8); PG8_BAR; PG8_WAIT_L(0); PG8_MMA(0, 0, At, B0); PG8_BAR; PG8_SCHED;
            PG8_LDB(B1, 1, 1); PG8_STAGE(PG8_SB(1, 0), b3, voffB);
            PG8_BAR; PG8_WAIT_L(0); PG8_MMA(0, 1, At, B1); PG8_BAR;
            PG8_LDA(At, 1, 1); PG8_STAGE(PG8_SA(1, 0), a3, voffA);
            PG8_BAR; PG8_WAIT_L(0); PG8_MMA(1, 0, At, B0); PG8_BAR; PG8_SCHED;
            PG8_STAGE(PG8_SB(1, 1), b3 + hstep, voffB);
            PG8_WAIT_V(6); PG8_BAR; PG8_MMA(1, 1, At, B1); PG8_BAR;
            }
        }
        if constexpr (ALIGN_EPI) { if (wr == 0) PG8_BAR; }
        if constexpr (!Epi::AFTER_DRAIN) { E(acc, cur, wr, wc, fr, fq); S.done(cur); }
        if (!has_next) break;
#pragma unroll
        for (int a = 0; a < 2; ++a)
#pragma unroll
            for (int b = 0; b < 2; ++b)
#pragma unroll
                for (int m = 0; m < 4; ++m)
#pragma unroll
                    for (int n = 0; n < 2; ++n) acc[a][b][m][n] = (f32x4){0.f, 0.f, 0.f, 0.f};
        cur = nxt; cA = nA; cB = nB; ++ui;
        if constexpr (ALIGN_EPI) { if (wr == 1) PG8_BAR; }
    }
    PG8_WAIT_V(0);
    if constexpr (!ALIGN_EPI) { if (wr == 0) PG8_BAR; }
    PG8_BAR;
    if constexpr (Epi::AFTER_DRAIN) { E.fused(acc, cur, wr, wc, fr, fq, lds, wid, lane); S.done(cur); }
#undef PG8_SA
#undef PG8_SB
#undef PG8_STAGE
#undef PG8_LDA
#undef PG8_LDB
#undef PG8_MMA
#undef PG8_WAIT_V
#undef PG8_WAIT_L
#undef PG8_BAR
#undef PG8_SCHED
}
}

#include <hip/hip_cooperative_groups.h>
namespace cg = cooperative_groups;
#define LAS __attribute__((address_space(3)))
#define DI __device__ __forceinline__
typedef unsigned short bf16_t;
typedef unsigned u32x4 __attribute__((ext_vector_type(4)));
typedef unsigned u32x2 __attribute__((ext_vector_type(2)));
typedef float f32x4 __attribute__((ext_vector_type(4)));

constexpr int SEQ = 4096, NB = 4, M = NB * SEQ, DM = 1024, FF = 4096, PLE = 256;
constexpr int PP = 3584;
constexpr int IN_ORIG = 3332;
constexpr int AQ = 0, AK = 256, AV = 512, BZ = 768, BX = 1024, BDT = 1792, CQ = 2048, CK = 2304, CV = 2560, CG = 2816, DV = 3072, DG = 3328;
constexpr float EPS = 1e-6f;
constexpr int NTHR = 512, NWV = 8;
constexpr int LDS_BYTES = 147456;
constexpr size_t MiB = 1u << 20;
constexpr size_t WS_SS = 0;
constexpr size_t WS_CDEC = 512 * 1024; constexpr size_t WS_BAR = 600 * 1024;
constexpr size_t WS_TAB = 1 * MiB;
constexpr size_t WS_PB0 = 3 * MiB;
constexpr size_t WS_WIN = 11 * MiB, WS_WOUT = 18 * MiB, WS_WUP = 20 * MiB, WS_WDOWN = 28 * MiB, WS_WPLE0 = 36 * MiB, WS_WGATE0 = 37 * MiB;
constexpr size_t WS_XB = 39 * MiB, WS_YCAT = 71 * MiB, WS_PROJ = 103 * MiB, WS_SST = 215 * MiB, WS_RST = 231 * MiB;
constexpr size_t WS_H = 103 * MiB, WS_PE = 103 * MiB;
constexpr size_t WS_VT = 39 * MiB;
constexpr size_t WS_LSE = 250 * MiB;
constexpr size_t WS_WPLE1 = 239 * MiB, WS_WGATE1 = 240 * MiB, WS_PB1 = 242 * MiB, WS_END = 256 * MiB;

struct Params {
    const float* in[23]; float* out; unsigned char* ws;
};

DI float bf2f(bf16_t u) { return __uint_as_float((unsigned)u << 16); }
DI unsigned f2bf(float f) { unsigned u = __float_as_uint(f); return (u + 0x7fffu + ((u >> 16) & 1u)) >> 16; }
DI unsigned pk2(float lo, float hi) { return f2bf(lo) | (f2bf(hi) << 16); }
DI float lo16(unsigned w) { return __uint_as_float(w << 16); }
DI float hi16(unsigned w) { return __uint_as_float(w & 0xffff0000u); }
DI float wave_sum(float v) {
#pragma unroll
    for (int o = 1; o < 64; o <<= 1) v += __shfl_xor(v, o);
    return v;
}
DI float wave_max(float v) {
#pragma unroll
    for (int o = 1; o < 64; o <<= 1) v = fmaxf(v, __shfl_xor(v, o));
    return v;
}
DI float silu_f(float v) { return v / (1.f + __expf(-v)); }
DI float sigm_f(float v) { return 1.f / (1.f + __expf(-v)); }
DI void unpack8(const u32x4 w, float (&f)[8]) { f[0] = lo16(w.x); f[1] = hi16(w.x); f[2] = lo16(w.y); f[3] = hi16(w.y); f[4] = lo16(w.z); f[5] = hi16(w.z); f[6] = lo16(w.w); f[7] = hi16(w.w); }

DI void tr_item(const float* W, int K, int Norig, bf16_t* WT, const float* g, bool gap, LAS float* scr, int item, int nblk, int lane) {
    const int kb = item / nblk, nb = item % nblk, k0 = 64 * kb, n0 = 32 * nb;
    const int n = n0 + (lane & 31);
    int orig = n; if (gap) orig = (n < 1796) ? n : (n < 2048 ? -1 : n - 252);
#pragma unroll 8
    for (int i = 0; i < 32; ++i) { const int kk = 2 * i + (lane >> 5); float v = 0.f;
        if (orig >= 0) { v = W[(size_t)(k0 + kk) * Norig + orig]; if (g) v *= g[k0 + kk]; }
        scr[kk * 33 + (lane & 31)] = v; }
    asm volatile("s_waitcnt lgkmcnt(0)" ::: "memory");
    const int c = lane & 7;
#pragma unroll
    for (int j = 0; j < 4; ++j) { const int nn = (lane >> 3) + 8 * j; const LAS float* s = scr + (8 * c) * 33 + nn;
        u32x4 o; o.x = pk2(s[0 * 33], s[1 * 33]); o.y = pk2(s[2 * 33], s[3 * 33]); o.z = pk2(s[4 * 33], s[5 * 33]); o.w = pk2(s[6 * 33], s[7 * 33]);
        *(u32x4*)(WT + (size_t)(n0 + nn) * K + k0 + 8 * c) = o; }
    asm volatile("s_waitcnt lgkmcnt(0)" ::: "memory");
}
DI void convert_weights(const Params& p, int l, int which, LAS unsigned char* lds, int gw, int NGW, int lane, int wave) {
    LAS float* scr = (LAS float*)(lds + wave * 16384);
    unsigned char* ws = p.ws;
    if (which & 1) {
        constexpr int I_IN = 16 * 112, I_OUT = 16 * 32, I_UP = 16 * 128, I_DN = 64 * 32;
        for (int it = gw; it < I_IN + I_OUT + I_UP + I_DN; it += NGW) {
            int r = it;
            if (r < I_IN) { tr_item(p.in[3] + (size_t)l * DM * IN_ORIG, DM, IN_ORIG, (bf16_t*)(ws + WS_WIN), p.in[2] + l * DM, true, scr, r, 112, lane); continue; } r -= I_IN;
            if (r < I_OUT) { tr_item(p.in[16] + (size_t)l * DM * DM, DM, DM, (bf16_t*)(ws + WS_WOUT), nullptr, false, scr, r, 32, lane); continue; } r -= I_OUT;
            if (r < I_UP) { tr_item(p.in[18] + (size_t)l * DM * FF, DM, FF, (bf16_t*)(ws + WS_WUP), p.in[17] + l * DM, false, scr, r, 128, lane); continue; } r -= I_UP;
            tr_item(p.in[19] + (size_t)l * FF * DM, FF, DM, (bf16_t*)(ws + WS_WDOWN), nullptr, false, scr, r, 32, lane);
        }
    }
    if (which & 2) {
        constexpr int I_PLE = 4 * 32, I_GATE = 16 * 32;
        bf16_t* wple = (bf16_t*)(ws + (l ? WS_WPLE1 : WS_WPLE0)); bf16_t* wgate = (bf16_t*)(ws + (l ? WS_WGATE1 : WS_WGATE0));
        for (int it = gw; it < I_PLE + I_GATE; it += NGW) {
            int r = it;
            if (r < I_PLE) { tr_item(p.in[21] + (size_t)l * PLE * DM, PLE, DM, wple, nullptr, false, scr, r, 32, lane); continue; } r -= I_PLE;
            tr_item(p.in[22] + (size_t)l * DM * DM, DM, DM, wgate, p.in[20] + l * DM, false, scr, r, 32, lane);
        }
        const f32x4* src = (const f32x4*)(p.in[1] + (size_t)l * M * PLE); u32x2* dst = (u32x2*)(ws + (l ? WS_PB1 : WS_PB0));
        const int gt = gw * 64 + lane, NT = NGW * 64;
        for (int i = gt; i < M * PLE / 4; i += NT) { const f32x4 v = src[i]; u32x2 o; o.x = pk2(v[0], v[1]); o.y = pk2(v[2], v[3]); dst[i] = o; }
    }
}

DI void prologue(const Params& p, int gw, int NGW, int lane) {
    unsigned char* ws = p.ws;
    const int gt = gw * 64 + lane, NT = NGW * 64;
    float* ss = (float*)(ws + WS_SS);
    for (int i = gt; i < 6 * M; i += NT) ss[M + i] = 0.f;
    float* tab = (float*)(ws + WS_TAB);
    for (int idx = gt; idx < 2 * SEQ * 32; idx += NT) {
        const int t = idx / (SEQ * 32), e = idx % (SEQ * 32), pos = e >> 5, i = e & 31;
        const double base = t ? 0.7429639507594948 : 0.7498942093324559;
        double a = 1.0;
        for (int k = 0; k < 31; ++k) a = (k < i) ? a * base : a;
        const double ang = (double)pos * a;
        const double kk = rint(ang * 0.15915494309189535);
        const double r = ang - kk * 6.283185307179586477;
        const double r2 = r * r; double s = r, c = 1.0, ts = r, tc = 1.0;
        for (int n = 1; n <= 14; ++n) { tc *= -r2 / (double)((2 * n - 1) * (2 * n)); c += tc; ts *= -r2 / (double)((2 * n) * (2 * n + 1)); s += ts; }
        tab[(size_t)(2 * t) * SEQ * 32 + e] = (float)c; tab[(size_t)(2 * t + 1) * SEQ * 32 + e] = (float)s;
    }
    const float* x = p.in[0]; bf16_t* xb = (bf16_t*)(ws + WS_XB);
    for (int m = gw; m < M; m += NGW) {
        const f32x4* xr = (const f32x4*)(x + (size_t)m * DM) + lane; f32x4 v[4]; float s = 0.f;
#pragma unroll
        for (int j = 0; j < 4; ++j) { v[j] = xr[64 * j]; s += (v[j][0] * v[j][0] + v[j][1] * v[j][1]) + (v[j][2] * v[j][2] + v[j][3] * v[j][3]); }
        s = wave_sum(s);
        if (lane == 0) ss[m] = s;
        u32x2* o = (u32x2*)(xb + (size_t)m * DM) + lane;
#pragma unroll
        for (int j = 0; j < 4; ++j) { u32x2 w; w.x = pk2(v[j][0], v[j][1]); w.y = pk2(v[j][2], v[j][3]); o[64 * j] = w; }
    }
}

DI void e1_tokens(const Params& p, int l, int tok_lo, int tok_hi, int lane) {
    bf16_t* proj = (bf16_t*)(p.ws + WS_PROJ); const float* tab = (const float*)(p.ws + WS_TAB);
    const int sub = lane >> 5, l5 = lane & 31, which = l5 >> 2, hq = which & 3, isk = which >> 2, i0 = (l5 & 3) * 8;
    const int col = (sub == 0 ? (isk ? AK : AQ) : (isk ? CK : CQ)) + hq * 64;
    const float* gain = (isk ? p.in[5] : p.in[4]) + l * 64;
    const float sc = ((sub == 0 && !isk) || (sub == 1 && isk)) ? 0.125f : 1.0f;
    const float* ct = tab + (size_t)(2 * sub) * SEQ * 32; const float* st = tab + (size_t)(2 * sub + 1) * SEQ * 32;
    for (int tok = tok_lo; tok < tok_hi; ++tok) {
        const int pos = tok & (SEQ - 1);
        bf16_t* ptr = proj + (size_t)tok * PP + col;
        float x1[8], x2[8];
        unpack8(*(const u32x4*)(ptr + i0), x1); unpack8(*(const u32x4*)(ptr + 32 + i0), x2);
        float s2 = 0.f;
#pragma unroll
        for (int i = 0; i < 8; ++i) s2 += x1[i] * x1[i] + x2[i] * x2[i];
        s2 += __shfl_xor(s2, 1); s2 += __shfl_xor(s2, 2);
        if (sub == 0) { const float r = rsqrtf(s2 * (1.0f / 64.0f) + EPS);
#pragma unroll
            for (int i = 0; i < 8; ++i) { x1[i] *= r * gain[i0 + i]; x2[i] *= r * gain[32 + i0 + i]; } }
        float o1[8], o2[8];
#pragma unroll
        for (int i = 0; i < 8; ++i) { const float c = ct[pos * 32 + i0 + i], s = st[pos * 32 + i0 + i]; o1[i] = (x1[i] * c - x2[i] * s) * sc; o2[i] = (x2[i] * c + x1[i] * s) * sc; }
        u32x4 w1, w2; w1.x = pk2(o1[0], o1[1]); w1.y = pk2(o1[2], o1[3]); w1.z = pk2(o1[4], o1[5]); w1.w = pk2(o1[6], o1[7]);
        w2.x = pk2(o2[0], o2[1]); w2.y = pk2(o2[2], o2[3]); w2.z = pk2(o2[4], o2[5]); w2.w = pk2(o2[6], o2[7]);
        *(u32x4*)(ptr + i0) = w1; *(u32x4*)(ptr + 32 + i0) = w2;
        bf16_t* vp = proj + (size_t)tok * PP + DV + lane * 4; const bf16_t* gp = proj + (size_t)tok * PP + DG + lane * 4;
        const u32x2 vw = *(const u32x2*)vp, gwd = *(const u32x2*)gp;
        u32x2 o; o.x = pk2(lo16(vw.x) * sigm_f(lo16(gwd.x)), hi16(vw.x) * sigm_f(hi16(gwd.x))); o.y = pk2(lo16(vw.y) * sigm_f(lo16(gwd.y)), hi16(vw.y) * sigm_f(hi16(gwd.y)));
        *(u32x2*)vp = o;
    }
}


DI void e1_tile(const Params& p, int l, int tile, LAS unsigned char* lds, int tid, int wave, int lane) {
    const int T0 = tile * 64; const int b = T0 >> 12, s0 = T0 & (SEQ - 1);
    LAS bf16_t* Vs = (LAS bf16_t*)lds;
    const bf16_t* proj = (const bf16_t*)(p.ws + WS_PROJ);
    for (int e = tid; e < 64 * 32; e += NTHR) { const int j = e >> 5, c8 = (e & 31) * 8;
        *(LAS u32x4*)(Vs + j * 264 + c8) = *(const u32x4*)(proj + (size_t)(T0 + j) * PP + AV + c8); }
    e1_tokens(p, l, T0 + wave * 8, T0 + wave * 8 + 8, lane);
    __syncthreads();
    bf16_t* vt = (bf16_t*)(p.ws + WS_VT);
    const int col = tid & 255, half = tid >> 8, h = col >> 6, dim = col & 63;
    {
      bf16_t* dst = vt + ((size_t)((b * 4 + h) * 64 + dim)) * SEQ + s0 + half * 32;
#pragma unroll
      for (int c8 = 0; c8 < 32; c8 += 8) { u32x4 w; const LAS bf16_t* s = Vs + (half * 32 + c8) * 264 + col;
          w.x = (unsigned)s[0] | ((unsigned)s[264] << 16); w.y = (unsigned)s[2 * 264] | ((unsigned)s[3 * 264] << 16); w.z = (unsigned)s[4 * 264] | ((unsigned)s[5 * 264] << 16); w.w = (unsigned)s[6 * 264] | ((unsigned)s[7 * 264] << 16);
          *(u32x4*)(dst + c8) = w; } }
    {
      bf16_t* base = vt + (size_t)4 * 1024 * 1024;
#pragma unroll
      for (int r = 0; r < 4; ++r) { const LAS bf16_t* s = Vs + (half * 32 + r) * 264 + col; u32x4 w;
          w.x = (unsigned)s[0] | ((unsigned)s[4 * 264] << 16); w.y = (unsigned)s[8 * 264] | ((unsigned)s[12 * 264] << 16); w.z = (unsigned)s[16 * 264] | ((unsigned)s[20 * 264] << 16); w.w = (unsigned)s[24 * 264] | ((unsigned)s[28 * 264] << 16);
          *(u32x4*)(base + ((size_t)(((b * 4 + h) * 4 + r) * 64 + dim)) * 1024 + (s0 >> 2) + half * 8) = w; } }
    {
      bf16_t* base = vt + (size_t)8 * 1024 * 1024;
#pragma unroll
      for (int r = 0; r < 16; ++r) { const LAS bf16_t* s = Vs + (half * 32 + r) * 264 + col;
          const unsigned w = (unsigned)s[0] | ((unsigned)s[16 * 264] << 16);
          *(unsigned*)(base + ((size_t)(((b * 4 + h) * 16 + r) * 64 + dim)) * 256 + (s0 >> 4) + half * 2) = w; } }
    __syncthreads();
}

typedef short bf16x8_t __attribute__((ext_vector_type(8)));
DI void attn_tile(const Params& p, int b, int h, int pat, int r, int i0, int lane) {
    const int dsh = 2 * pat, L = SEQ >> dsh;
    const int fr = lane & 15, quad = lane >> 4;
    const bf16_t* projb = (const bf16_t*)(p.ws + WS_PROJ) + (size_t)(b * SEQ) * PP + h * 64 + quad * 8;
    const int tq = ((i0 + fr) << dsh) + r;
    bf16x8_t qf[2];
    qf[0] = *(const bf16x8_t*)(projb + (size_t)tq * PP + AQ); qf[1] = *(const bf16x8_t*)(projb + (size_t)tq * PP + AQ + 32);
    f32x4 acc[5][2];
#pragma unroll
    for (int s = 0; s < 5; ++s)
#pragma unroll
        for (int u = 0; u < 2; ++u) {
            const int krel = 32 * s + 8 * (fr >> 2) + 4 * u + (fr & 3);
            int kap = i0 - 128 + krel; kap = kap < 0 ? 0 : (kap > L - 1 ? L - 1 : kap);
            const bf16_t* kp = projb + (size_t)((kap << dsh) + r) * PP + AK;
            const bf16x8_t k0 = *(const bf16x8_t*)kp, k1 = *(const bf16x8_t*)(kp + 32);
            f32x4 a = (f32x4){0.f, 0.f, 0.f, 0.f};
            a = __builtin_amdgcn_mfma_f32_16x16x32_bf16(k0, qf[0], a, 0, 0, 0);
            a = __builtin_amdgcn_mfma_f32_16x16x32_bf16(k1, qf[1], a, 0, 0, 0);
            acc[s][u] = a; }
    float mx = -INFINITY;
#pragma unroll
    for (int s = 0; s < 5; ++s)
#pragma unroll
        for (int u = 0; u < 2; ++u)
#pragma unroll
            for (int j = 0; j < 4; ++j) { const int k = 32 * s + 8 * quad + 4 * u + j; const bool valid = (k >= fr) && (k <= 128 + fr) && (i0 - 128 + k >= 0);
                const float v = valid ? acc[s][u][j] : -INFINITY; acc[s][u][j] = v; mx = fmaxf(mx, v); }
    mx = fmaxf(mx, __shfl_xor(mx, 16)); mx = fmaxf(mx, __shfl_xor(mx, 32));
    float sum = 0.f; bf16x8_t pb[5];
#pragma unroll
    for (int s = 0; s < 5; ++s) { float e[8];
#pragma unroll
        for (int u = 0; u < 2; ++u)
#pragma unroll
            for (int j = 0; j < 4; ++j) { const float v = acc[s][u][j]; const float ev = (v == -INFINITY) ? 0.f : __expf(v - mx); e[u * 4 + j] = ev; sum += ev; }
        u32x4 w; w.x = pk2(e[0], e[1]); w.y = pk2(e[2], e[3]); w.z = pk2(e[4], e[5]); w.w = pk2(e[6], e[7]); pb[s] = __builtin_bit_cast(bf16x8_t, w); }
    sum += __shfl_xor(sum, 16); sum += __shfl_xor(sum, 32);
    const bf16_t* vtb = (const bf16_t*)(p.ws + WS_VT) + (size_t)pat * 4 * 1024 * 1024 + ((size_t)((((b * 4 + h) << dsh) + r) * 64 + fr)) * L;
    f32x4 o[4];
#pragma unroll
    for (int dt = 0; dt < 4; ++dt) o[dt] = (f32x4){0.f, 0.f, 0.f, 0.f};
#pragma unroll
    for (int s = 0; s < 5; ++s) { int st = i0 - 128 + 32 * s + 8 * quad; st = st < 0 ? 0 : (st > L - 8 ? L - 8 : st);
#pragma unroll
        for (int dt = 0; dt < 4; ++dt) { const bf16x8_t vf = *(const bf16x8_t*)(vtb + (size_t)(dt * 16) * L + st);
            o[dt] = __builtin_amdgcn_mfma_f32_16x16x32_bf16(vf, pb[s], o[dt], 0, 0, 0); } }
    const float inv = 1.0f / sum; const size_t tok = (size_t)(b * SEQ + tq);
    bf16_t* yo = (bf16_t*)(p.ws + WS_YCAT) + tok * DM + pat * 256 + h * 64 + quad * 4;
#pragma unroll
    for (int dt = 0; dt < 4; ++dt) { u32x2 w; w.x = pk2(o[dt][0] * inv, o[dt][1] * inv); w.y = pk2(o[dt][2] * inv, o[dt][3] * inv); *(u32x2*)(yo + dt * 16) = w; }
    if (quad == 0) ((float*)(p.ws + WS_LSE))[((size_t)pat * M + tok) * 4 + h] = mx + __logf(sum);
}
DI void attn_combine(const Params& p, int gt, int NT) {
    bf16_t* yc = (bf16_t*)(p.ws + WS_YCAT); const float* lse = (const float*)(p.ws + WS_LSE);
    for (int i = gt; i < M * 32; i += NT) { const int tok = i >> 5, c8 = (i & 31) * 8, h = c8 >> 6;
        const float l0 = lse[((size_t)0 * M + tok) * 4 + h], l1 = lse[((size_t)1 * M + tok) * 4 + h], l2 = lse[((size_t)2 * M + tok) * 4 + h];
        const float mm = fmaxf(l0, fmaxf(l1, l2)); float w0 = __expf(l0 - mm), w1 = __expf(l1 - mm), w2 = __expf(l2 - mm); const float iz = 1.0f / (w0 + w1 + w2); w0 *= iz; w1 *= iz; w2 *= iz;
        bf16_t* pp = yc + (size_t)tok * DM + c8; float a[8], bq[8], c[8];
        unpack8(*(const u32x4*)pp, a); unpack8(*(const u32x4*)(pp + 256), bq); unpack8(*(const u32x4*)(pp + 512), c);
        u32x4 w; w.x = pk2(w0 * a[0] + w1 * bq[0] + w2 * c[0], w0 * a[1] + w1 * bq[1] + w2 * c[1]); w.y = pk2(w0 * a[2] + w1 * bq[2] + w2 * c[2], w0 * a[3] + w1 * bq[3] + w2 * c[3]);
        w.z = pk2(w0 * a[4] + w1 * bq[4] + w2 * c[4], w0 * a[5] + w1 * bq[5] + w2 * c[5]); w.w = pk2(w0 * a[6] + w1 * bq[6] + w2 * c[6], w0 * a[7] + w1 * bq[7] + w2 * c[7]);
        *(u32x4*)pp = w; }
}

template <int NC, int K> DI void nt_acc(float (&acc)[NC], const LAS bf16_t* Ap, const LAS bf16_t* Bp, int ldb) {
    for (int k = 0; k < K; k += 8) {
        float a[8]; unpack8(*(const LAS u32x4*)(Ap + k), a);
#pragma unroll
        for (int c = 0; c < NC; ++c) { float b[8]; unpack8(*(const LAS u32x4*)(Bp + c * ldb + k), b);
            acc[c] += (a[0] * b[0] + a[1] * b[1]) + (a[2] * b[2] + a[3] * b[3]) + (a[4] * b[4] + a[5] * b[5]) + (a[6] * b[6] + a[7] * b[7]); }
    }
}
template <int NC> DI void axpy_row(float (&acc)[NC], float coef, const LAS bf16_t* Bp) {
#pragma unroll
    for (int c8 = 0; c8 < NC; c8 += 8) { float b[8]; unpack8(*(const LAS u32x4*)(Bp + c8), b);
#pragma unroll
        for (int e = 0; e < 8; ++e) acc[c8 + e] += coef * b[e]; }
}

DI void ssd_dt_acum(const Params& p, int l, int tok0, int g, LAS float* dts, LAS float* acs, int wave, int lane) {
    if (wave < 2) {
        const int h = 2 * g + wave; const bf16_t* proj = (const bf16_t*)(p.ws + WS_PROJ);
        const float bias = p.in[8][l * 4 + h], a = -__expf(p.in[9][l * 4 + h]);
        float d[2];
#pragma unroll
        for (int e = 0; e < 2; ++e) { const float raw = bf2f(proj[(size_t)(tok0 + 2 * lane + e) * PP + BDT + h]) + bias; d[e] = raw > 20.f ? raw : log1pf(__expf(raw)); }
        const float v0 = d[0] * a, v1 = d[1] * a; float s = v0 + v1;
#pragma unroll
        for (int off = 1; off < 64; off <<= 1) { const float t = __shfl_up(s, off); if (lane >= off) s += t; }
        dts[wave * 128 + 2 * lane] = d[0]; dts[wave * 128 + 2 * lane + 1] = d[1];
        acs[wave * 128 + 2 * lane] = s - v1; acs[wave * 128 + 2 * lane + 1] = s;
    }
}
DI void stage_conv(const Params& p, int l, LAS bf16_t* dst, int ld, int tok0, int seqpos0, int choff, int tid) {
    const bf16_t* src = (const bf16_t*)(p.ws + WS_PROJ) + (size_t)tok0 * PP + BX + choff;
    const float* cw = p.in[6] + (size_t)l * 4 * 768 + choff; const float* cb = p.in[7] + l * 768 + choff;
    for (int e = tid; e < 128 * 128; e += NTHR) { const int j = e >> 7, ch = e & 127;
        float v = cb[ch];
#pragma unroll
        for (int k = 0; k < 4; ++k) { const int s = j - 3 + k; if (seqpos0 + s >= 0) v += cw[k * 768 + ch] * bf2f(src[(long)s * PP + ch]); }
        dst[j * ld + ch] = (bf16_t)f2bf(silu_f(v)); }
}


DI void stage_conv_t(const Params& p, int l, LAS bf16_t* dst, int ld, int tok0, int seqpos0, int choff, const LAS float* wsc, int tid) {
    const bf16_t* src = (const bf16_t*)(p.ws + WS_PROJ) + (size_t)tok0 * PP + BX + choff;
    const float* cw = p.in[6] + (size_t)l * 4 * 768 + choff; const float* cb = p.in[7] + l * 768 + choff;
    for (int e = tid; e < 128 * 128; e += NTHR) { const int j = e >> 7, ch = e & 127;
        float v = cb[ch];
#pragma unroll
        for (int k = 0; k < 4; ++k) { const int s = j - 3 + k; if (seqpos0 + s >= 0) v += cw[k * 768 + ch] * bf2f(src[(long)s * PP + ch]); }
        v = silu_f(v); if (wsc) v *= wsc[(ch >> 6) * 128 + j];
        dst[ch * ld + j] = (bf16_t)f2bf(v); }
}
typedef short bf16x8_t __attribute__((ext_vector_type(8)));
#define MFMA16(a, b, c) __builtin_amdgcn_mfma_f32_16x16x32_bf16((a), (b), (c), 0, 0, 0)
DI void ssd_states_mfma(const Params& p, int l, int b, int c, int g, LAS unsigned char* lds, int tid, int wave, int lane) {
    LAS bf16_t* XT = (LAS bf16_t*)lds; LAS bf16_t* BT = XT + 128 * 136;
    LAS float* dts = (LAS float*)(BT + 128 * 136); LAS float* acs = dts + 256; LAS float* wsc = acs + 256;
    const int tok0 = b * SEQ + c * 128;
    ssd_dt_acum(p, l, tok0, g, dts, acs, wave, lane);
    __syncthreads();
    if (tid < 256) { const int hh = tid >> 7, j = tid & 127; wsc[tid] = __expf(acs[hh * 128 + 127] - acs[hh * 128 + j]) * dts[hh * 128 + j]; }
    if (tid < 2) ((float*)(p.ws + WS_CDEC))[(b * 32 + c) * 4 + 2 * g + tid] = __expf(acs[tid * 128 + 127]);
    __syncthreads();
    stage_conv_t(p, l, XT, 136, tok0, c * 128, g * 128, wsc, tid);
    stage_conv_t(p, l, BT, 136, tok0, c * 128, 256 + g * 128, nullptr, tid);
    __syncthreads();
    const int fr = lane & 15, quad = lane >> 4, hh = wave >> 2, pt = wave & 3;
    bf16x8_t af[4];
#pragma unroll
    for (int ks = 0; ks < 4; ++ks) af[ks] = *(const LAS bf16x8_t*)(XT + (hh * 64 + pt * 16 + fr) * 136 + ks * 32 + quad * 8);
    float* dst = (float*)(p.ws + WS_SST) + ((size_t)((b * 32 + c) * 4 + 2 * g + hh)) * 8192 + (pt * 16 + quad * 4) * 128 + fr;
#pragma unroll
    for (int nt = 0; nt < 8; ++nt) { f32x4 acc = (f32x4){0.f, 0.f, 0.f, 0.f};
#pragma unroll
        for (int ks = 0; ks < 4; ++ks) { const bf16x8_t bfv = *(const LAS bf16x8_t*)(BT + (nt * 16 + fr) * 136 + ks * 32 + quad * 8); acc = MFMA16(af[ks], bfv, acc); }
#pragma unroll
        for (int jj = 0; jj < 4; ++jj) dst[jj * 128 + nt * 16] = acc[jj]; }
    __syncthreads();
}
DI void ssd_y_mfma(const Params& p, int l, int b, int c, int g, LAS unsigned char* lds, int tid, int wave, int lane) {
    LAS bf16_t* Cs = (LAS bf16_t*)lds; LAS bf16_t* Bs = Cs + 128 * 136; LAS bf16_t* XT = Bs + 128 * 136; LAS bf16_t* Pv = XT + 128 * 136;
    LAS float* dts = (LAS float*)(Pv + 128 * 136); LAS float* acs = dts + 256;
    const int tok0 = b * SEQ + c * 128; const bf16_t* proj = (const bf16_t*)(p.ws + WS_PROJ);
    ssd_dt_acum(p, l, tok0, g, dts, acs, wave, lane);
    stage_conv(p, l, Cs, 136, tok0, c * 128, 512 + g * 128, tid);
    stage_conv(p, l, Bs, 136, tok0, c * 128, 256 + g * 128, tid);
    stage_conv_t(p, l, XT, 136, tok0, c * 128, g * 128, nullptr, tid);
    { const float* prev = (const float*)(p.ws + WS_SST) + ((size_t)((b * 32 + c) * 4 + 2 * g)) * 8192;
      for (int e = tid; e < 128 * 32; e += NTHR) { const int r = e >> 5, n4 = (e & 31) * 4; const f32x4 v = *(const f32x4*)(prev + r * 128 + n4);
          u32x2 w; w.x = pk2(v[0], v[1]); w.y = pk2(v[2], v[3]); *(LAS u32x2*)(Pv + r * 136 + n4) = w; } }
    __syncthreads();
    const int fr = lane & 15, quad = lane >> 4, i = wave * 16 + fr, smax = (wave * 16 + 15) >> 5;
    const int dq = 8 * quad - fr; const LAS float* acq = acs + 8 * quad; const LAS float* dtq = dts + 8 * quad;
    bf16x8_t cf[4];
#pragma unroll
    for (int ks = 0; ks < 4; ++ks) cf[ks] = *(const LAS bf16x8_t*)(Cs + i * 136 + ks * 32 + quad * 8);
    f32x4 cbt[4][2];
#pragma unroll
    for (int s = 0; s < 4; ++s)
#pragma unroll
        for (int u = 0; u < 2; ++u) { f32x4 a = (f32x4){0.f, 0.f, 0.f, 0.f};
            if (s <= smax) { const int j = 32 * s + 8 * (fr >> 2) + 4 * u + (fr & 3);
#pragma unroll
                for (int ks = 0; ks < 4; ++ks) { const bf16x8_t bfv = *(const LAS bf16x8_t*)(Bs + j * 136 + ks * 32 + quad * 8); a = MFMA16(bfv, cf[ks], a); } }
#pragma unroll
            for (int jj = 0; jj < 4; ++jj) a[jj] = (dq <= 16 * wave - 32 * s - 4 * u - jj) ? a[jj] : 0.f;
            cbt[s][u] = a; asm volatile("" ::: "memory"); }
    float y[2][4][4];
#pragma unroll
    for (int hh = 0; hh < 2; ++hh) {
        const float ai = acs[hh * 128 + i];
        f32x4 o[4], o2[4];
#pragma unroll
        for (int pt = 0; pt < 4; ++pt) { o[pt] = (f32x4){0.f, 0.f, 0.f, 0.f}; o2[pt] = (f32x4){0.f, 0.f, 0.f, 0.f}; }
#pragma unroll
        for (int s = 0; s < 4; ++s) if (s <= smax) { float e[8];
#pragma unroll
            for (int u = 0; u < 2; ++u)
#pragma unroll
                for (int jj = 0; jj < 4; ++jj) { const int jo = hh * 128 + 32 * s + 4 * u + jj;
                    e[u * 4 + jj] = cbt[s][u][jj] * __expf(fminf(ai - acq[jo], 0.f)) * dtq[jo]; }
            u32x4 w; w.x = pk2(e[0], e[1]); w.y = pk2(e[2], e[3]); w.z = pk2(e[4], e[5]); w.w = pk2(e[6], e[7]); const bf16x8_t pb = __builtin_bit_cast(bf16x8_t, w);
#pragma unroll
            for (int pt = 0; pt < 4; ++pt) { const bf16x8_t xf = *(const LAS bf16x8_t*)(XT + (hh * 64 + pt * 16 + fr) * 136 + 32 * s + 8 * quad); o[pt] = MFMA16(xf, pb, o[pt]); } asm volatile("" ::: "memory"); }
#pragma unroll
        for (int ks = 0; ks < 4; ++ks) {
#pragma unroll
            for (int pt = 0; pt < 4; ++pt) { const bf16x8_t pf = *(const LAS bf16x8_t*)(Pv + (hh * 64 + pt * 16 + fr) * 136 + ks * 32 + quad * 8); o2[pt] = MFMA16(pf, cf[ks], o2[pt]); }
            asm volatile("" ::: "memory"); }
        const float ea = __expf(ai);
#pragma unroll
        for (int pt = 0; pt < 4; ++pt)
#pragma unroll
            for (int jj = 0; jj < 4; ++jj) y[hh][pt][jj] = o[pt][jj] + ea * o2[pt][jj];
    }
    float s2 = 0.f;
#pragma unroll
    for (int hh = 0; hh < 2; ++hh) { const float dsk = p.in[10][l * 4 + 2 * g + hh];
#pragma unroll
        for (int pt = 0; pt < 4; ++pt) { const int ch = hh * 64 + pt * 16 + quad * 4;
            const u32x2 zw = *(const u32x2*)(proj + (size_t)(tok0 + i) * PP + BZ + g * 128 + ch);
            const float z4[4] = {lo16(zw.x), hi16(zw.x), lo16(zw.y), hi16(zw.y)};
#pragma unroll
            for (int jj = 0; jj < 4; ++jj) { const float xv = bf2f(XT[(ch + jj) * 136 + i]); const float v = (y[hh][pt][jj] + dsk * xv) * silu_f(z4[jj]); y[hh][pt][jj] = v; s2 += v * v; } } }
    s2 += __shfl_xor(s2, 16); s2 += __shfl_xor(s2, 32);
    const float rs = rsqrtf(s2 * (1.0f / 128.0f) + EPS);
    bf16_t* yo = (bf16_t*)(p.ws + WS_YCAT) + (size_t)(tok0 + i) * DM + 256 + g * 128;
#pragma unroll
    for (int hh = 0; hh < 2; ++hh)
#pragma unroll
        for (int pt = 0; pt < 4; ++pt) { const int ch = hh * 64 + pt * 16 + quad * 4; const f32x4 ng = *(const f32x4*)(p.in[11] + l * 256 + g * 128 + ch);
            u32x2 w; w.x = pk2(y[hh][pt][0] * rs * ng[0], y[hh][pt][1] * rs * ng[1]); w.y = pk2(y[hh][pt][2] * rs * ng[2], y[hh][pt][3] * rs * ng[3]); *(u32x2*)(yo + ch) = w; }
    __syncthreads();
}

DI void ssd_states_unit(const Params& p, int l, int b, int c, int g, LAS unsigned char* lds, int tid, int wave, int lane) {
    LAS bf16_t* Xs = (LAS bf16_t*)lds; LAS bf16_t* Bs = Xs + 128 * 136;
    LAS float* dts = (LAS float*)(Bs + 128 * 136); LAS float* acs = dts + 256; LAS float* wsc = acs + 256;
    const int tok0 = b * SEQ + c * 128;
    ssd_dt_acum(p, l, tok0, g, dts, acs, wave, lane);
    stage_conv(p, l, Xs, 136, tok0, c * 128, g * 128, tid);
    stage_conv(p, l, Bs, 136, tok0, c * 128, 256 + g * 128, tid);
    __syncthreads();
    if (tid < 256) { const int hh = tid >> 7, j = tid & 127; wsc[tid] = __expf(acs[hh * 128 + 127] - acs[hh * 128 + j]) * dts[hh * 128 + j]; }
    if (tid < 2) ((float*)(p.ws + WS_CDEC))[(b * 32 + c) * 4 + 2 * g + tid] = __expf(acs[tid * 128 + 127]);
    __syncthreads();
    const int r = tid >> 2, q = tid & 3, hh = r >> 6;
    float acc[32];
#pragma unroll
    for (int i = 0; i < 32; ++i) acc[i] = 0.f;
    for (int j = 0; j < 128; ++j) { const float coef = bf2f(Xs[j * 136 + r]) * wsc[hh * 128 + j]; axpy_row<32>(acc, coef, Bs + j * 136 + q * 32); }
    float* dst = (float*)(p.ws + WS_SST) + ((size_t)((b * 32 + c) * 4 + 2 * g + hh)) * 8192 + (r & 63) * 128 + q * 32;
#pragma unroll
    for (int i = 0; i < 32; i += 4) *(f32x4*)(dst + i) = (f32x4){acc[i], acc[i + 1], acc[i + 2], acc[i + 3]};
    __syncthreads();
}

DI void ret_states_unit(const Params& p, int b, int c, LAS unsigned char* lds, int tid) {
    LAS bf16_t* Ks = (LAS bf16_t*)lds; LAS bf16_t* Vs = Ks + 128 * 264;
    const int tok0 = b * SEQ + c * 128; const bf16_t* proj = (const bf16_t*)(p.ws + WS_PROJ);
    for (int e = tid; e < 128 * 32; e += NTHR) { const int j = e >> 5, c8 = (e & 31) * 8;
        *(LAS u32x4*)(Ks + j * 264 + c8) = *(const u32x4*)(proj + (size_t)(tok0 + j) * PP + CK + c8);
        *(LAS u32x4*)(Vs + j * 264 + c8) = *(const u32x4*)(proj + (size_t)(tok0 + j) * PP + CV + c8); }
    __syncthreads();
    const int h = tid >> 7, d = (tid >> 1) & 63, eh = tid & 1;
    const float lg = log2f(1.0f - exp2f(-5.0f - (float)h));
    float acc[32];
#pragma unroll
    for (int i = 0; i < 32; ++i) acc[i] = 0.f;
    for (int j = 0; j < 128; ++j) { const float coef = bf2f(Ks[j * 264 + h * 64 + d]) * exp2f((float)(127 - j) * lg); axpy_row<32>(acc, coef, Vs + j * 264 + h * 64 + eh * 32); }
    float* dst = (float*)(p.ws + WS_RST) + ((size_t)((b * 32 + c) * 4 + h)) * 4096 + d * 64 + eh * 32;
#pragma unroll
    for (int i = 0; i < 32; i += 4) *(f32x4*)(dst + i) = (f32x4){acc[i], acc[i + 1], acc[i + 2], acc[i + 3]};
    __syncthreads();
}

DI void conv_unit(const Params& p, int l, int b, int s0, LAS unsigned char* lds, int tid, int wave, int lane) {
    LAS bf16_t* Hs = (LAS bf16_t*)lds;
    LAS float* Os = (LAS float*)(lds + 94 * 256 * 2);
    const bf16_t* proj = (const bf16_t*)(p.ws + WS_PROJ);
    for (int e = tid; e < 94 * 32; e += NTHR) { const int r = e >> 5, c8 = (e & 31) * 8; const int s = s0 - 30 + r;
        u32x4 v = (u32x4){0u, 0u, 0u, 0u};
        if (s >= 0) v = *(const u32x4*)(proj + (size_t)(b * SEQ + s) * PP + DV + c8);
        *(LAS u32x4*)(Hs + r * 256 + c8) = v; }
    __syncthreads();
    { const int ch = tid & 255, half = tid >> 8;
      const float* w = p.in[12] + (size_t)l * 31 * 256 + ch; const float bias = p.in[13][l * 256 + ch];
      float wr[31];
#pragma unroll
      for (int k = 0; k < 31; ++k) wr[k] = w[k * 256];
      for (int tt = 0; tt < 32; ++tt) { const int t = half * 32 + tt; float a = bias;
#pragma unroll
          for (int k = 0; k < 31; ++k) a += wr[k] * bf2f(Hs[(t + k) * 256 + ch]);
          Os[t * 256 + ch] = a; } }
    __syncthreads();
    const f32x4 lg = *(const f32x4*)(p.in[14] + l * 256 + lane * 4), lb = *(const f32x4*)(p.in[15] + l * 256 + lane * 4);
    bf16_t* ycat = (bf16_t*)(p.ws + WS_YCAT);
    for (int tt = 0; tt < 8; ++tt) { const int t = wave * 8 + tt; const f32x4 v = *(const LAS f32x4*)(Os + t * 256 + lane * 4);
        const float mean = wave_sum((v[0] + v[1]) + (v[2] + v[3])) * (1.0f / 256.0f);
        const f32x4 d = v - mean; const float var = wave_sum((d[0] * d[0] + d[1] * d[1]) + (d[2] * d[2] + d[3] * d[3])) * (1.0f / 256.0f);
        const float rs = rsqrtf(var + EPS); f32x4 o = d * rs * lg + lb;
        u32x2 w; w.x = pk2(silu_f(o[0]), silu_f(o[1])); w.y = pk2(silu_f(o[2]), silu_f(o[3]));
        *(u32x2*)(ycat + (size_t)(b * SEQ + s0 + t) * DM + 768 + lane * 4) = w; }
    __syncthreads();
}

DI void attn_task(const Params& p, int tok, int hd, int lane, LAS float* qs) {
    const bf16_t* proj = (const bf16_t*)(p.ws + WS_PROJ);
    const int pos = tok & (SEQ - 1); const size_t rowbase = (size_t)(tok - pos);
    qs[lane] = bf2f(proj[(size_t)tok * PP + AQ + hd * 64 + lane]);
    float sc[7];
#pragma unroll
    for (int ps = 0; ps < 7; ++ps) { const int e = ps * 64 + lane; const int pat = e / 129, j = e - pat * 129; const int kp = pos - (j << (2 * pat));
        const bool valid = (e < 387) && (kp >= 0); float s = 0.f;
        if (valid) { const u32x4* kr = (const u32x4*)(proj + (rowbase + kp) * PP + AK + hd * 64);
#pragma unroll
            for (int c = 0; c < 8; ++c) { float kf[8]; unpack8(kr[c], kf); const f32x4 q0 = *(const LAS f32x4*)(qs + c * 8), q1 = *(const LAS f32x4*)(qs + c * 8 + 4);
                s += (q0[0] * kf[0] + q0[1] * kf[1]) + (q0[2] * kf[2] + q0[3] * kf[3]) + (q1[0] * kf[4] + q1[1] * kf[5]) + (q1[2] * kf[6] + q1[3] * kf[7]); } }
        sc[ps] = valid ? s : -INFINITY; }
    float mx = sc[0];
#pragma unroll
    for (int ps = 1; ps < 7; ++ps) mx = fmaxf(mx, sc[ps]);
    mx = wave_max(mx);
    float z = 0.f; int pr[7];
#pragma unroll
    for (int ps = 0; ps < 7; ++ps) { const float e = (sc[ps] == -INFINITY) ? 0.f : __expf(sc[ps] - mx); z += e; pr[ps] = __float_as_int(e); }
    z = wave_sum(z);
    float o = 0.f;
    const bf16_t* vb = proj + rowbase * PP + AV + hd * 64 + lane;
#pragma unroll
    for (int ps = 0; ps < 7; ++ps) {
        const int nl = ps == 6 ? 3 : 64;
#pragma unroll 8
        for (int ln = 0; ln < nl; ++ln) { const int e = ps * 64 + ln; const int pat = e / 129, j = e - pat * 129; int kp = pos - (j << (2 * pat));
            const bool ok = kp >= 0; kp = ok ? kp : pos;
            const float pe = ok ? __int_as_float(__builtin_amdgcn_readlane(pr[ps], ln)) : 0.f;
            o += pe * bf2f(vb[(size_t)kp * PP]); } }
    ((bf16_t*)(p.ws + WS_YCAT))[(size_t)tok * DM + hd * 64 + lane] = (bf16_t)f2bf(o / z);
}

DI void scan_phase(const Params& p, int gt, int NT) {
    float* sst = (float*)(p.ws + WS_SST); const float* cdec = (const float*)(p.ws + WS_CDEC);
    for (int i = gt; i < NB * 4 * 8192; i += NT) { const int b = i >> 15, rem = i & 32767, h = rem >> 13, pn = rem & 8191; float run = 0.f;
#pragma unroll 8
        for (int c = 0; c < 32; ++c) { const size_t idx = ((size_t)((b * 32 + c) * 4 + h)) * 8192 + pn; const float st = sst[idx]; sst[idx] = run; run = cdec[(b * 32 + c) * 4 + h] * run + st; } }
    float* rst = (float*)(p.ws + WS_RST);
    for (int i = gt; i < NB * 4 * 4096; i += NT) { const int b = i >> 14, rem = i & 16383, h = rem >> 12, de = rem & 4095; float run = 0.f;
        const float gc = exp2f(128.0f * log2f(1.0f - exp2f(-5.0f - (float)h)));
#pragma unroll 8
        for (int c = 0; c < 32; ++c) { const size_t idx = ((size_t)((b * 32 + c) * 4 + h)) * 4096 + de; const float st = rst[idx]; rst[idx] = run; run = gc * run + st; } }
}

DI void ssd_y_unit(const Params& p, int l, int b, int c, int g, LAS unsigned char* lds, int tid, int wave, int lane) {
    LAS bf16_t* Cs = (LAS bf16_t*)lds; LAS bf16_t* Bs = Cs + 128 * 136;
    LAS float* CB = (LAS float*)(Bs + 128 * 136); LAS bf16_t* Pv = (LAS bf16_t*)CB;
    LAS float* dts = CB + 128 * 132; LAS float* acs = dts + 256;
    const int tok0 = b * SEQ + c * 128; const bf16_t* proj = (const bf16_t*)(p.ws + WS_PROJ);
    ssd_dt_acum(p, l, tok0, g, dts, acs, wave, lane);
    stage_conv(p, l, Cs, 136, tok0, c * 128, 512 + g * 128, tid);
    { const float* prev = (const float*)(p.ws + WS_SST) + ((size_t)((b * 32 + c) * 4 + 2 * g)) * 8192;
      for (int e = tid; e < 128 * 32; e += NTHR) { const int r = e >> 5, n4 = (e & 31) * 4; const f32x4 v = *(const f32x4*)(prev + r * 128 + n4);
          u32x2 w; w.x = pk2(v[0], v[1]); w.y = pk2(v[2], v[3]); *(LAS u32x2*)(Pv + r * 136 + (r >> 5) * 8 + n4) = w; } }
    __syncthreads();
    const int i = tid >> 2, q = tid & 3, hh = q >> 1;
    float y[32];
#pragma unroll
    for (int cc = 0; cc < 32; ++cc) y[cc] = 0.f;
    nt_acc<32, 128>(y, Cs + i * 136, Pv + (q * 32) * 136 + q * 8, 136);
    { const float ea = __expf(acs[hh * 128 + i]);
#pragma unroll
      for (int cc = 0; cc < 32; ++cc) y[cc] *= ea; }
    __syncthreads();
    stage_conv(p, l, Bs, 136, tok0, c * 128, 256 + g * 128, tid);
    __syncthreads();
    { float cb[32];
#pragma unroll
      for (int cc = 0; cc < 32; ++cc) cb[cc] = 0.f;
      nt_acc<32, 128>(cb, Cs + i * 136, Bs + q * 136, 4 * 136);
#pragma unroll
      for (int cc = 0; cc < 32; ++cc) CB[i * 132 + cc * 4 + q] = cb[cc]; }
    __syncthreads();
    stage_conv(p, l, Bs, 136, tok0, c * 128, g * 128, tid);
    __syncthreads();
    { const float ai = acs[hh * 128 + i]; const int jmax = wave * 16 + 15;
      for (int j = 0; j <= jmax; ++j) { const float m = (j <= i) ? CB[i * 132 + j] * __expf(ai - acs[hh * 128 + j]) * dts[hh * 128 + j] : 0.f; axpy_row<32>(y, m, Bs + j * 136 + q * 32); } }
    { const int head = 2 * g + hh; const float dsk = p.in[10][l * 4 + head]; float xs[32];
#pragma unroll
      for (int c8 = 0; c8 < 32; c8 += 8) { float t8[8]; unpack8(*(const LAS u32x4*)(Bs + i * 136 + q * 32 + c8), t8);
#pragma unroll
          for (int e = 0; e < 8; ++e) xs[c8 + e] = t8[e]; }
      const bf16_t* zp = proj + (size_t)(tok0 + i) * PP + BZ + g * 128 + q * 32; float s2 = 0.f;
#pragma unroll
      for (int c8 = 0; c8 < 32; c8 += 8) { float z8[8]; unpack8(*(const u32x4*)(zp + c8), z8);
#pragma unroll
          for (int e = 0; e < 8; ++e) { const float v = (y[c8 + e] + dsk * xs[c8 + e]) * silu_f(z8[e]); y[c8 + e] = v; s2 += v * v; } }
      s2 += __shfl_xor(s2, 1); s2 += __shfl_xor(s2, 2);
      const float rs = rsqrtf(s2 * (1.0f / 128.0f) + EPS);
      const float* ng = p.in[11] + l * 256 + g * 128 + q * 32;
      bf16_t* yo = (bf16_t*)(p.ws + WS_YCAT) + (size_t)(tok0 + i) * DM + 256 + g * 128 + q * 32;
#pragma unroll
      for (int c8 = 0; c8 < 32; c8 += 8) { u32x4 w; w.x = pk2(y[c8] * rs * ng[c8], y[c8 + 1] * rs * ng[c8 + 1]); w.y = pk2(y[c8 + 2] * rs * ng[c8 + 2], y[c8 + 3] * rs * ng[c8 + 3]);
          w.z = pk2(y[c8 + 4] * rs * ng[c8 + 4], y[c8 + 5] * rs * ng[c8 + 5]); w.w = pk2(y[c8 + 6] * rs * ng[c8 + 6], y[c8 + 7] * rs * ng[c8 + 7]); *(u32x4*)(yo + c8) = w; } }
    __syncthreads();
}

DI void ret_y_unit(const Params& p, int b, int c, int h, LAS unsigned char* lds, int tid, int wave) {
    LAS bf16_t* Qs = (LAS bf16_t*)lds; LAS bf16_t* Ks = Qs + 128 * 72; LAS bf16_t* Vs = Ks + 128 * 72;
    LAS float* Pr = (LAS float*)(Vs + 128 * 72); LAS float* S = Pr + 64 * 64;
    const int tok0 = b * SEQ + c * 128; const bf16_t* proj = (const bf16_t*)(p.ws + WS_PROJ);
    for (int e = tid; e < 128 * 8; e += NTHR) { const int j = e >> 3, c8 = (e & 7) * 8; const bf16_t* rp = proj + (size_t)(tok0 + j) * PP + h * 64 + c8;
        *(LAS u32x4*)(Qs + j * 72 + c8) = *(const u32x4*)(rp + CQ); *(LAS u32x4*)(Ks + j * 72 + c8) = *(const u32x4*)(rp + CK); *(LAS u32x4*)(Vs + j * 72 + c8) = *(const u32x4*)(rp + CV); }
    { const float* prev = (const float*)(p.ws + WS_RST) + ((size_t)((b * 32 + c) * 4 + h)) * 4096;
      for (int e = tid; e < 1024; e += NTHR) *(LAS f32x4*)(Pr + e * 4) = *(const f32x4*)(prev + e * 4); }
    __syncthreads();
    const int i = tid >> 2, q = tid & 3; const float lg = log2f(1.0f - exp2f(-5.0f - (float)h));
    { float s[32];
#pragma unroll
      for (int cc = 0; cc < 32; ++cc) s[cc] = 0.f;
      nt_acc<32, 64>(s, Qs + i * 72, Ks + q * 72, 4 * 72);
#pragma unroll
      for (int cc = 0; cc < 32; ++cc) { const int j = cc * 4 + q; S[i * 132 + j] = (j <= i) ? s[cc] * exp2f((float)(i - j) * lg) : 0.f; } }
    __syncthreads();
    float y[16];
#pragma unroll
    for (int cc = 0; cc < 16; ++cc) y[cc] = 0.f;
    for (int d = 0; d < 64; ++d) { const float qv = bf2f(Qs[i * 72 + d]);
#pragma unroll
        for (int c4 = 0; c4 < 16; c4 += 4) { const f32x4 pv = *(const LAS f32x4*)(Pr + d * 64 + q * 16 + c4); y[c4] += qv * pv[0]; y[c4 + 1] += qv * pv[1]; y[c4 + 2] += qv * pv[2]; y[c4 + 3] += qv * pv[3]; } }
    { const float xi = exp2f((float)(i + 1) * lg);
#pragma unroll
      for (int cc = 0; cc < 16; ++cc) y[cc] *= xi; }
    { const int jmax = wave * 16 + 15;
      for (int j = 0; j <= jmax; ++j) axpy_row<16>(y, S[i * 132 + j], Vs + j * 72 + q * 16); }
    float s2 = 0.f;
#pragma unroll
    for (int cc = 0; cc < 16; ++cc) s2 += y[cc] * y[cc];
    s2 += __shfl_xor(s2, 1); s2 += __shfl_xor(s2, 2);
    const float rs = rsqrtf(s2 * (1.0f / 64.0f) + EPS);
    const bf16_t* gp = proj + (size_t)(tok0 + i) * PP + CG + h * 64 + q * 16;
    bf16_t* yo = (bf16_t*)(p.ws + WS_YCAT) + (size_t)(tok0 + i) * DM + 512 + h * 64 + q * 16;
#pragma unroll
    for (int c8 = 0; c8 < 16; c8 += 8) { float g8[8]; unpack8(*(const u32x4*)(gp + c8), g8); u32x4 w;
        w.x = pk2(y[c8] * rs * silu_f(g8[0]), y[c8 + 1] * rs * silu_f(g8[1])); w.y = pk2(y[c8 + 2] * rs * silu_f(g8[2]), y[c8 + 3] * rs * silu_f(g8[3]));
        w.z = pk2(y[c8 + 4] * rs * silu_f(g8[4]), y[c8 + 5] * rs * silu_f(g8[5])); w.w = pk2(y[c8 + 6] * rs * silu_f(g8[6]), y[c8 + 7] * rs * silu_f(g8[7])); *(u32x4*)(yo + c8) = w; }
    __syncthreads();
}

#define SSB ((float*)(ws + WS_SS))
#define XB ((bf16_t*)(ws + WS_XB))
#define YC ((bf16_t*)(ws + WS_YCAT))
#define PROJ ((bf16_t*)(ws + WS_PROJ))
#define HB ((bf16_t*)(ws + WS_H))
#define PE ((bf16_t*)(ws + WS_PE))

#define CAS4 __attribute__((address_space(4)))
#define RELOAD_P() const CAS4 Params* kp_ = (const CAS4 Params*)__builtin_amdgcn_kernarg_segment_ptr(); asm volatile("" : "+s"(kp_)); const Params& p = *(const Params*)kp_; unsigned char* ws = p.ws; (void)ws
#define FRESH_LANE(v) int v; asm volatile("v_mbcnt_lo_u32_b32 %0, -1, 0\n\tv_mbcnt_hi_u32_b32 %0, -1, %0" : "=v"(v))
#define RELOAD_IDS() RELOAD_P(); FRESH_LANE(lane_); const int lane = lane_, wave = wave_s, tid = wave_s * 64 + lane_; const int gw = blk * NWV + wave, gt = blk * NTHR + tid; (void)gw; (void)gt; (void)lane
#define GEMM_TID() ({ FRESH_LANE(l_); wave_s * 64 + l_; })
#define GBAR() do { ++nbar; asm volatile("s_waitcnt vmcnt(0)" ::: "memory"); __syncthreads(); { FRESH_LANE(l_); if (wave_s == 0 && l_ == 0) { RELOAD_P(); unsigned* bar = (unsigned*)(ws + WS_BAR); \
        const bool grouped = (G & 15) == 0; const unsigned gsz = grouped ? (unsigned)G >> 4 : (unsigned)G, ngrp = grouped ? 16u : 1u; unsigned* gc = bar + 64 + 64 * (grouped ? (blk & 15) : 0); \
        __builtin_amdgcn_fence(__ATOMIC_RELEASE, "agent"); \
        const unsigned old = __hip_atomic_fetch_add(gc, 1u, __ATOMIC_RELAXED, __HIP_MEMORY_SCOPE_AGENT); \
        if (old + 1u == nbar * gsz) __hip_atomic_fetch_add(bar, 1u, __ATOMIC_RELAXED, __HIP_MEMORY_SCOPE_AGENT); \
        const unsigned target = nbar * ngrp; \
        while (__hip_atomic_load(bar, __ATOMIC_RELAXED, __HIP_MEMORY_SCOPE_AGENT) < target) __builtin_amdgcn_s_sleep(1); \
        __builtin_amdgcn_fence(__ATOMIC_ACQUIRE, "agent"); } } __syncthreads(); } while (0)
#define SS_IN (SSB + (l == 0 ? 0 : 3 * M))
#define SSA (SSB + (1 + 3 * l) * M)
#define SSBB (SSB + (2 + 3 * l) * M)
#define SSC (SSB + (3 + 3 * l) * M)
template <int l> DI void run_layer(LAS unsigned char* lds, const int G, const int blk, const int NGW, const int NT, const int wave_s, unsigned& nbar) {

        { RELOAD_P(); pg8::Gemm g{l == 0 ? XB : YC, (const bf16_t*)(ws + WS_WIN), M, PP, DM}; pg8::StaticOrder S; S.init(M, PP, G, blk);
          pg8::EpiScale<0> E{PROJ, PP, SS_IN};
          pg8::gemm_phase<pg8::EpiScale<0>, pg8::StaticOrder, true, true>(lds, g, S, E, GEMM_TID()); }
        GBAR();
        { RELOAD_IDS(); for (int t = blk; t < 256; t += G) e1_tile(p, l, t, lds, tid, wave, lane); }
        GBAR();
        { RELOAD_IDS(); for (int u = blk; u < 256; u += G) ssd_states_mfma(p, l, u >> 6, (u >> 1) & 31, u & 1, lds, tid, wave, lane); }
        { RELOAD_IDS(); for (int u = blk; u < 128; u += G) ret_states_unit(p, u >> 5, u & 31, lds, tid); }
        { RELOAD_IDS(); for (int u = blk; u < 256; u += G) conv_unit(p, l, u >> 6, (u & 63) * 64, lds, tid, wave, lane); }
        { RELOAD_IDS(); for (int ub = blk; ub < 256; ub += G) { const int bh = ub >> 4, seg = ub & 15;
            for (int it = 0; it < 6; ++it) { const int task = it * 8 + wave, pat = task >> 4, k = task & 15;
                const int r = pat == 0 ? 0 : (pat == 1 ? (k >> 2) : k); const int i0 = pat == 0 ? seg * 256 + k * 16 : (pat == 1 ? seg * 64 + (k & 3) * 16 : seg * 16);
                attn_tile(p, bh >> 2, bh & 3, pat, r, i0, lane); } } }
        GBAR();
        { RELOAD_IDS(); scan_phase(p, gt, NT); attn_combine(p, gt, NT); }
        GBAR();
        { RELOAD_IDS(); for (int u = blk; u < 256; u += G) ssd_y_mfma(p, l, u >> 6, (u >> 1) & 31, u & 1, lds, tid, wave, lane); }
        { RELOAD_IDS(); for (int u = blk; u < 512; u += G) ret_y_unit(p, u >> 7, (u >> 2) & 31, u & 3, lds, tid, wave); }
        GBAR();
        { RELOAD_P(); pg8::Gemm g{YC, (const bf16_t*)(ws + WS_WOUT), M, DM, DM}; pg8::StaticOrder S; S.init(M, DM, G, blk);
          pg8::EpiRes<0> E{l == 0 ? p.in[0] : p.out, p.out, XB, SSA, DM, nullptr, nullptr};
          pg8::gemm_phase<pg8::EpiRes<0>, pg8::StaticOrder, true, true>(lds, g, S, E, GEMM_TID()); }
        GBAR();
        { RELOAD_P(); pg8::Gemm g{XB, (const bf16_t*)(ws + WS_WUP), M, FF, DM}; pg8::StaticOrder S; S.init(M, FF, G, blk);
          pg8::EpiScale<1> E{HB, FF, SSA};
          pg8::gemm_phase<pg8::EpiScale<1>, pg8::StaticOrder, true, true>(lds, g, S, E, GEMM_TID()); }
        GBAR();
        { RELOAD_P(); pg8::Gemm g{HB, (const bf16_t*)(ws + WS_WDOWN), M, DM, FF}; pg8::StaticOrder S; S.init(M, DM, G, blk);
          pg8::EpiRes<0> E{p.out, p.out, XB, SSBB, DM, nullptr, nullptr};
          pg8::gemm_phase<pg8::EpiRes<0>, pg8::StaticOrder, true, true>(lds, g, S, E, GEMM_TID()); }
        GBAR();
        if (l == 0) { RELOAD_IDS(); convert_weights(p, 1, 1, lds, gw, NGW, lane, wave); __syncthreads(); }
        { RELOAD_P(); pg8::Gemm g{(const bf16_t*)(ws + (l ? WS_PB1 : WS_PB0)), (const bf16_t*)(ws + (l ? WS_WPLE1 : WS_WPLE0)), M, DM, PLE}; pg8::StaticOrder S; S.init(M, DM, G, blk);
          pg8::EpiPe E{PE, DM};
          pg8::gemm_phase<pg8::EpiPe, pg8::StaticOrder, true, true>(lds, g, S, E, GEMM_TID()); }
        { RELOAD_P(); pg8::Gemm g{XB, (const bf16_t*)(ws + (l ? WS_WGATE1 : WS_WGATE0)), M, DM, DM}; pg8::StaticOrder S; S.init(M, DM, G, blk);
          pg8::EpiRes<1> E{p.out, p.out, YC, SSC, DM, PE, SSBB};
          pg8::gemm_phase<pg8::EpiRes<1>, pg8::StaticOrder, true, true>(lds, g, S, E, GEMM_TID()); }
        if (l == 0) GBAR();
    }

__global__ void __launch_bounds__(NTHR, 2) fwd_kernel(Params p_unused) {
    extern __shared__ __attribute__((aligned(16))) unsigned char lds_raw[];
    LAS unsigned char* lds = (LAS unsigned char*)lds_raw;
    cg::grid_group grid = cg::this_grid();
    const int G = gridDim.x, blk = blockIdx.x;
    const int NGW = G * NWV, NT = G * NTHR;
    const int wave_s = __builtin_amdgcn_readfirstlane(threadIdx.x >> 6);
    unsigned nbar = 0;
    { RELOAD_IDS();
    prologue(p, gw, NGW, lane);
    convert_weights(p, 0, 3, lds, gw, NGW, lane, wave);
    convert_weights(p, 1, 2, lds, gw, NGW, lane, wave); }
    grid.sync();

    run_layer<0>(lds, G, blk, NGW, NT, wave_s, nbar);
    run_layer<1>(lds, G, blk, NGW, NT, wave_s, nbar);
}

extern "C" void kernel_launch(void* const* d_in, const int* in_sizes, int n_in, void* d_out, int out_size, void* d_ws, size_t ws_size, hipStream_t stream) {
    static int grid = 0;
    if (grid == 0) {
        int dev = 0, cus = 0, per_cu = 0;
        hipGetDevice(&dev); hipDeviceGetAttribute(&cus, hipDeviceAttributeMultiprocessorCount, dev);
        if (hipFuncSetAttribute((const void*)fwd_kernel, hipFuncAttributeMaxDynamicSharedMemorySize, LDS_BYTES) != hipSuccess) { fprintf(stderr, "kernel_launch: hipFuncSetAttribute failed\n"); }
        if (hipOccupancyMaxActiveBlocksPerMultiprocessor(&per_cu, (const void*)fwd_kernel, NTHR, LDS_BYTES) != hipSuccess || per_cu < 1) { fprintf(stderr, "kernel_launch: occupancy query says %d\n", per_cu); per_cu = 1; }
        (void)hipGetLastError();
        grid = cus * (per_cu > 1 ? 1 : per_cu);
        if (n_in != 23 || ws_size < WS_END) { fprintf(stderr, "kernel_launch: unexpected n_in %d / ws %zu\n", n_in, ws_size); }
    }
    (void)hipMemsetAsync((unsigned char*)d_ws + WS_BAR, 0, 8192, stream);
    Params p{};
    for (int i = 0; i < 23; ++i) p.in[i] = (const float*)d_in[i];
    p.out = (float*)d_out; p.ws = (unsigned char*)d_ws;
    void* args[] = {&p};
    hipError_t e = hipLaunchCooperativeKernel((const void*)fwd_kernel, dim3(grid), dim3(NTHR), args, LDS_BYTES, stream);
    if (e != hipSuccess) fprintf(stderr, "cooperative launch failed: %s (grid %d)\n", hipGetErrorString(e), grid);
}
```

```cpp
#include <hip/hip_runtime.h>
#include <cstdio>
#include <cstdint>
namespace pg8 {
#define PG8_LAS __attribute__((address_space(3)))
typedef unsigned short bf16_t;
typedef short bf16x8 __attribute__((ext_vector_type(8)));
typedef float f32x4 __attribute__((ext_vector_type(4)));
typedef unsigned u32x4 __attribute__((ext_vector_type(4)));
constexpr int BM = 256, BK = 64, HALF = 128, HTB = HALF * BK * 2  , STAGE_BYTES = 8 * HTB, NXCD = 8, WGM = 8;

__host__ __device__ __forceinline__ int lds_byte(int r, int c) { const int st = (r >> 4) * 2 + (c >> 5), rr = r & 15, cc = c & 31, ob = rr * 64 + cc * 2; return st * 1024 + (ob ^ (((ob >> 9) & 1) << 5)); }
__host__ __device__ __forceinline__ void stage_rc(int b, int& R, int& C) { const int st = b / 1024, sb = b % 1024, swz = sb ^ (((sb >> 9) & 1) << 5); R = (st >> 1) * 16 + swz / 64; C = (st & 1) * 32 + (swz % 64) / 2; }
__host__ __device__ __forceinline__ int perm32(int rho) { const int n = rho >> 4, i = rho & 15; return 8 * (i >> 2) + 4 * n + (i & 3); }

struct Unit { int pm, pn; };
struct Gemm { const bf16_t* A; const bf16_t* Bt; int M, N, K; };

struct StaticOrder {
    int nM, nN, nwg, G, c;
    __host__ __device__ void init(int M, int N, int G_, int c_) { nM = M / BM; nN = N / BM; nwg = nM * nN; G = G_; c = c_; }
    __host__ __device__ bool next(int i, Unit& u) const {
        const long L = (long)i * G + c; if (L >= nwg) return false;
        int wgid = (int)L; { const int q = nwg / NXCD, r = nwg % NXCD, xcd = wgid % NXCD, off = wgid / NXCD; wgid = (xcd < r ? xcd * (q + 1) : r * (q + 1) + (xcd - r) * q) + off; }
        const int nig = WGM * nN, gid = wgid / nig, fm = gid * WGM, gsz = (nM - fm) < WGM ? (nM - fm) : WGM;
        u.pm = fm + ((wgid % nig) % gsz); u.pn = (wgid % nig) / gsz; return true;
    }
    __device__ __forceinline__ void a_ready(const Unit&) const {}
    __device__ __forceinline__ void done(const Unit&) const {}
};

__device__ __forceinline__ unsigned cvt_pk_bf16(float lo, float hi) { unsigned r; asm volatile("v_cvt_pk_bf16_f32 %0, %1, %2" : "=v"(r) : "v"(lo), "v"(hi)); return r; }

typedef unsigned u32x2 __attribute__((ext_vector_type(2)));
constexpr float RMS_EPS = 1e-6f;
template <int ACT> struct EpiScale {
    static constexpr bool PERM = true, AFTER_DRAIN = false;
    bf16_t* O; int ldc; const float* ss;
    __device__ __forceinline__ void operator()(const f32x4 (&acc)[2][2][4][2], const Unit& u, int wr, int wc, int fr, int fq) const {
        const int row0 = u.pm * BM + wr * 64 + fr; const int col0 = u.pn * BM + wc * 32 + 8 * fq;
#pragma unroll
        for (int ai = 0; ai < 2; ++ai)
#pragma unroll
            for (int m = 0; m < 4; ++m) { const int row = row0 + ai * HALF + m * 16; const float r = ss ? rsqrtf(ss[row] * (1.0f / 1024.0f) + RMS_EPS) : 1.0f;
                bf16_t* rowp = O + (size_t)row * ldc + col0;
#pragma unroll
                for (int bj = 0; bj < 2; ++bj) { f32x4 v0 = acc[ai][bj][m][0] * r, v1 = acc[ai][bj][m][1] * r;
                    if (ACT == 1) {
#pragma unroll
                        for (int e = 0; e < 4; ++e) { float a = fmaxf(v0[e], 0.f), b = fmaxf(v1[e], 0.f); v0[e] = a * a; v1[e] = b * b; } }
                    u32x4 w; w.x = cvt_pk_bf16(v0[0], v0[1]); w.y = cvt_pk_bf16(v0[2], v0[3]); w.z = cvt_pk_bf16(v1[0], v1[1]); w.w = cvt_pk_bf16(v1[2], v1[3]);
                    *(u32x4*)(rowp + bj * HALF) = w; }
                asm volatile("" ::: "memory"); }
    }
};
struct EpiPe {
    static constexpr bool PERM = false, AFTER_DRAIN = false;
    bf16_t* O; int ldc;
    __device__ __forceinline__ void operator()(const f32x4 (&acc)[2][2][4][2], const Unit& u, int wr, int wc, int fr, int fq) const {
        const int col0 = u.pn * BM + wc * 32 + 4 * fq;
#pragma unroll
        for (int ai = 0; ai < 2; ++ai)
#pragma unroll
            for (int m = 0; m < 4; ++m) { const size_t off = (size_t)(u.pm * BM + ai * HALF + wr * 64 + m * 16 + fr) * ldc + col0;
#pragma unroll
                for (int bj = 0; bj < 2; ++bj)
#pragma unroll
                    for (int n = 0; n < 2; ++n) { const f32x4 v = acc[ai][bj][m][n]; u32x2 w; w.x = cvt_pk_bf16(v[0], v[1]); w.y = cvt_pk_bf16(v[2], v[3]);
                        *(u32x2*)(O + off + bj * HALF + n * 16) = w; } }
    }
};
template <int GATE> struct EpiRes {
    static constexpr bool PERM = false, AFTER_DRAIN = false;
    const float* base; float* out; bf16_t* xb; float* ssout; int ldc; const bf16_t* pe; const float* ss;
    __device__ __forceinline__ void operator()(const f32x4 (&acc)[2][2][4][2], const Unit& u, int wr, int wc, int fr, int fq) const {
        const int col0 = u.pn * BM + wc * 32 + 4 * fq;
#pragma unroll
        for (int ai = 0; ai < 2; ++ai)
#pragma unroll
            for (int m = 0; m < 4; ++m) { const int row = u.pm * BM + ai * HALF + wr * 64 + m * 16 + fr; const size_t off = (size_t)row * ldc + col0; float s = 0.f;
                float r = 1.f; if (GATE) r = rsqrtf(ss[row] * (1.0f / 1024.0f) + RMS_EPS);
#pragma unroll
                for (int bj = 0; bj < 2; ++bj)
#pragma unroll
                    for (int n = 0; n < 2; ++n) { const size_t o2 = off + bj * HALF + n * 16; const f32x4 bs = *(const f32x4*)(base + o2); f32x4 a = acc[ai][bj][m][n];
                        if (GATE) { const u32x2 pw = *(const u32x2*)(pe + o2);
                            const float p0 = __uint_as_float(pw.x << 16), p1 = __uint_as_float(pw.x & 0xffff0000u), p2 = __uint_as_float(pw.y << 16), p3 = __uint_as_float(pw.y & 0xffff0000u);
                            a[0] = p0 / (1.f + __expf(-a[0] * r)); a[1] = p1 / (1.f + __expf(-a[1] * r)); a[2] = p2 / (1.f + __expf(-a[2] * r)); a[3] = p3 / (1.f + __expf(-a[3] * r)); }
                        const f32x4 o = bs + a; *(f32x4*)(out + o2) = o;
                        u32x2 w; w.x = cvt_pk_bf16(o[0], o[1]); w.y = cvt_pk_bf16(o[2], o[3]); *(u32x2*)(xb + o2) = w;
                        s += (o[0] * o[0] + o[1] * o[1]) + (o[2] * o[2] + o[3] * o[3]); }
                s += __shfl_xor(s, 16); s += __shfl_xor(s, 32);
                if (fq == 0) atomicAdd(ssout + row, s);
                asm volatile("" ::: "memory"); }
    }
};
template <class Epi, class Sched, bool ALIGN_EPI = false, bool SP2 = false>
__device__ __forceinline__ void gemm_phase(PG8_LAS unsigned char* lds, const Gemm g, const Sched& S, const Epi& E, int tid_) {
    const int tid = tid_, wid = __builtin_amdgcn_readfirstlane(tid >> 6), lane = tid & 63, wr = wid >> 2, wc = wid & 3, fr = lane & 15, fq = lane >> 4;
    const int K = g.K, nt = K / BK;
    unsigned voffA[2], voffB[2];
#pragma unroll
    for (int i = 0; i < 2; ++i) { int R, C; stage_rc(tid * 16 + i * 8192, R, C); const int Rb = Epi::PERM ? ((R & ~31) + perm32(R & 31)) : R;
        voffA[i] = (unsigned)(R * K + C) * 2u; voffB[i] = (unsigned)(Rb * K + C) * 2u; }
    const size_t kstep = (size_t)(BK * 2);
    const size_t hstep = (size_t)HALF * K * 2;
    const size_t tstep = 2 * hstep;
    const unsigned ldsw = (unsigned)wid * 1024u;
    const int aoff = lds_byte(wr * 64 + fr, fq * 8), boff = lds_byte(wc * 32 + fr, fq * 8);
#define PG8_SA(b, h) (((b) * 2 + (h)) * HTB)
#define PG8_SB(b, h) ((4 + (b) * 2 + (h)) * HTB)
#define PG8_STAGE(bufoff, gbase, voff) do { _Pragma("unroll") for (int _i = 0; _i < 2; ++_i) \
        __builtin_amdgcn_global_load_lds((const unsigned*)((const char*)(gbase) + (voff)[_i]), (PG8_LAS unsigned*)(lds + (bufoff) + ldsw + _i * 8192), 16, 0, 0); } while (0)
#define PG8_LDA(dst, b, h) do { _Pragma("unroll") for (int m = 0; m < 4; ++m) _Pragma("unroll") for (int k = 0; k < 2; ++k) dst[m][k] = *(const PG8_LAS bf16x8*)(lds + PG8_SA(b, h) + aoff + m * 2048 + k * 1024); } while (0)
#define PG8_LDB(dst, b, h) do { _Pragma("unroll") for (int n = 0; n < 2; ++n) _Pragma("unroll") for (int k = 0; k < 2; ++k) dst[n][k] = *(const PG8_LAS bf16x8*)(lds + PG8_SB(b, h) + boff + n * 2048 + k * 1024); } while (0)
#define PG8_MMA(ai, bj, At, Bt) do { __builtin_amdgcn_s_setprio(1); _Pragma("unroll") for (int m = 0; m < 4; ++m) _Pragma("unroll") for (int n = 0; n < 2; ++n) _Pragma("unroll") for (int k = 0; k < 2; ++k) \
        acc[ai][bj][m][n] = __builtin_amdgcn_mfma_f32_16x16x32_bf16(Bt[n][k], At[m][k], acc[ai][bj][m][n], 0, 0, 0); __builtin_amdgcn_s_setprio(0); } while (0)
#define PG8_WAIT_V(n) asm volatile("s_waitcnt vmcnt(" #n ")" ::: "memory")
#define PG8_WAIT_L(n) asm volatile("s_waitcnt lgkmcnt(" #n ")" ::: "memory")
#define PG8_BAR __builtin_amdgcn_s_barrier()
#define PG8_SCHED __builtin_amdgcn_sched_barrier(0)
    Unit cur, nxt; int ui = 0;
    if (!S.next(0, cur)) return;
    f32x4 acc[2][2][4][2];
#pragma unroll
    for (int a = 0; a < 2; ++a)
#pragma unroll
        for (int b = 0; b < 2; ++b)
#pragma unroll
            for (int m = 0; m < 4; ++m)
#pragma unroll
                for (int n = 0; n < 2; ++n) acc[a][b][m][n] = (f32x4){0.f, 0.f, 0.f, 0.f};
    bf16x8 At[4][2], B0[2][2], B1[2][2];
    const char* cA = (const char*)g.A + (size_t)cur.pm * tstep; const char* cB = (const char*)g.Bt + (size_t)cur.pn * tstep;
    S.a_ready(cur);
    if constexpr (SP2) {
        PG8_STAGE(PG8_SB(0, 0), cB, voffB); PG8_STAGE(PG8_SB(0, 1), cB + hstep, voffB); PG8_STAGE(PG8_SA(0, 0), cA, voffA); PG8_STAGE(PG8_SA(0, 1), cA + hstep, voffA);
        if (wr == 1) PG8_BAR;
        PG8_WAIT_V(2); PG8_BAR;
        PG8_STAGE(PG8_SB(1, 0), cB + kstep, voffB); PG8_STAGE(PG8_SA(1, 0), cA + kstep, voffA); PG8_STAGE(PG8_SB(1, 1), cB + hstep + kstep, voffB);
        PG8_WAIT_V(6); PG8_BAR;
    } else {
        PG8_STAGE(PG8_SB(0, 0), cB, voffB); PG8_STAGE(PG8_SA(0, 0), cA, voffA); PG8_STAGE(PG8_SB(0, 1), cB + hstep, voffB); PG8_STAGE(PG8_SA(0, 1), cA + hstep, voffA);
        if (wr == 1) PG8_BAR;
        PG8_WAIT_V(4); PG8_BAR;
        PG8_STAGE(PG8_SB(1, 0), cB + kstep, voffB); PG8_STAGE(PG8_SA(1, 0), cA + kstep, voffA); PG8_STAGE(PG8_SB(1, 1), cB + hstep + kstep, voffB);
        PG8_WAIT_V(6); PG8_BAR;
    }
    for (;;) {
        const bool has_next = S.next(ui + 1, nxt);
        const char* nA = has_next ? (const char*)g.A + (size_t)nxt.pm * tstep : cA; const char* nB = has_next ? (const char*)g.Bt + (size_t)nxt.pn * tstep : cB;
        for (int t = 0; t < nt; t += 2) {
            const bool last = (t == nt - 2);
            const char* a1 = cA + (size_t)(t + 1) * kstep;
            const char* a2 = last ? nA : cA + (size_t)(t + 2) * kstep; const char* b2 = last ? nB : cB + (size_t)(t + 2) * kstep;
            const char* a3 = a2 + kstep; const char* b3 = b2 + kstep;
            if (last && has_next) S.a_ready(nxt);
            if constexpr (SP2) {
            PG8_LDB(B0, 0, 0); PG8_LDB(B1, 0, 1); PG8_SCHED; PG8_LDA(At, 0, 0); PG8_STAGE(PG8_SA(1, 1), a1 + hstep, voffA);
            PG8_WAIT_V(8); PG8_WAIT_L(0); PG8_BAR; PG8_MMA(0, 0, At, B0); PG8_MMA(0, 1, At, B1); PG8_BAR; PG8_SCHED;
            PG8_LDA(At, 0, 1); PG8_STAGE(PG8_SB(0, 0), b2, voffB); PG8_STAGE(PG8_SB(0, 1), b2 + hstep, voffB); PG8_STAGE(PG8_SA(0, 0), a2, voffA);
            PG8_WAIT_V(8); PG8_WAIT_L(0); PG8_BAR; PG8_MMA(1, 0, At, B0); PG8_MMA(1, 1, At, B1); PG8_BAR; PG8_SCHED;
            PG8_LDB(B0, 1, 0); PG8_LDB(B1, 1, 1); PG8_SCHED; PG8_LDA(At, 1, 0); PG8_STAGE(PG8_SA(0, 1), a2 + hstep, voffA);
            PG8_WAIT_V(8); PG8_WAIT_L(0); PG8_BAR; PG8_MMA(0, 0, At, B0); PG8_MMA(0, 1, At, B1); PG8_BAR; PG8_SCHED;
            PG8_LDA(At, 1, 1); PG8_STAGE(PG8_SB(1, 0), b3, voffB); PG8_STAGE(PG8_SB(1, 1), b3 + hstep, voffB); PG8_STAGE(PG8_SA(1, 0), a3, voffA);
            PG8_WAIT_V(8); PG8_WAIT_L(0); PG8_BAR; PG8_MMA(1, 0, At, B0); PG8_MMA(1, 1, At, B1); PG8_BAR; PG8_SCHED;
            } else {
            PG8_LDB(B0, 0, 0); PG8_SCHED; PG8_LDA(At, 0, 0); PG8_STAGE(PG8_SA(1, 1), a1 + hstep, voffA);
            PG8_WAIT_L(8); PG8_BAR; PG8_WAIT_L(0); PG8_MMA(0, 0, At, B0); PG8_BAR; PG8_SCHED;
            PG8_LDB(B1, 0, 1); PG8_STAGE(PG8_SB(0, 0), b2, voffB);
            PG8_BAR; PG8_WAIT_L(0); PG8_MMA(0, 1, At, B1); PG8_BAR;
            PG8_LDA(At, 0, 1); PG8_STAGE(PG8_SA(0, 0), a2, voffA);
            PG8_BAR; PG8_WAIT_L(0); PG8_MMA(1, 0, At, B0); PG8_BAR; PG8_SCHED;
            PG8_STAGE(PG8_SB(0, 1), b2 + hstep, voffB);
            PG8_WAIT_V(6); PG8_BAR; PG8_MMA(1, 1, At, B1); PG8_BAR;
            PG8_LDB(B0, 1, 0); PG8_SCHED; PG8_LDA(At, 1, 0); PG8_STAGE(PG8_SA(0, 1), a2 + hstep, voffA);
            PG8_WAIT_L(8); PG8_BAR; PG8_WAIT_L(0); PG8_MMA(0, 0, At, B0); PG8_BAR; PG8_SCHED;
            PG8_LDB(B1, 1, 1); PG8_STAGE(PG8_SB(1, 0), b3, voffB);
            PG8_BAR; PG8_WAIT_L(0); PG8_MMA(0, 1, At, B1); PG8_BAR;
            PG8_LDA(At, 1, 1); PG8_STAGE(PG8_SA(1, 0), a3, voffA);
            PG8_BAR; PG8_WAIT_L(0); PG8_MMA(1, 0, At, B0); PG8_BAR; PG8_SCHED;
            PG8_STAGE(PG8_SB(1, 1), b3 + hstep, voffB);
            PG8_WAIT_V(6); PG8_BAR; PG8_MMA(1, 1, At, B1); PG8_BAR;
            }
        }
        if constexpr (ALIGN_EPI) { if (wr == 0) PG8_BAR; }
        if constexpr (!Epi::AFTER_DRAIN) { E(acc, cur, wr, wc, fr, fq); S.done(cur); }
        if (!has_next) break;
#pragma unroll
        for (int a = 0; a < 2; ++a)
#pragma unroll
            for (int b = 0; b < 2; ++b)
#pragma unroll
                for (int m = 0; m < 4; ++m)
#pragma unroll
                    for (int n = 0; n < 2; ++n) acc[a][b][m][n] = (f32x4){0.f, 0.f, 0.f, 0.f};
        cur = nxt; cA = nA; cB = nB; ++ui;
        if constexpr (ALIGN_EPI) { if (wr == 1) PG8_BAR; }
    }
    PG8_WAIT_V(0);
    if constexpr (!ALIGN_EPI) { if (wr == 0) PG8_BAR; }
    PG8_BAR;
    if constexpr (Epi::AFTER_DRAIN) { E.fused(acc, cur, wr, wc, fr, fq, lds, wid, lane); S.done(cur); }
#undef PG8_SA
#undef PG8_SB
#undef PG8_STAGE
#undef PG8_LDA
#undef PG8_LDB
#undef PG8_MMA
#undef PG8_WAIT_V
#undef PG8_WAIT_L
#undef PG8_BAR
#undef PG8_SCHED
}
}

#include <hip/hip_cooperative_groups.h>
namespace cg = cooperative_groups;
#define LAS __attribute__((address_space(3)))
#define DI __device__ __forceinline__
typedef unsigned short bf16_t;
typedef unsigned u32x4 __attribute__((ext_vector_type(4)));
typedef unsigned u32x2 __attribute__((ext_vector_type(2)));
typedef float f32x4 __attribute__((ext_vector_type(4)));

constexpr int SEQ = 4096, NB = 4, M = NB * SEQ, DM = 1024, FF = 4096, PLE = 256;
constexpr int PP = 3584;
constexpr int IN_ORIG = 3332;
constexpr int AQ = 0, AK = 256, AV = 512, BZ = 768, BX = 1024, BDT = 1792, CQ = 2048, CK = 2304, CV = 2560, CG = 2816, DV = 3072, DG = 3328;
constexpr float EPS = 1e-6f;
constexpr int NTHR = 512, NWV = 8;
constexpr int LDS_BYTES = 147456;
constexpr size_t MiB = 1u << 20;
constexpr size_t WS_SS = 0;
constexpr size_t WS_CDEC = 512 * 1024; constexpr size_t WS_BAR = 600 * 1024;
constexpr size_t WS_TAB = 1 * MiB;
constexpr size_t WS_PB0 = 3 * MiB;
constexpr size_t WS_WIN = 11 * MiB, WS_WOUT = 18 * MiB, WS_WUP = 20 * MiB, WS_WDOWN = 28 * MiB, WS_WPLE0 = 36 * MiB, WS_WGATE0 = 37 * MiB;
constexpr size_t WS_XB = 39 * MiB, WS_YCAT = 71 * MiB, WS_PROJ = 103 * MiB, WS_SST = 215 * MiB, WS_RST = 231 * MiB;
constexpr size_t WS_H = 103 * MiB, WS_PE = 103 * MiB;
constexpr size_t WS_VT = 39 * MiB;
constexpr size_t WS_LSE = 250 * MiB;
constexpr size_t WS_WPLE1 = 239 * MiB, WS_WGATE1 = 240 * MiB, WS_PB1 = 242 * MiB, WS_END = 256 * MiB;

struct Params {
    const float* in[23]; float* out; unsigned char* ws;
};

DI float bf2f(bf16_t u) { return __uint_as_float((unsigned)u << 16); }
DI unsigned f2bf(float f) { unsigned u = __float_as_uint(f); return (u + 0x7fffu + ((u >> 16) & 1u)) >> 16; }
DI unsigned pk2(float lo, float hi) { return f2bf(lo) | (f2bf(hi) << 16); }
DI float lo16(unsigned w) { return __uint_as_float(w << 16); }
DI float hi16(unsigned w) { return __uint_as_float(w & 0xffff0000u); }
DI float wave_sum(float v) {
#pragma unroll
    for (int o = 1; o < 64; o <<= 1) v += __shfl_xor(v, o);
    return v;
}
DI float wave_max(float v) {
#pragma unroll
    for (int o = 1; o < 64; o <<= 1) v = fmaxf(v, __shfl_xor(v, o));
    return v;
}
DI float silu_f(float v) { return v / (1.f + __expf(-v)); }
DI float sigm_f(float v) { return 1.f / (1.f + __expf(-v)); }
DI void unpack8(const u32x4 w, float (&f)[8]) { f[0] = lo16(w.x); f[1] = hi16(w.x); f[2] = lo16(w.y); f[3] = hi16(w.y); f[4] = lo16(w.z); f[5] = hi16(w.z); f[6] = lo16(w.w); f[7] = hi16(w.w); }

DI void tr_item(const float* W, int K, int Norig, bf16_t* WT, const float* g, bool gap, LAS float* scr, int item, int nblk, int lane) {
    const int kb = item / nblk, nb = item % nblk, k0 = 64 * kb, n0 = 32 * nb;
    const int n = n0 + (lane & 31);
    int orig = n; if (gap) orig = (n < 1796) ? n : (n < 2048 ? -1 : n - 252);
#pragma unroll 8
    for (int i = 0; i < 32; ++i) { const int kk = 2 * i + (lane >> 5); float v = 0.f;
        if (orig >= 0) { v = W[(size_t)(k0 + kk) * Norig + orig]; if (g) v *= g[k0 + kk]; }
        scr[kk * 33 + (lane & 31)] = v; }
    asm volatile("s_waitcnt lgkmcnt(0)" ::: "memory");
    const int c = lane & 7;
#pragma unroll
    for (int j = 0; j < 4; ++j) { const int nn = (lane >> 3) + 8 * j; const LAS float* s = scr + (8 * c) * 33 + nn;
        u32x4 o; o.x = pk2(s[0 * 33], s[1 * 33]); o.y = pk2(s[2 * 33], s[3 * 33]); o.z = pk2(s[4 * 33], s[5 * 33]); o.w = pk2(s[6 * 33], s[7 * 33]);
        *(u32x4*)(WT + (size_t)(n0 + nn) * K + k0 + 8 * c) = o; }
    asm volatile("s_waitcnt lgkmcnt(0)" ::: "memory");
}
DI void convert_weights(const Params& p, int l, int which, LAS unsigned char* lds, int gw, int NGW, int lane, int wave) {
    LAS float* scr = (LAS float*)(lds + wave * 16384);
    unsigned char* ws = p.ws;
    if (which & 1) {
        constexpr int I_IN = 16 * 112, I_OUT = 16 * 32, I_UP = 16 * 128, I_DN = 64 * 32;
        for (int it = gw; it < I_IN + I_OUT + I_UP + I_DN; it += NGW) {
            int r = it;
            if (r < I_IN) { tr_item(p.in[3] + (size_t)l * DM * IN_ORIG, DM, IN_ORIG, (bf16_t*)(ws + WS_WIN), p.in[2] + l * DM, true, scr, r, 112, lane); continue; } r -= I_IN;
            if (r < I_OUT) { tr_item(p.in[16] + (size_t)l * DM * DM, DM, DM, (bf16_t*)(ws + WS_WOUT), nullptr, false, scr, r, 32, lane); continue; } r -= I_OUT;
            if (r < I_UP) { tr_item(p.in[18] + (size_t)l * DM * FF, DM, FF, (bf16_t*)(ws + WS_WUP), p.in[17] + l * DM, false, scr, r, 128, lane); continue; } r -= I_UP;
            tr_item(p.in[19] + (size_t)l * FF * DM, FF, DM, (bf16_t*)(ws + WS_WDOWN), nullptr, false, scr, r, 32, lane);
        }
    }
    if (which & 2) {
        constexpr int I_PLE = 4 * 32, I_GATE = 16 * 32;
        bf16_t* wple = (bf16_t*)(ws + (l ? WS_WPLE1 : WS_WPLE0)); bf16_t* wgate = (bf16_t*)(ws + (l ? WS_WGATE1 : WS_WGATE0));
        for (int it = gw; it < I_PLE + I_GATE; it += NGW) {
            int r = it;
            if (r < I_PLE) { tr_item(p.in[21] + (size_t)l * PLE * DM, PLE, DM, wple, nullptr, false, scr, r, 32, lane); continue; } r -= I_PLE;
            tr_item(p.in[22] + (size_t)l * DM * DM, DM, DM, wgate, p.in[20] + l * DM, false, scr, r, 32, lane);
        }
        const f32x4* src = (const f32x4*)(p.in[1] + (size_t)l * M * PLE); u32x2* dst = (u32x2*)(ws + (l ? WS_PB1 : WS_PB0));
        const int gt = gw * 64 + lane, NT = NGW * 64;
        for (int i = gt; i < M * PLE / 4; i += NT) { const f32x4 v = src[i]; u32x2 o; o.x = pk2(v[0], v[1]); o.y = pk2(v[2], v[3]); dst[i] = o; }
    }
}

DI void prologue(const Params& p, int gw, int NGW, int lane) {
    unsigned char* ws = p.ws;
    const int gt = gw * 64 + lane, NT = NGW * 64;
    float* ss = (float*)(ws + WS_SS);
    for (int i = gt; i < 6 * M; i += NT) ss[M + i] = 0.f;
    float* tab = (float*)(ws + WS_TAB);
    for (int idx = gt; idx < 2 * SEQ * 32; idx += NT) {
        const int t = idx / (SEQ * 32), e = idx % (SEQ * 32), pos = e >> 5, i = e & 31;
        const double base = t ? 0.7429639507594948 : 0.7498942093324559;
        double a = 1.0;
        for (int k = 0; k < 31; ++k) a = (k < i) ? a * base : a;
        const double ang = (double)pos * a;
        const double kk = rint(ang * 0.15915494309189535);
        const double r = ang - kk * 6.283185307179586477;
        const double r2 = r * r; double s = r, c = 1.0, ts = r, tc = 1.0;
        for (int n = 1; n <= 14; ++n) { tc *= -r2 / (double)((2 * n - 1) * (2 * n)); c += tc; ts *= -r2 / (double)((2 * n) * (2 * n + 1)); s += ts; }
        tab[(size_t)(2 * t) * SEQ * 32 + e] = (float)c; tab[(size_t)(2 * t + 1) * SEQ * 32 + e] = (float)s;
    }
    const float* x = p.in[0]; bf16_t* xb = (bf16_t*)(ws + WS_XB);
    for (int m = gw; m < M; m += NGW) {
        const f32x4* xr = (const f32x4*)(x + (size_t)m * DM) + lane; f32x4 v[4]; float s = 0.f;
#pragma unroll
        for (int j = 0; j < 4; ++j) { v[j] = xr[64 * j]; s += (v[j][0] * v[j][0] + v[j][1] * v[j][1]) + (v[j][2] * v[j][2] + v[j][3] * v[j][3]); }
        s = wave_sum(s);
        if (lane == 0) ss[m] = s;
        u32x2* o = (u32x2*)(xb + (size_t)m * DM) + lane;
#pragma unroll
        for (int j = 0; j < 4; ++j) { u32x2 w; w.x = pk2(v[j][0], v[j][1]); w.y = pk2(v[j][2], v[j][3]); o[64 * j] = w; }
    }
}

DI void e1_tokens(const Params& p, int l, int tok_lo, int tok_hi, int lane) {
    bf16_t* proj = (bf16_t*)(p.ws + WS_PROJ); const float* tab = (const float*)(p.ws + WS_TAB);
    const int sub = lane >> 5, l5 = lane & 31, which = l5 >> 2, hq = which & 3, isk = which >> 2, i0 = (l5 & 3) * 8;
    const int col = (sub == 0 ? (isk ? AK : AQ) : (isk ? CK : CQ)) + hq * 64;
    const float* gain = (isk ? p.in[5] : p.in[4]) + l * 64;
    const float sc = ((sub == 0 && !isk) || (sub == 1 && isk)) ? 0.125f : 1.0f;
    const float* ct = tab + (size_t)(2 * sub) * SEQ * 32; const float* st = tab + (size_t)(2 * sub + 1) * SEQ * 32;
    for (int tok = tok_lo; tok < tok_hi; ++tok) {
        const int pos = tok & (SEQ - 1);
        bf16_t* ptr = proj + (size_t)tok * PP + col;
        float x1[8], x2[8];
        unpack8(*(const u32x4*)(ptr + i0), x1); unpack8(*(const u32x4*)(ptr + 32 + i0), x2);
        float s2 = 0.f;
#pragma unroll
        for (int i = 0; i < 8; ++i) s2 += x1[i] * x1[i] + x2[i] * x2[i];
        s2 += __shfl_xor(s2, 1); s2 += __shfl_xor(s2, 2);
        if (sub == 0) { const float r = rsqrtf(s2 * (1.0f / 64.0f) + EPS);
#pragma unroll
            for (int i = 0; i < 8; ++i) { x1[i] *= r * gain[i0 + i]; x2[i] *= r * gain[32 + i0 + i]; } }
        float o1[8], o2[8];
#pragma unroll
        for (int i = 0; i < 8; ++i) { const float c = ct[pos * 32 + i0 + i], s = st[pos * 32 + i0 + i]; o1[i] = (x1[i] * c - x2[i] * s) * sc; o2[i] = (x2[i] * c + x1[i] * s) * sc; }
        u32x4 w1, w2; w1.x = pk2(o1[0], o1[1]); w1.y = pk2(o1[2], o1[3]); w1.z = pk2(o1[4], o1[5]); w1.w = pk2(o1[6], o1[7]);
        w2.x = pk2(o2[0], o2[1]); w2.y = pk2(o2[2], o2[3]); w2.z = pk2(o2[4], o2[5]); w2.w = pk2(o2[6], o2[7]);
        *(u32x4*)(ptr + i0) = w1; *(u32x4*)(ptr + 32 + i0) = w2;
        bf16_t* vp = proj + (size_t)tok * PP + DV + lane * 4; const bf16_t* gp = proj + (size_t)tok * PP + DG + lane * 4;
        const u32x2 vw = *(const u32x2*)vp, gwd = *(const u32x2*)gp;
        u32x2 o; o.x = pk2(lo16(vw.x) * sigm_f(lo16(gwd.x)), hi16(vw.x) * sigm_f(hi16(gwd.x))); o.y = pk2(lo16(vw.y) * sigm_f(lo16(gwd.y)), hi16(vw.y) * sigm_f(hi16(gwd.y)));
        *(u32x2*)vp = o;
    }
}


DI void e1_tile(const Params& p, int l, int tile, LAS unsigned char* lds, int tid, int wave, int lane) {
    const int T0 = tile * 64; const int b = T0 >> 12, s0 = T0 & (SEQ - 1);
    LAS bf16_t* Vs = (LAS bf16_t*)lds;
    const bf16_t* proj = (const bf16_t*)(p.ws + WS_PROJ);
    LAS bf16_t* Vr = Vs + 64 * 264;
    for (int e = tid; e < 64 * 32; e += NTHR) { const int j = e >> 5, c8 = (e & 31) * 8;
        *(LAS u32x4*)(Vs + j * 264 + c8) = *(const u32x4*)(proj + (size_t)(T0 + j) * PP + AV + c8);
        *(LAS u32x4*)(Vr + j * 264 + c8) = *(const u32x4*)(proj + (size_t)(T0 + j) * PP + CV + c8); }
    e1_tokens(p, l, T0 + wave * 8, T0 + wave * 8 + 8, lane);
    __syncthreads();
    bf16_t* vt = (bf16_t*)(p.ws + WS_VT);
    const int col = tid & 255, half = tid >> 8, h = col >> 6, dim = col & 63;
    {
      bf16_t* dst = vt + ((size_t)((b * 4 + h) * 64 + dim)) * SEQ + s0 + half * 32;
#pragma unroll
      for (int c8 = 0; c8 < 32; c8 += 8) { u32x4 w; const LAS bf16_t* s = Vs + (half * 32 + c8) * 264 + col;
          w.x = (unsigned)s[0] | ((unsigned)s[264] << 16); w.y = (unsigned)s[2 * 264] | ((unsigned)s[3 * 264] << 16); w.z = (unsigned)s[4 * 264] | ((unsigned)s[5 * 264] << 16); w.w = (unsigned)s[6 * 264] | ((unsigned)s[7 * 264] << 16);
          *(u32x4*)(dst + c8) = w; } }
    {
      bf16_t* dst = vt + (size_t)12 * 1024 * 1024 + ((size_t)((b * 4 + h) * 64 + dim)) * SEQ + s0 + half * 32;
#pragma unroll
      for (int c8 = 0; c8 < 32; c8 += 8) { u32x4 w; const LAS bf16_t* s = Vr + (half * 32 + c8) * 264 + col;
          w.x = (unsigned)s[0] | ((unsigned)s[264] << 16); w.y = (unsigned)s[2 * 264] | ((unsigned)s[3 * 264] << 16); w.z = (unsigned)s[4 * 264] | ((unsigned)s[5 * 264] << 16); w.w = (unsigned)s[6 * 264] | ((unsigned)s[7 * 264] << 16);
          *(u32x4*)(dst + c8) = w; } }
    {
      bf16_t* base = vt + (size_t)4 * 1024 * 1024;
#pragma unroll
      for (int r = 0; r < 4; ++r) { const LAS bf16_t* s = Vs + (half * 32 + r) * 264 + col; u32x4 w;
          w.x = (unsigned)s[0] | ((unsigned)s[4 * 264] << 16); w.y = (unsigned)s[8 * 264] | ((unsigned)s[12 * 264] << 16); w.z = (unsigned)s[16 * 264] | ((unsigned)s[20 * 264] << 16); w.w = (unsigned)s[24 * 264] | ((unsigned)s[28 * 264] << 16);
          *(u32x4*)(base + ((size_t)(((b * 4 + h) * 4 + r) * 64 + dim)) * 1024 + (s0 >> 2) + half * 8) = w; } }
    {
      bf16_t* base = vt + (size_t)8 * 1024 * 1024;
#pragma unroll
      for (int r = 0; r < 16; ++r) { const LAS bf16_t* s = Vs + (half * 32 + r) * 264 + col;
          const unsigned w = (unsigned)s[0] | ((unsigned)s[16 * 264] << 16);
          *(unsigned*)(base + ((size_t)(((b * 4 + h) * 16 + r) * 64 + dim)) * 256 + (s0 >> 4) + half * 2) = w; } }
    __syncthreads();
}

typedef short bf16x8_t __attribute__((ext_vector_type(8)));
DI void attn_tile(const Params& p, int b, int h, int pat, int r, int i0, int lane) {
    const int dsh = 2 * pat, L = SEQ >> dsh;
    const int fr = lane & 15, quad = lane >> 4;
    const bf16_t* projb = (const bf16_t*)(p.ws + WS_PROJ) + (size_t)(b * SEQ) * PP + h * 64 + quad * 8;
    const int tq = ((i0 + fr) << dsh) + r;
    bf16x8_t qf[2];
    qf[0] = *(const bf16x8_t*)(projb + (size_t)tq * PP + AQ); qf[1] = *(const bf16x8_t*)(projb + (size_t)tq * PP + AQ + 32);
    f32x4 acc[5][2];
#pragma unroll
    for (int s = 0; s < 5; ++s)
#pragma unroll
        for (int u = 0; u < 2; ++u) {
            const int krel = 32 * s + 8 * (fr >> 2) + 4 * u + (fr & 3);
            int kap = i0 - 128 + krel; kap = kap < 0 ? 0 : (kap > L - 1 ? L - 1 : kap);
            const bf16_t* kp = projb + (size_t)((kap << dsh) + r) * PP + AK;
            const bf16x8_t k0 = *(const bf16x8_t*)kp, k1 = *(const bf16x8_t*)(kp + 32);
            f32x4 a = (f32x4){0.f, 0.f, 0.f, 0.f};
            a = __builtin_amdgcn_mfma_f32_16x16x32_bf16(k0, qf[0], a, 0, 0, 0);
            a = __builtin_amdgcn_mfma_f32_16x16x32_bf16(k1, qf[1], a, 0, 0, 0);
            acc[s][u] = a; }
    float mx = -INFINITY;
#pragma unroll
    for (int s = 0; s < 5; ++s)
#pragma unroll
        for (int u = 0; u < 2; ++u)
#pragma unroll
            for (int j = 0; j < 4; ++j) { const int k = 32 * s + 8 * quad + 4 * u + j; const bool valid = (k >= fr) && (k <= 128 + fr) && (i0 - 128 + k >= 0);
                const float v = valid ? acc[s][u][j] : -INFINITY; acc[s][u][j] = v; mx = fmaxf(mx, v); }
    mx = fmaxf(mx, __shfl_xor(mx, 16)); mx = fmaxf(mx, __shfl_xor(mx, 32));
    float sum = 0.f; bf16x8_t pb[5];
#pragma unroll
    for (int s = 0; s < 5; ++s) { float e[8];
#pragma unroll
        for (int u = 0; u < 2; ++u)
#pragma unroll
            for (int j = 0; j < 4; ++j) { const float v = acc[s][u][j]; const float ev = (v == -INFINITY) ? 0.f : __expf(v - mx); e[u * 4 + j] = ev; sum += ev; }
        u32x4 w; w.x = pk2(e[0], e[1]); w.y = pk2(e[2], e[3]); w.z = pk2(e[4], e[5]); w.w = pk2(e[6], e[7]); pb[s] = __builtin_bit_cast(bf16x8_t, w); }
    sum += __shfl_xor(sum, 16); sum += __shfl_xor(sum, 32);
    const bf16_t* vtb = (const bf16_t*)(p.ws + WS_VT) + (size_t)pat * 4 * 1024 * 1024 + ((size_t)((((b * 4 + h) << dsh) + r) * 64 + fr)) * L;
    f32x4 o[4];
#pragma unroll
    for (int dt = 0; dt < 4; ++dt) o[dt] = (f32x4){0.f, 0.f, 0.f, 0.f};
#pragma unroll
    for (int s = 0; s < 5; ++s) { int st = i0 - 128 + 32 * s + 8 * quad; st = st < 0 ? 0 : (st > L - 8 ? L - 8 : st);
#pragma unroll
        for (int dt = 0; dt < 4; ++dt) { const bf16x8_t vf = *(const bf16x8_t*)(vtb + (size_t)(dt * 16) * L + st);
            o[dt] = __builtin_amdgcn_mfma_f32_16x16x32_bf16(vf, pb[s], o[dt], 0, 0, 0); } }
    const float inv = 1.0f / sum; const size_t tok = (size_t)(b * SEQ + tq);
    bf16_t* yo = (bf16_t*)(p.ws + WS_YCAT) + tok * DM + pat * 256 + h * 64 + quad * 4;
#pragma unroll
    for (int dt = 0; dt < 4; ++dt) { u32x2 w; w.x = pk2(o[dt][0] * inv, o[dt][1] * inv); w.y = pk2(o[dt][2] * inv, o[dt][3] * inv); *(u32x2*)(yo + dt * 16) = w; }
    if (quad == 0) ((float*)(p.ws + WS_LSE))[((size_t)pat * M + tok) * 4 + h] = mx + __logf(sum);
}
DI void attn_combine(const Params& p, int gt, int NT) {
    bf16_t* yc = (bf16_t*)(p.ws + WS_YCAT); const float* lse = (const float*)(p.ws + WS_LSE);
    for (int i = gt; i < M * 32; i += NT) { const int tok = i >> 5, c8 = (i & 31) * 8, h = c8 >> 6;
        const float l0 = lse[((size_t)0 * M + tok) * 4 + h], l1 = lse[((size_t)1 * M + tok) * 4 + h], l2 = lse[((size_t)2 * M + tok) * 4 + h];
        const float mm = fmaxf(l0, fmaxf(l1, l2)); float w0 = __expf(l0 - mm), w1 = __expf(l1 - mm), w2 = __expf(l2 - mm); const float iz = 1.0f / (w0 + w1 + w2); w0 *= iz; w1 *= iz; w2 *= iz;
        bf16_t* pp = yc + (size_t)tok * DM + c8; float a[8], bq[8], c[8];
        unpack8(*(const u32x4*)pp, a); unpack8(*(const u32x4*)(pp + 256), bq); unpack8(*(const u32x4*)(pp + 512), c);
        u32x4 w; w.x = pk2(w0 * a[0] + w1 * bq[0] + w2 * c[0], w0 * a[1] + w1 * bq[1] + w2 * c[1]); w.y = pk2(w0 * a[2] + w1 * bq[2] + w2 * c[2], w0 * a[3] + w1 * bq[3] + w2 * c[3]);
        w.z = pk2(w0 * a[4] + w1 * bq[4] + w2 * c[4], w0 * a[5] + w1 * bq[5] + w2 * c[5]); w.w = pk2(w0 * a[6] + w1 * bq[6] + w2 * c[6], w0 * a[7] + w1 * bq[7] + w2 * c[7]);
        *(u32x4*)pp = w; }
}

template <int NC, int K> DI void nt_acc(float (&acc)[NC], const LAS bf16_t* Ap, const LAS bf16_t* Bp, int ldb) {
    for (int k = 0; k < K; k += 8) {
        float a[8]; unpack8(*(const LAS u32x4*)(Ap + k), a);
#pragma unroll
        for (int c = 0; c < NC; ++c) { float b[8]; unpack8(*(const LAS u32x4*)(Bp + c * ldb + k), b);
            acc[c] += (a[0] * b[0] + a[1] * b[1]) + (a[2] * b[2] + a[3] * b[3]) + (a[4] * b[4] + a[5] * b[5]) + (a[6] * b[6] + a[7] * b[7]); }
    }
}
template <int NC> DI void axpy_row(float (&acc)[NC], float coef, const LAS bf16_t* Bp) {
#pragma unroll
    for (int c8 = 0; c8 < NC; c8 += 8) { float b[8]; unpack8(*(const LAS u32x4*)(Bp + c8), b);
#pragma unroll
        for (int e = 0; e < 8; ++e) acc[c8 + e] += coef * b[e]; }
}

DI void ssd_dt_acum(const Params& p, int l, int tok0, int g, LAS float* dts, LAS float* acs, int wave, int lane) {
    if (wave < 2) {
        const int h = 2 * g + wave; const bf16_t* proj = (const bf16_t*)(p.ws + WS_PROJ);
        const float bias = p.in[8][l * 4 + h], a = -__expf(p.in[9][l * 4 + h]);
        float d[2];
#pragma unroll
        for (int e = 0; e < 2; ++e) { const float raw = bf2f(proj[(size_t)(tok0 + 2 * lane + e) * PP + BDT + h]) + bias; d[e] = raw > 20.f ? raw : log1pf(__expf(raw)); }
        const float v0 = d[0] * a, v1 = d[1] * a; float s = v0 + v1;
#pragma unroll
        for (int off = 1; off < 64; off <<= 1) { const float t = __shfl_up(s, off); if (lane >= off) s += t; }
        dts[wave * 128 + 2 * lane] = d[0]; dts[wave * 128 + 2 * lane + 1] = d[1];
        acs[wave * 128 + 2 * lane] = s - v1; acs[wave * 128 + 2 * lane + 1] = s;
    }
}
DI void stage_conv(const Params& p, int l, LAS bf16_t* dst, int ld, int tok0, int seqpos0, int choff, int tid) {
    const bf16_t* src = (const bf16_t*)(p.ws + WS_PROJ) + (size_t)tok0 * PP + BX + choff;
    const float* cw = p.in[6] + (size_t)l * 4 * 768 + choff; const float* cb = p.in[7] + l * 768 + choff;
    for (int e = tid; e < 128 * 128; e += NTHR) { const int j = e >> 7, ch = e & 127;
        float v = cb[ch];
#pragma unroll
        for (int k = 0; k < 4; ++k) { const int s = j - 3 + k; if (seqpos0 + s >= 0) v += cw[k * 768 + ch] * bf2f(src[(long)s * PP + ch]); }
        dst[j * ld + ch] = (bf16_t)f2bf(silu_f(v)); }
}


DI void stage_conv_t(const Params& p, int l, LAS bf16_t* dst, int ld, int tok0, int seqpos0, int choff, const LAS float* wsc, int tid) {
    const bf16_t* src = (const bf16_t*)(p.ws + WS_PROJ) + (size_t)tok0 * PP + BX + choff;
    const float* cw = p.in[6] + (size_t)l * 4 * 768 + choff; const float* cb = p.in[7] + l * 768 + choff;
    for (int e = tid; e < 128 * 128; e += NTHR) { const int j = e >> 7, ch = e & 127;
        float v = cb[ch];
#pragma unroll
        for (int k = 0; k < 4; ++k) { const int s = j - 3 + k; if (seqpos0 + s >= 0) v += cw[k * 768 + ch] * bf2f(src[(long)s * PP + ch]); }
        v = silu_f(v); if (wsc) v *= wsc[(ch >> 6) * 128 + j];
        dst[ch * ld + j] = (bf16_t)f2bf(v); }
}
template <bool TR> DI void stage_conv_v(const Params& p, int l, LAS bf16_t* dst, int ld, int tok0, int seqpos0, int choff, const LAS float* wsc, int tid) {
    const int cc = tid & 15, j0 = (tid >> 4) * 4;
    const bf16_t* src = (const bf16_t*)(p.ws + WS_PROJ) + (size_t)tok0 * PP + BX + choff + cc * 8;
    const float* cw = p.in[6] + (size_t)l * 4 * 768 + choff + cc * 8; const float* cb = p.in[7] + l * 768 + choff + cc * 8;
    float w[4][8], bias[8];
#pragma unroll
    for (int k = 0; k < 4; ++k) { const f32x4 a = *(const f32x4*)(cw + k * 768), b2 = *(const f32x4*)(cw + k * 768 + 4);
        w[k][0] = a[0]; w[k][1] = a[1]; w[k][2] = a[2]; w[k][3] = a[3]; w[k][4] = b2[0]; w[k][5] = b2[1]; w[k][6] = b2[2]; w[k][7] = b2[3]; }
    { const f32x4 a = *(const f32x4*)cb, b2 = *(const f32x4*)(cb + 4); bias[0] = a[0]; bias[1] = a[1]; bias[2] = a[2]; bias[3] = a[3]; bias[4] = b2[0]; bias[5] = b2[1]; bias[6] = b2[2]; bias[7] = b2[3]; }
    float x[7][8];
#pragma unroll
    for (int rr = 0; rr < 7; ++rr) { const int s = j0 - 3 + rr; u32x4 v = (u32x4){0u, 0u, 0u, 0u}; if (seqpos0 + s >= 0) v = *(const u32x4*)(src + (long)s * PP); unpack8(v, x[rr]); }
    float o[4][8];
#pragma unroll
    for (int r = 0; r < 4; ++r)
#pragma unroll
        for (int e = 0; e < 8; ++e) { float v = bias[e];
#pragma unroll
            for (int k = 0; k < 4; ++k) v += w[k][e] * x[r + k][e];
            v = silu_f(v); if (TR && wsc) v *= wsc[(((choff + cc * 8 + e) & 64) ? 128 : 0) + j0 + r]; o[r][e] = v; }
    if (!TR) {
#pragma unroll
        for (int r = 0; r < 4; ++r) { u32x4 wv; wv.x = pk2(o[r][0], o[r][1]); wv.y = pk2(o[r][2], o[r][3]); wv.z = pk2(o[r][4], o[r][5]); wv.w = pk2(o[r][6], o[r][7]); *(LAS u32x4*)(dst + (j0 + r) * ld + cc * 8) = wv; }
    } else {
#pragma unroll
        for (int e = 0; e < 8; ++e) { u32x2 wv; wv.x = pk2(o[0][e], o[1][e]); wv.y = pk2(o[2][e], o[3][e]); *(LAS u32x2*)(dst + (cc * 8 + e) * ld + j0) = wv; }
    }
}
typedef short bf16x8_t __attribute__((ext_vector_type(8)));
#define MFMA16(a, b, c) __builtin_amdgcn_mfma_f32_16x16x32_bf16((a), (b), (c), 0, 0, 0)
DI void ssd_states_mfma(const Params& p, int l, int b, int c, int g, LAS unsigned char* lds, int tid, int wave, int lane) {
    LAS bf16_t* XT = (LAS bf16_t*)lds; LAS bf16_t* BT = XT + 128 * 136;
    LAS float* dts = (LAS float*)(BT + 128 * 136); LAS float* acs = dts + 256; LAS float* wsc = acs + 256;
    const int tok0 = b * SEQ + c * 128;
    ssd_dt_acum(p, l, tok0, g, dts, acs, wave, lane);
    __syncthreads();
    if (tid < 256) { const int hh = tid >> 7, j = tid & 127; wsc[tid] = __expf(acs[hh * 128 + 127] - acs[hh * 128 + j]) * dts[hh * 128 + j]; }
    if (tid < 2) ((float*)(p.ws + WS_CDEC))[(b * 32 + c) * 4 + 2 * g + tid] = __expf(acs[tid * 128 + 127]);
    __syncthreads();
    stage_conv_v<true>(p, l, XT, 136, tok0, c * 128, g * 128, wsc, tid);
    stage_conv_v<true>(p, l, BT, 136, tok0, c * 128, 256 + g * 128, nullptr, tid);
    __syncthreads();
    const int fr = lane & 15, quad = lane >> 4, hh = wave >> 2, pt = wave & 3;
    bf16x8_t af[4];
#pragma unroll
    for (int ks = 0; ks < 4; ++ks) af[ks] = *(const LAS bf16x8_t*)(XT + (hh * 64 + pt * 16 + fr) * 136 + ks * 32 + quad * 8);
    float* dst = (float*)(p.ws + WS_SST) + ((size_t)((b * 32 + c) * 4 + 2 * g + hh)) * 8192 + (pt * 16 + quad * 4) * 128 + fr;
#pragma unroll
    for (int nt = 0; nt < 8; ++nt) { f32x4 acc = (f32x4){0.f, 0.f, 0.f, 0.f};
#pragma unroll
        for (int ks = 0; ks < 4; ++ks) { const bf16x8_t bfv = *(const LAS bf16x8_t*)(BT + (nt * 16 + fr) * 136 + ks * 32 + quad * 8); acc = MFMA16(af[ks], bfv, acc); }
#pragma unroll
        for (int jj = 0; jj < 4; ++jj) dst[jj * 128 + nt * 16] = acc[jj]; }
    __syncthreads();
}
DI void ssd_y_mfma(const Params& p, int l, int b, int c, int g, LAS unsigned char* lds, int tid, int wave, int lane) {
    LAS bf16_t* Cs = (LAS bf16_t*)lds; LAS bf16_t* Bs = Cs + 128 * 136; LAS bf16_t* XT = Bs + 128 * 136; LAS bf16_t* Pv = XT + 128 * 136;
    LAS float* dts = (LAS float*)(Pv + 128 * 136); LAS float* acs = dts + 256;
    const int tok0 = b * SEQ + c * 128; const bf16_t* proj = (const bf16_t*)(p.ws + WS_PROJ);
    ssd_dt_acum(p, l, tok0, g, dts, acs, wave, lane);
    stage_conv_v<false>(p, l, Cs, 136, tok0, c * 128, 512 + g * 128, nullptr, tid);
    stage_conv_v<false>(p, l, Bs, 136, tok0, c * 128, 256 + g * 128, nullptr, tid);
    stage_conv_v<true>(p, l, XT, 136, tok0, c * 128, g * 128, nullptr, tid);
    { const float* prev = (const float*)(p.ws + WS_SST) + ((size_t)((b * 32 + c) * 4 + 2 * g)) * 8192;
      for (int e = tid; e < 128 * 32; e += NTHR) { const int r = e >> 5, n4 = (e & 31) * 4; const f32x4 v = *(const f32x4*)(prev + r * 128 + n4);
          u32x2 w; w.x = pk2(v[0], v[1]); w.y = pk2(v[2], v[3]); *(LAS u32x2*)(Pv + r * 136 + n4) = w; } }
    __syncthreads();
    const int fr = lane & 15, quad = lane >> 4, i = wave * 16 + fr, smax = (wave * 16 + 15) >> 5;
    const int dq = 8 * quad - fr; const LAS float* acq = acs + 8 * quad; const LAS float* dtq = dts + 8 * quad;
    bf16x8_t cf[4];
#pragma unroll
    for (int ks = 0; ks < 4; ++ks) cf[ks] = *(const LAS bf16x8_t*)(Cs + i * 136 + ks * 32 + quad * 8);
    f32x4 cbt[4][2];
#pragma unroll
    for (int s = 0; s < 4; ++s)
#pragma unroll
        for (int u = 0; u < 2; ++u) { f32x4 a = (f32x4){0.f, 0.f, 0.f, 0.f};
            if (s <= smax) { const int j = 32 * s + 8 * (fr >> 2) + 4 * u + (fr & 3);
#pragma unroll
                for (int ks = 0; ks < 4; ++ks) { const bf16x8_t bfv = *(const LAS bf16x8_t*)(Bs + j * 136 + ks * 32 + quad * 8); a = MFMA16(bfv, cf[ks], a); } }
#pragma unroll
            for (int jj = 0; jj < 4; ++jj) a[jj] = (dq <= 16 * wave - 32 * s - 4 * u - jj) ? a[jj] : 0.f;
            cbt[s][u] = a; asm volatile("" ::: "memory"); }
    float y[2][4][4];
#pragma unroll
    for (int hh = 0; hh < 2; ++hh) {
        const float ai = acs[hh * 128 + i];
        f32x4 o[4], o2[4];
#pragma unroll
        for (int pt = 0; pt < 4; ++pt) { o[pt] = (f32x4){0.f, 0.f, 0.f, 0.f}; o2[pt] = (f32x4){0.f, 0.f, 0.f, 0.f}; }
#pragma unroll
        for (int s = 0; s < 4; ++s) if (s <= smax) { float e[8];
#pragma unroll
            for (int u = 0; u < 2; ++u)
#pragma unroll
                for (int jj = 0; jj < 4; ++jj) { const int jo = hh * 128 + 32 * s + 4 * u + jj;
                    e[u * 4 + jj] = cbt[s][u][jj] * __expf(fminf(ai - acq[jo], 0.f)) * dtq[jo]; }
            u32x4 w; w.x = pk2(e[0], e[1]); w.y = pk2(e[2], e[3]); w.z = pk2(e[4], e[5]); w.w = pk2(e[6], e[7]); const bf16x8_t pb = __builtin_bit_cast(bf16x8_t, w);
#pragma unroll
            for (int pt = 0; pt < 4; ++pt) { const bf16x8_t xf = *(const LAS bf16x8_t*)(XT + (hh * 64 + pt * 16 + fr) * 136 + 32 * s + 8 * quad); o[pt] = MFMA16(xf, pb, o[pt]); } asm volatile("" ::: "memory"); }
#pragma unroll
        for (int ks = 0; ks < 4; ++ks) {
#pragma unroll
            for (int pt = 0; pt < 4; ++pt) { const bf16x8_t pf = *(const LAS bf16x8_t*)(Pv + (hh * 64 + pt * 16 + fr) * 136 + ks * 32 + quad * 8); o2[pt] = MFMA16(pf, cf[ks], o2[pt]); }
            asm volatile("" ::: "memory"); }
        const float ea = __expf(ai);
#pragma unroll
        for (int pt = 0; pt < 4; ++pt)
#pragma unroll
            for (int jj = 0; jj < 4; ++jj) y[hh][pt][jj] = o[pt][jj] + ea * o2[pt][jj];
    }
    float s2 = 0.f;
#pragma unroll
    for (int hh = 0; hh < 2; ++hh) { const float dsk = p.in[10][l * 4 + 2 * g + hh];
#pragma unroll
        for (int pt = 0; pt < 4; ++pt) { const int ch = hh * 64 + pt * 16 + quad * 4;
            const u32x2 zw = *(const u32x2*)(proj + (size_t)(tok0 + i) * PP + BZ + g * 128 + ch);
            const float z4[4] = {lo16(zw.x), hi16(zw.x), lo16(zw.y), hi16(zw.y)};
#pragma unroll
            for (int jj = 0; jj < 4; ++jj) { const float xv = bf2f(XT[(ch + jj) * 136 + i]); const float v = (y[hh][pt][jj] + dsk * xv) * silu_f(z4[jj]); y[hh][pt][jj] = v; s2 += v * v; } } }
    s2 += __shfl_xor(s2, 16); s2 += __shfl_xor(s2, 32);
    const float rs = rsqrtf(s2 * (1.0f / 128.0f) + EPS);
    bf16_t* yo = (bf16_t*)(p.ws + WS_YCAT) + (size_t)(tok0 + i) * DM + 256 + g * 128;
#pragma unroll
    for (int hh = 0; hh < 2; ++hh)
#pragma unroll
        for (int pt = 0; pt < 4; ++pt) { const int ch = hh * 64 + pt * 16 + quad * 4; const f32x4 ng = *(const f32x4*)(p.in[11] + l * 256 + g * 128 + ch);
            u32x2 w; w.x = pk2(y[hh][pt][0] * rs * ng[0], y[hh][pt][1] * rs * ng[1]); w.y = pk2(y[hh][pt][2] * rs * ng[2], y[hh][pt][3] * rs * ng[3]); *(u32x2*)(yo + ch) = w; }
    __syncthreads();
}

DI void ssd_states_unit(const Params& p, int l, int b, int c, int g, LAS unsigned char* lds, int tid, int wave, int lane) {
    LAS bf16_t* Xs = (LAS bf16_t*)lds; LAS bf16_t* Bs = Xs + 128 * 136;
    LAS float* dts = (LAS float*)(Bs + 128 * 136); LAS float* acs = dts + 256; LAS float* wsc = acs + 256;
    const int tok0 = b * SEQ + c * 128;
    ssd_dt_acum(p, l, tok0, g, dts, acs, wave, lane);
    stage_conv(p, l, Xs, 136, tok0, c * 128, g * 128, tid);
    stage_conv(p, l, Bs, 136, tok0, c * 128, 256 + g * 128, tid);
    __syncthreads();
    if (tid < 256) { const int hh = tid >> 7, j = tid & 127; wsc[tid] = __expf(acs[hh * 128 + 127] - acs[hh * 128 + j]) * dts[hh * 128 + j]; }
    if (tid < 2) ((float*)(p.ws + WS_CDEC))[(b * 32 + c) * 4 + 2 * g + tid] = __expf(acs[tid * 128 + 127]);
    __syncthreads();
    const int r = tid >> 2, q = tid & 3, hh = r >> 6;
    float acc[32];
#pragma unroll
    for (int i = 0; i < 32; ++i) acc[i] = 0.f;
    for (int j = 0; j < 128; ++j) { const float coef = bf2f(Xs[j * 136 + r]) * wsc[hh * 128 + j]; axpy_row<32>(acc, coef, Bs + j * 136 + q * 32); }
    float* dst = (float*)(p.ws + WS_SST) + ((size_t)((b * 32 + c) * 4 + 2 * g + hh)) * 8192 + (r & 63) * 128 + q * 32;
#pragma unroll
    for (int i = 0; i < 32; i += 4) *(f32x4*)(dst + i) = (f32x4){acc[i], acc[i + 1], acc[i + 2], acc[i + 3]};
    __syncthreads();
}

DI void ret_states_unit(const Params& p, int b, int c, LAS unsigned char* lds, int tid) {
    LAS bf16_t* Ks = (LAS bf16_t*)lds; LAS bf16_t* Vs = Ks + 128 * 264;
    const int tok0 = b * SEQ + c * 128; const bf16_t* proj = (const bf16_t*)(p.ws + WS_PROJ);
    for (int e = tid; e < 128 * 32; e += NTHR) { const int j = e >> 5, c8 = (e & 31) * 8;
        *(LAS u32x4*)(Ks + j * 264 + c8) = *(const u32x4*)(proj + (size_t)(tok0 + j) * PP + CK + c8);
        *(LAS u32x4*)(Vs + j * 264 + c8) = *(const u32x4*)(proj + (size_t)(tok0 + j) * PP + CV + c8); }
    __syncthreads();
    const int h = tid >> 7, d = (tid >> 1) & 63, eh = tid & 1;
    const float lg = log2f(1.0f - exp2f(-5.0f - (float)h));
    float acc[32];
#pragma unroll
    for (int i = 0; i < 32; ++i) acc[i] = 0.f;
    for (int j = 0; j < 128; ++j) { const float coef = bf2f(Ks[j * 264 + h * 64 + d]) * exp2f((float)(127 - j) * lg); axpy_row<32>(acc, coef, Vs + j * 264 + h * 64 + eh * 32); }
    float* dst = (float*)(p.ws + WS_RST) + ((size_t)((b * 32 + c) * 4 + h)) * 4096 + d * 64 + eh * 32;
#pragma unroll
    for (int i = 0; i < 32; i += 4) *(f32x4*)(dst + i) = (f32x4){acc[i], acc[i + 1], acc[i + 2], acc[i + 3]};
    __syncthreads();
}

DI void conv_unit(const Params& p, int l, int b, int s0, LAS unsigned char* lds, int tid, int wave, int lane) {
    LAS bf16_t* Hs = (LAS bf16_t*)lds;
    LAS float* Os = (LAS float*)(lds + 94 * 256 * 2);
    const bf16_t* proj = (const bf16_t*)(p.ws + WS_PROJ);
    for (int e = tid; e < 94 * 32; e += NTHR) { const int r = e >> 5, c8 = (e & 31) * 8; const int s = s0 - 30 + r;
        u32x4 v = (u32x4){0u, 0u, 0u, 0u};
        if (s >= 0) v = *(const u32x4*)(proj + (size_t)(b * SEQ + s) * PP + DV + c8);
        *(LAS u32x4*)(Hs + r * 256 + c8) = v; }
    __syncthreads();
    { const int ch = tid & 255, half = tid >> 8;
      const float* w = p.in[12] + (size_t)l * 31 * 256 + ch; const float bias = p.in[13][l * 256 + ch];
      float wr[31];
#pragma unroll
      for (int k = 0; k < 31; ++k) wr[k] = w[k * 256];
      for (int tt = 0; tt < 32; ++tt) { const int t = half * 32 + tt; float a = bias;
#pragma unroll
          for (int k = 0; k < 31; ++k) a += wr[k] * bf2f(Hs[(t + k) * 256 + ch]);
          Os[t * 256 + ch] = a; } }
    __syncthreads();
    const f32x4 lg = *(const f32x4*)(p.in[14] + l * 256 + lane * 4), lb = *(const f32x4*)(p.in[15] + l * 256 + lane * 4);
    bf16_t* ycat = (bf16_t*)(p.ws + WS_YCAT);
    for (int tt = 0; tt < 8; ++tt) { const int t = wave * 8 + tt; const f32x4 v = *(const LAS f32x4*)(Os + t * 256 + lane * 4);
        const float mean = wave_sum((v[0] + v[1]) + (v[2] + v[3])) * (1.0f / 256.0f);
        const f32x4 d = v - mean; const float var = wave_sum((d[0] * d[0] + d[1] * d[1]) + (d[2] * d[2] + d[3] * d[3])) * (1.0f / 256.0f);
        const float rs = rsqrtf(var + EPS); f32x4 o = d * rs * lg + lb;
        u32x2 w; w.x = pk2(silu_f(o[0]), silu_f(o[1])); w.y = pk2(silu_f(o[2]), silu_f(o[3]));
        *(u32x2*)(ycat + (size_t)(b * SEQ + s0 + t) * DM + 768 + lane * 4) = w; }
    __syncthreads();
}

DI void attn_task(const Params& p, int tok, int hd, int lane, LAS float* qs) {
    const bf16_t* proj = (const bf16_t*)(p.ws + WS_PROJ);
    const int pos = tok & (SEQ - 1); const size_t rowbase = (size_t)(tok - pos);
    qs[lane] = bf2f(proj[(size_t)tok * PP + AQ + hd * 64 + lane]);
    float sc[7];
#pragma unroll
    for (int ps = 0; ps < 7; ++ps) { const int e = ps * 64 + lane; const int pat = e / 129, j = e - pat * 129; const int kp = pos - (j << (2 * pat));
        const bool valid = (e < 387) && (kp >= 0); float s = 0.f;
        if (valid) { const u32x4* kr = (const u32x4*)(proj + (rowbase + kp) * PP + AK + hd * 64);
#pragma unroll
            for (int c = 0; c < 8; ++c) { float kf[8]; unpack8(kr[c], kf); const f32x4 q0 = *(const LAS f32x4*)(qs + c * 8), q1 = *(const LAS f32x4*)(qs + c * 8 + 4);
                s += (q0[0] * kf[0] + q0[1] * kf[1]) + (q0[2] * kf[2] + q0[3] * kf[3]) + (q1[0] * kf[4] + q1[1] * kf[5]) + (q1[2] * kf[6] + q1[3] * kf[7]); } }
        sc[ps] = valid ? s : -INFINITY; }
    float mx = sc[0];
#pragma unroll
    for (int ps = 1; ps < 7; ++ps) mx = fmaxf(mx, sc[ps]);
    mx = wave_max(mx);
    float z = 0.f; int pr[7];
#pragma unroll
    for (int ps = 0; ps < 7; ++ps) { const float e = (sc[ps] == -INFINITY) ? 0.f : __expf(sc[ps] - mx); z += e; pr[ps] = __float_as_int(e); }
    z = wave_sum(z);
    float o = 0.f;
    const bf16_t* vb = proj + rowbase * PP + AV + hd * 64 + lane;
#pragma unroll
    for (int ps = 0; ps < 7; ++ps) {
        const int nl = ps == 6 ? 3 : 64;
#pragma unroll 8
        for (int ln = 0; ln < nl; ++ln) { const int e = ps * 64 + ln; const int pat = e / 129, j = e - pat * 129; int kp = pos - (j << (2 * pat));
            const bool ok = kp >= 0; kp = ok ? kp : pos;
            const float pe = ok ? __int_as_float(__builtin_amdgcn_readlane(pr[ps], ln)) : 0.f;
            o += pe * bf2f(vb[(size_t)kp * PP]); } }
    ((bf16_t*)(p.ws + WS_YCAT))[(size_t)tok * DM + hd * 64 + lane] = (bf16_t)f2bf(o / z);
}

DI void ret_states_mfma(const Params& p, int b, int c, int h, LAS unsigned char* lds, int tid, int wave, int lane) {
    LAS bf16_t* KT = (LAS bf16_t*)lds;
    const int tok0 = b * SEQ + c * 128; const bf16_t* proj = (const bf16_t*)(p.ws + WS_PROJ);
    const float lg = log2f(1.0f - exp2f(-5.0f - (float)h));
    { const int cc = tid & 7, j0 = (tid >> 3) * 2; float k0[8], k1[8];
      unpack8(*(const u32x4*)(proj + (size_t)(tok0 + j0) * PP + CK + h * 64 + cc * 8), k0); unpack8(*(const u32x4*)(proj + (size_t)(tok0 + j0 + 1) * PP + CK + h * 64 + cc * 8), k1);
      const float z0 = exp2f((float)(127 - j0) * lg), z1 = exp2f((float)(126 - j0) * lg);
#pragma unroll
      for (int e = 0; e < 8; ++e) *(LAS unsigned*)(KT + (cc * 8 + e) * 136 + j0) = pk2(k0[e] * z0, k1[e] * z1); }
    __syncthreads();
    const int fr = lane & 15, quad = lane >> 4, et = wave >> 1;
    const bf16_t* vtr = (const bf16_t*)(p.ws + WS_VT) + (size_t)12 * 1024 * 1024 + ((size_t)((b * 4 + h) * 64 + et * 16 + fr)) * SEQ + c * 128 + quad * 8;
    bf16x8_t vf[4];
#pragma unroll
    for (int ks = 0; ks < 4; ++ks) vf[ks] = *(const bf16x8_t*)(vtr + ks * 32);
    float* dst = (float*)(p.ws + WS_RST) + ((size_t)((b * 32 + c) * 4 + h)) * 4096 + (et * 16 + quad * 4) * 64 + fr;
#pragma unroll
    for (int d2 = 0; d2 < 2; ++d2) { const int dt = (wave & 1) * 2 + d2; f32x4 acc = (f32x4){0.f, 0.f, 0.f, 0.f};
#pragma unroll
        for (int ks = 0; ks < 4; ++ks) { const bf16x8_t kf = *(const LAS bf16x8_t*)(KT + (dt * 16 + fr) * 136 + ks * 32 + quad * 8); acc = MFMA16(vf[ks], kf, acc); }
#pragma unroll
        for (int jj = 0; jj < 4; ++jj) dst[jj * 64 + dt * 16] = acc[jj]; }
    __syncthreads();
}
DI void ret_y_tile(const Params& p, int b, int c, int h, int I, int lane) {
    const int fr = lane & 15, quad = lane >> 4, smax = (I * 16 + 15) >> 5, i = I * 16 + fr;
    const int tok0 = b * SEQ + c * 128;
    const bf16_t* projb = (const bf16_t*)(p.ws + WS_PROJ) + (size_t)tok0 * PP + h * 64 + quad * 8;
    const float lg = log2f(1.0f - exp2f(-5.0f - (float)h));
    bf16x8_t qf[2];
    qf[0] = *(const bf16x8_t*)(projb + (size_t)i * PP + CQ); qf[1] = *(const bf16x8_t*)(projb + (size_t)i * PP + CQ + 32);
    const int dq = 8 * quad - fr;
    bf16x8_t pb[4];
#pragma unroll
    for (int s = 0; s < 4; ++s) { float e[8];
#pragma unroll
        for (int u = 0; u < 2; ++u) { f32x4 a = (f32x4){0.f, 0.f, 0.f, 0.f};
            if (s <= smax) { const int j = 32 * s + 8 * (fr >> 2) + 4 * u + (fr & 3); const bf16_t* kp = projb + (size_t)j * PP + CK;
                a = MFMA16(*(const bf16x8_t*)kp, qf[0], a); a = MFMA16(*(const bf16x8_t*)(kp + 32), qf[1], a); }
#pragma unroll
            for (int jj = 0; jj < 4; ++jj) { const int cst = 16 * I - 32 * s - 4 * u - jj;
                e[u * 4 + jj] = (dq <= cst) ? a[jj] * exp2f((float)(cst - dq) * lg) : 0.f; } }
        u32x4 w; w.x = pk2(e[0], e[1]); w.y = pk2(e[2], e[3]); w.z = pk2(e[4], e[5]); w.w = pk2(e[6], e[7]); pb[s] = __builtin_bit_cast(bf16x8_t, w); }
    const bf16_t* vtr = (const bf16_t*)(p.ws + WS_VT) + (size_t)12 * 1024 * 1024 + ((size_t)((b * 4 + h) * 64 + fr)) * SEQ + c * 128 + quad * 8;
    const float* prevT = (const float*)(p.ws + WS_RST) + ((size_t)((b * 32 + c) * 4 + h)) * 4096 + fr * 64 + quad * 8;
    f32x4 o[4], o2[4];
#pragma unroll
    for (int et = 0; et < 4; ++et) { o[et] = (f32x4){0.f, 0.f, 0.f, 0.f}; o2[et] = (f32x4){0.f, 0.f, 0.f, 0.f}; }
#pragma unroll
    for (int s = 0; s < 4; ++s) if (s <= smax) {
#pragma unroll
        for (int et = 0; et < 4; ++et) { const bf16x8_t vf = *(const bf16x8_t*)(vtr + (size_t)(et * 16) * SEQ + s * 32); o[et] = MFMA16(vf, pb[s], o[et]); } }
#pragma unroll
    for (int ks = 0; ks < 2; ++ks)
#pragma unroll
        for (int et = 0; et < 4; ++et) { const float* pp = prevT + (et * 16) * 64 + ks * 32; const f32x4 a = *(const f32x4*)pp, b2 = *(const f32x4*)(pp + 4);
            u32x4 w; w.x = pk2(a[0], a[1]); w.y = pk2(a[2], a[3]); w.z = pk2(b2[0], b2[1]); w.w = pk2(b2[2], b2[3]);
            o2[et] = MFMA16(__builtin_bit_cast(bf16x8_t, w), qf[ks], o2[et]); }
    const float xi = exp2f((float)(i + 1) * lg);
    float s2 = 0.f;
#pragma unroll
    for (int et = 0; et < 4; ++et)
#pragma unroll
        for (int jj = 0; jj < 4; ++jj) { const float v = o[et][jj] + xi * o2[et][jj]; o[et][jj] = v; s2 += v * v; }
    s2 += __shfl_xor(s2, 16); s2 += __shfl_xor(s2, 32);
    const float rs = rsqrtf(s2 * (1.0f / 64.0f) + EPS);
    const bf16_t* gp = (const bf16_t*)(p.ws + WS_PROJ) + (size_t)(tok0 + i) * PP + CG + h * 64 + quad * 4;
    bf16_t* yo = (bf16_t*)(p.ws + WS_YCAT) + (size_t)(tok0 + i) * DM + 512 + h * 64 + quad * 4;
#pragma unroll
    for (int et = 0; et < 4; ++et) { const u32x2 gw2 = *(const u32x2*)(gp + et * 16);
        u32x2 w; w.x = pk2(o[et][0] * rs * silu_f(lo16(gw2.x)), o[et][1] * rs * silu_f(hi16(gw2.x))); w.y = pk2(o[et][2] * rs * silu_f(lo16(gw2.y)), o[et][3] * rs * silu_f(hi16(gw2.y)));
        *(u32x2*)(yo + et * 16) = w; }
}

DI void scan_phase(const Params& p, int gt, int NT) {
    float* sst = (float*)(p.ws + WS_SST); const float* cdec = (const float*)(p.ws + WS_CDEC);
    for (int i = gt; i < NB * 4 * 8192; i += NT) { const int b = i >> 15, rem = i & 32767, h = rem >> 13, pn = rem & 8191; float run = 0.f;
#pragma unroll 8
        for (int c = 0; c < 32; ++c) { const size_t idx = ((size_t)((b * 32 + c) * 4 + h)) * 8192 + pn; const float st = sst[idx]; sst[idx] = run; run = cdec[(b * 32 + c) * 4 + h] * run + st; } }
    float* rst = (float*)(p.ws + WS_RST);
    for (int i = gt; i < NB * 4 * 4096; i += NT) { const int b = i >> 14, rem = i & 16383, h = rem >> 12, de = rem & 4095; float run = 0.f;
        const float gc = exp2f(128.0f * log2f(1.0f - exp2f(-5.0f - (float)h)));
#pragma unroll 8
        for (int c = 0; c < 32; ++c) { const size_t idx = ((size_t)((b * 32 + c) * 4 + h)) * 4096 + de; const float st = rst[idx]; rst[idx] = run; run = gc * run + st; } }
}

DI void ssd_y_unit(const Params& p, int l, int b, int c, int g, LAS unsigned char* lds, int tid, int wave, int lane) {
    LAS bf16_t* Cs = (LAS bf16_t*)lds; LAS bf16_t* Bs = Cs + 128 * 136;
    LAS float* CB = (LAS float*)(Bs + 128 * 136); LAS bf16_t* Pv = (LAS bf16_t*)CB;
    LAS float* dts = CB + 128 * 132; LAS float* acs = dts + 256;
    const int tok0 = b * SEQ + c * 128; const bf16_t* proj = (const bf16_t*)(p.ws + WS_PROJ);
    ssd_dt_acum(p, l, tok0, g, dts, acs, wave, lane);
    stage_conv(p, l, Cs, 136, tok0, c * 128, 512 + g * 128, tid);
    { const float* prev = (const float*)(p.ws + WS_SST) + ((size_t)((b * 32 + c) * 4 + 2 * g)) * 8192;
      for (int e = tid; e < 128 * 32; e += NTHR) { const int r = e >> 5, n4 = (e & 31) * 4; const f32x4 v = *(const f32x4*)(prev + r * 128 + n4);
          u32x2 w; w.x = pk2(v[0], v[1]); w.y = pk2(v[2], v[3]); *(LAS u32x2*)(Pv + r * 136 + (r >> 5) * 8 + n4) = w; } }
    __syncthreads();
    const int i = tid >> 2, q = tid & 3, hh = q >> 1;
    float y[32];
#pragma unroll
    for (int cc = 0; cc < 32; ++cc) y[cc] = 0.f;
    nt_acc<32, 128>(y, Cs + i * 136, Pv + (q * 32) * 136 + q * 8, 136);
    { const float ea = __expf(acs[hh * 128 + i]);
#pragma unroll
      for (int cc = 0; cc < 32; ++cc) y[cc] *= ea; }
    __syncthreads();
    stage_conv(p, l, Bs, 136, tok0, c * 128, 256 + g * 128, tid);
    __syncthreads();
    { float cb[32];
#pragma unroll
      for (int cc = 0; cc < 32; ++cc) cb[cc] = 0.f;
      nt_acc<32, 128>(cb, Cs + i * 136, Bs + q * 136, 4 * 136);
#pragma unroll
      for (int cc = 0; cc < 32; ++cc) CB[i * 132 + cc * 4 + q] = cb[cc]; }
    __syncthreads();
    stage_conv(p, l, Bs, 136, tok0, c * 128, g * 128, tid);
    __syncthreads();
    { const float ai = acs[hh * 128 + i]; const int jmax = wave * 16 + 15;
      for (int j = 0; j <= jmax; ++j) { const float m = (j <= i) ? CB[i * 132 + j] * __expf(ai - acs[hh * 128 + j]) * dts[hh * 128 + j] : 0.f; axpy_row<32>(y, m, Bs + j * 136 + q * 32); } }
    { const int head = 2 * g + hh; const float dsk = p.in[10][l * 4 + head]; float xs[32];
#pragma unroll
      for (int c8 = 0; c8 < 32; c8 += 8) { float t8[8]; unpack8(*(const LAS u32x4*)(Bs + i * 136 + q * 32 + c8), t8);
#pragma unroll
          for (int e = 0; e < 8; ++e) xs[c8 + e] = t8[e]; }
      const bf16_t* zp = proj + (size_t)(tok0 + i) * PP + BZ + g * 128 + q * 32; float s2 = 0.f;
#pragma unroll
      for (int c8 = 0; c8 < 32; c8 += 8) { float z8[8]; unpack8(*(const u32x4*)(zp + c8), z8);
#pragma unroll
          for (int e = 0; e < 8; ++e) { const float v = (y[c8 + e] + dsk * xs[c8 + e]) * silu_f(z8[e]); y[c8 + e] = v; s2 += v * v; } }
      s2 += __shfl_xor(s2, 1); s2 += __shfl_xor(s2, 2);
      const float rs = rsqrtf(s2 * (1.0f / 128.0f) + EPS);
      const float* ng = p.in[11] + l * 256 + g * 128 + q * 32;
      bf16_t* yo = (bf16_t*)(p.ws + WS_YCAT) + (size_t)(tok0 + i) * DM + 256 + g * 128 + q * 32;
#pragma unroll
      for (int c8 = 0; c8 < 32; c8 += 8) { u32x4 w; w.x = pk2(y[c8] * rs * ng[c8], y[c8 + 1] * rs * ng[c8 + 1]); w.y = pk2(y[c8 + 2] * rs * ng[c8 + 2], y[c8 + 3] * rs * ng[c8 + 3]);
          w.z = pk2(y[c8 + 4] * rs * ng[c8 + 4], y[c8 + 5] * rs * ng[c8 + 5]); w.w = pk2(y[c8 + 6] * rs * ng[c8 + 6], y[c8 + 7] * rs * ng[c8 + 7]); *(u32x4*)(yo + c8) = w; } }
    __syncthreads();
}

DI void ret_y_unit(const Params& p, int b, int c, int h, LAS unsigned char* lds, int tid, int wave) {
    LAS bf16_t* Qs = (LAS bf16_t*)lds; LAS bf16_t* Ks = Qs + 128 * 72; LAS bf16_t* Vs = Ks + 128 * 72;
    LAS float* Pr = (LAS float*)(Vs + 128 * 72); LAS float* S = Pr + 64 * 64;
    const int tok0 = b * SEQ + c * 128; const bf16_t* proj = (const bf16_t*)(p.ws + WS_PROJ);
    for (int e = tid; e < 128 * 8; e += NTHR) { const int j = e >> 3, c8 = (e & 7) * 8; const bf16_t* rp = proj + (size_t)(tok0 + j) * PP + h * 64 + c8;
        *(LAS u32x4*)(Qs + j * 72 + c8) = *(const u32x4*)(rp + CQ); *(LAS u32x4*)(Ks + j * 72 + c8) = *(const u32x4*)(rp + CK); *(LAS u32x4*)(Vs + j * 72 + c8) = *(const u32x4*)(rp + CV); }
    { const float* prev = (const float*)(p.ws + WS_RST) + ((size_t)((b * 32 + c) * 4 + h)) * 4096;
      for (int e = tid; e < 1024; e += NTHR) *(LAS f32x4*)(Pr + e * 4) = *(const f32x4*)(prev + e * 4); }
    __syncthreads();
    const int i = tid >> 2, q = tid & 3; const float lg = log2f(1.0f - exp2f(-5.0f - (float)h));
    { float s[32];
#pragma unroll
      for (int cc = 0; cc < 32; ++cc) s[cc] = 0.f;
      nt_acc<32, 64>(s, Qs + i * 72, Ks + q * 72, 4 * 72);
#pragma unroll
      for (int cc = 0; cc < 32; ++cc) { const int j = cc * 4 + q; S[i * 132 + j] = (j <= i) ? s[cc] * exp2f((float)(i - j) * lg) : 0.f; } }
    __syncthreads();
    float y[16];
#pragma unroll
    for (int cc = 0; cc < 16; ++cc) y[cc] = 0.f;
    for (int d = 0; d < 64; ++d) { const float qv = bf2f(Qs[i * 72 + d]);
#pragma unroll
        for (int c4 = 0; c4 < 16; c4 += 4) { const f32x4 pv = *(const LAS f32x4*)(Pr + d * 64 + q * 16 + c4); y[c4] += qv * pv[0]; y[c4 + 1] += qv * pv[1]; y[c4 + 2] += qv * pv[2]; y[c4 + 3] += qv * pv[3]; } }
    { const float xi = exp2f((float)(i + 1) * lg);
#pragma unroll
      for (int cc = 0; cc < 16; ++cc) y[cc] *= xi; }
    { const int jmax = wave * 16 + 15;
      for (int j = 0; j <= jmax; ++j) axpy_row<16>(y, S[i * 132 + j], Vs + j * 72 + q * 16); }
    float s2 = 0.f;
#pragma unroll
    for (int cc = 0; cc < 16; ++cc) s2 += y[cc] * y[cc];
    s2 += __shfl_xor(s2, 1); s2 += __shfl_xor(s2, 2);
    const float rs = rsqrtf(s2 * (1.0f / 64.0f) + EPS);
    const bf16_t* gp = proj + (size_t)(tok0 + i) * PP + CG + h * 64 + q * 16;
    bf16_t* yo = (bf16_t*)(p.ws + WS_YCAT) + (size_t)(tok0 + i) * DM + 512 + h * 64 + q * 16;
#pragma unroll
    for (int c8 = 0; c8 < 16; c8 += 8) { float g8[8]; unpack8(*(const u32x4*)(gp + c8), g8); u32x4 w;
        w.x = pk2(y[c8] * rs * silu_f(g8[0]), y[c8 + 1] * rs * silu_f(g8[1])); w.y = pk2(y[c8 + 2] * rs * silu_f(g8[2]), y[c8 + 3] * rs * silu_f(g8[3]));
        w.z = pk2(y[c8 + 4] * rs * silu_f(g8[4]), y[c8 + 5] * rs * silu_f(g8[5])); w.w = pk2(y[c8 + 6] * rs * silu_f(g8[6]), y[c8 + 7] * rs * silu_f(g8[7])); *(u32x4*)(yo + c8) = w; }
    __syncthreads();
}

#define SSB ((float*)(ws + WS_SS))
#define XB ((bf16_t*)(ws + WS_XB))
#define YC ((bf16_t*)(ws + WS_YCAT))
#define PROJ ((bf16_t*)(ws + WS_PROJ))
#define HB ((bf16_t*)(ws + WS_H))
#define PE ((bf16_t*)(ws + WS_PE))

#define CAS4 __attribute__((address_space(4)))
#define RELOAD_P() const CAS4 Params* kp_ = (const CAS4 Params*)__builtin_amdgcn_kernarg_segment_ptr(); asm volatile("" : "+s"(kp_)); const Params& p = *(const Params*)kp_; unsigned char* ws = p.ws; (void)ws
#define FRESH_LANE(v) int v; asm volatile("v_mbcnt_lo_u32_b32 %0, -1, 0\n\tv_mbcnt_hi_u32_b32 %0, -1, %0" : "=v"(v))
#define RELOAD_IDS() RELOAD_P(); FRESH_LANE(lane_); const int lane = lane_, wave = wave_s, tid = wave_s * 64 + lane_; const int gw = blk * NWV + wave, gt = blk * NTHR + tid; (void)gw; (void)gt; (void)lane
#define GEMM_TID() ({ FRESH_LANE(l_); wave_s * 64 + l_; })
#define GBAR() do { ++nbar; asm volatile("s_waitcnt vmcnt(0)" ::: "memory"); __syncthreads(); { FRESH_LANE(l_); if (wave_s == 0 && l_ == 0) { RELOAD_P(); unsigned* bar = (unsigned*)(ws + WS_BAR); \
        const bool grouped = (G & 15) == 0; const unsigned gsz = grouped ? (unsigned)G >> 4 : (unsigned)G, ngrp = grouped ? 16u : 1u; unsigned* gc = bar + 64 + 64 * (grouped ? (blk & 15) : 0); \
        __builtin_amdgcn_fence(__ATOMIC_RELEASE, "agent"); \
        const unsigned old = __hip_atomic_fetch_add(gc, 1u, __ATOMIC_RELAXED, __HIP_MEMORY_SCOPE_AGENT); \
        if (old + 1u == nbar * gsz) __hip_atomic_fetch_add(bar, 1u, __ATOMIC_RELAXED, __HIP_MEMORY_SCOPE_AGENT); \
        const unsigned target = nbar * ngrp; \
        while (__hip_atomic_load(bar, __ATOMIC_RELAXED, __HIP_MEMORY_SCOPE_AGENT) < target) __builtin_amdgcn_s_sleep(1); \
        __builtin_amdgcn_fence(__ATOMIC_ACQUIRE, "agent"); } } __syncthreads(); } while (0)
#define SS_IN (SSB + (l == 0 ? 0 : 3 * M))
#define SSA (SSB + (1 + 3 * l) * M)
#define SSBB (SSB + (2 + 3 * l) * M)
#define SSC (SSB + (3 + 3 * l) * M)
template <int l> DI void run_layer(LAS unsigned char* lds, const int G, const int blk, const int NGW, const int NT, const int wave_s, unsigned& nbar) {

        { RELOAD_P(); pg8::Gemm g{l == 0 ? XB : YC, (const bf16_t*)(ws + WS_WIN), M, PP, DM}; pg8::StaticOrder S; S.init(M, PP, G, blk);
          pg8::EpiScale<0> E{PROJ, PP, SS_IN};
          pg8::gemm_phase<pg8::EpiScale<0>, pg8::StaticOrder, true, true>(lds, g, S, E, GEMM_TID()); }
        GBAR();
        { RELOAD_IDS(); for (int t = blk; t < 256; t += G) e1_tile(p, l, t, lds, tid, wave, lane); }
        GBAR();
        { RELOAD_IDS(); for (int u = blk; u < 256; u += G) ssd_states_mfma(p, l, u >> 6, (u >> 1) & 31, u & 1, lds, tid, wave, lane); }
        { RELOAD_IDS(); for (int u = blk; u < 512; u += G) ret_states_mfma(p, u >> 7, (u >> 2) & 31, u & 3, lds, tid, wave, lane); }
        { RELOAD_IDS(); for (int u = blk; u < 256; u += G) conv_unit(p, l, u >> 6, (u & 63) * 64, lds, tid, wave, lane); }
        { RELOAD_IDS(); for (int ub = blk; ub < 256; ub += G) { const int bh = ub >> 4, seg = ub & 15;
            for (int it = 0; it < 6; ++it) { const int task = it * 8 + wave, pat = task >> 4, k = task & 15;
                const int r = pat == 0 ? 0 : (pat == 1 ? (k >> 2) : k); const int i0 = pat == 0 ? seg * 256 + k * 16 : (pat == 1 ? seg * 64 + (k & 3) * 16 : seg * 16);
                attn_tile(p, bh >> 2, bh & 3, pat, r, i0, lane); } } }
        GBAR();
        { RELOAD_IDS(); scan_phase(p, gt, NT); attn_combine(p, gt, NT); }
        GBAR();
        { RELOAD_IDS(); for (int u = blk; u < 256; u += G) ssd_y_mfma(p, l, u >> 6, (u >> 1) & 31, u & 1, lds, tid, wave, lane); }
        { RELOAD_IDS(); int flip = 0; for (int u = blk; u < 512; u += G, flip ^= 7) ret_y_tile(p, u >> 7, (u >> 2) & 31, u & 3, wave ^ flip, lane); }
        GBAR();
        { RELOAD_P(); pg8::Gemm g{YC, (const bf16_t*)(ws + WS_WOUT), M, DM, DM}; pg8::StaticOrder S; S.init(M, DM, G, blk);
          pg8::EpiRes<0> E{l == 0 ? p.in[0] : p.out, p.out, XB, SSA, DM, nullptr, nullptr};
          pg8::gemm_phase<pg8::EpiRes<0>, pg8::StaticOrder, true, true>(lds, g, S, E, GEMM_TID()); }
        GBAR();
        { RELOAD_P(); pg8::Gemm g{XB, (const bf16_t*)(ws + WS_WUP), M, FF, DM}; pg8::StaticOrder S; S.init(M, FF, G, blk);
          pg8::EpiScale<1> E{HB, FF, SSA};
          pg8::gemm_phase<pg8::EpiScale<1>, pg8::StaticOrder, true, true>(lds, g, S, E, GEMM_TID()); }
        GBAR();
        { RELOAD_P(); pg8::Gemm g{HB, (const bf16_t*)(ws + WS_WDOWN), M, DM, FF}; pg8::StaticOrder S; S.init(M, DM, G, blk);
          pg8::EpiRes<0> E{p.out, p.out, XB, SSBB, DM, nullptr, nullptr};
          pg8::gemm_phase<pg8::EpiRes<0>, pg8::StaticOrder, true, true>(lds, g, S, E, GEMM_TID()); }
        GBAR();
        if (l == 0) { RELOAD_IDS(); convert_weights(p, 1, 1, lds, gw, NGW, lane, wave); __syncthreads(); }
        { RELOAD_P(); pg8::Gemm g{(const bf16_t*)(ws + (l ? WS_PB1 : WS_PB0)), (const bf16_t*)(ws + (l ? WS_WPLE1 : WS_WPLE0)), M, DM, PLE}; pg8::StaticOrder S; S.init(M, DM, G, blk);
          pg8::EpiPe E{PE, DM};
          pg8::gemm_phase<pg8::EpiPe, pg8::StaticOrder, true, true>(lds, g, S, E, GEMM_TID()); }
        { RELOAD_P(); pg8::Gemm g{XB, (const bf16_t*)(ws + (l ? WS_WGATE1 : WS_WGATE0)), M, DM, DM}; pg8::StaticOrder S; S.init(M, DM, G, blk);
          pg8::EpiRes<1> E{p.out, p.out, YC, SSC, DM, PE, SSBB};
          pg8::gemm_phase<pg8::EpiRes<1>, pg8::StaticOrder, true, true>(lds, g, S, E, GEMM_TID()); }
        if (l == 0) GBAR();
    }

__global__ void __launch_bounds__(NTHR, 2) fwd_kernel(Params p_unused) {
    extern __shared__ __attribute__((aligned(16))) unsigned char lds_raw[];
    LAS unsigned char* lds = (LAS unsigned char*)lds_raw;
    cg::grid_group grid = cg::this_grid();
    const int G = gridDim.x, blk = blockIdx.x;
    const int NGW = G * NWV, NT = G * NTHR;
    const int wave_s = __builtin_amdgcn_readfirstlane(threadIdx.x >> 6);
    unsigned nbar = 0;
    { RELOAD_IDS();
    prologue(p, gw, NGW, lane);
    convert_weights(p, 0, 3, lds, gw, NGW, lane, wave);
    convert_weights(p, 1, 2, lds, gw, NGW, lane, wave); }
    grid.sync();

    run_layer<0>(lds, G, blk, NGW, NT, wave_s, nbar);
    run_layer<1>(lds, G, blk, NGW, NT, wave_s, nbar);
}

extern "C" void kernel_launch(void* const* d_in, const int* in_sizes, int n_in, void* d_out, int out_size, void* d_ws, size_t ws_size, hipStream_t stream) {
    static int grid = 0;
    if (grid == 0) {
        int dev = 0, cus = 0, per_cu = 0;
        hipGetDevice(&dev); hipDeviceGetAttribute(&cus, hipDeviceAttributeMultiprocessorCount, dev);
        if (hipFuncSetAttribute((const void*)fwd_kernel, hipFuncAttributeMaxDynamicSharedMemorySize, LDS_BYTES) != hipSuccess) { fprintf(stderr, "kernel_launch: hipFuncSetAttribute failed\n"); }
        if (hipOccupancyMaxActiveBlocksPerMultiprocessor(&per_cu, (const void*)fwd_kernel, NTHR, LDS_BYTES) != hipSuccess || per_cu < 1) { fprintf(stderr, "kernel_launch: occupancy query says %d\n", per_cu); per_cu = 1; }
        (void)hipGetLastError();
        grid = cus * (per_cu > 1 ? 1 : per_cu);
        if (n_in != 23 || ws_size < WS_END) { fprintf(stderr, "kernel_launch: unexpected n_in %d / ws %zu\n", n_in, ws_size); }
    }
    (void)hipMemsetAsync((unsigned char*)d_ws + WS_BAR, 0, 8192, stream);
    Params p{};
    for (int i = 0; i < 23; ++i) p.in[i] = (const float*)d_in[i];
    p.out = (float*)d_out; p.ws = (unsigned char*)d_ws;
    void* args[] = {&p};
    hipError_t e = hipLaunchCooperativeKernel((const void*)fwd_kernel, dim3(grid), dim3(NTHR), args, LDS_BYTES, stream);
    if (e != hipSuccess) fprintf(stderr, "cooperative launch failed: %s (grid %d)\n", hipGetErrorString(e), grid);
}
```

```cpp
#include <hip/hip_runtime.h>
#include <cstdio>
#include <cstdint>
namespace pg8 {
#define PG8_LAS __attribute__((address_space(3)))
typedef unsigned short bf16_t;
typedef short bf16x8 __attribute__((ext_vector_type(8)));
typedef float f32x4 __attribute__((ext_vector_type(4)));
typedef unsigned u32x4 __attribute__((ext_vector_type(4)));
constexpr int BM = 256, BK = 64, HALF = 128, HTB = HALF * BK * 2  , STAGE_BYTES = 8 * HTB, NXCD = 8, WGM = 8;

__host__ __device__ __forceinline__ int lds_byte(int r, int c) { const int st = (r >> 4) * 2 + (c >> 5), rr = r & 15, cc = c & 31, ob = rr * 64 + cc * 2; return st * 1024 + (ob ^ (((ob >> 9) & 1) << 5)); }
__host__ __device__ __forceinline__ void stage_rc(int b, int& R, int& C) { const int st = b / 1024, sb = b % 1024, swz = sb ^ (((sb >> 9) & 1) << 5); R = (st >> 1) * 16 + swz / 64; C = (st & 1) * 32 + (swz % 64) / 2; }
__host__ __device__ __forceinline__ int perm32(int rho) { const int n = rho >> 4, i = rho & 15; return 8 * (i >> 2) + 4 * n + (i & 3); }

struct Unit { int pm, pn; };
struct Gemm { const bf16_t* A; const bf16_t* Bt; int M, N, K; };

struct StaticOrder {
    int nM, nN, nwg, G, c;
    __host__ __device__ void init(int M, int N, int G_, int c_) { nM = M / BM; nN = N / BM; nwg = nM * nN; G = G_; c = c_; }
    __host__ __device__ bool next(int i, Unit& u) const {
        const long L = (long)i * G + c; if (L >= nwg) return false;
        int wgid = (int)L; { const int q = nwg / NXCD, r = nwg % NXCD, xcd = wgid % NXCD, off = wgid / NXCD; wgid = (xcd < r ? xcd * (q + 1) : r * (q + 1) + (xcd - r) * q) + off; }
        const int nig = WGM * nN, gid = wgid / nig, fm = gid * WGM, gsz = (nM - fm) < WGM ? (nM - fm) : WGM;
        u.pm = fm + ((wgid % nig) % gsz); u.pn = (wgid % nig) / gsz; return true;
    }
    __device__ __forceinline__ void a_ready(const Unit&) const {}
    __device__ __forceinline__ void done(const Unit&) const {}
};

__device__ __forceinline__ unsigned cvt_pk_bf16(float lo, float hi) { unsigned r; asm volatile("v_cvt_pk_bf16_f32 %0, %1, %2" : "=v"(r) : "v"(lo), "v"(hi)); return r; }

typedef unsigned u32x2 __attribute__((ext_vector_type(2)));
constexpr float RMS_EPS = 1e-6f;
template <int ACT> struct EpiScale {
    static constexpr bool PERM = true, AFTER_DRAIN = false;
    bf16_t* O; int ldc; const unsigned long long* ss;
    __device__ __forceinline__ void operator()(const f32x4 (&acc)[2][2][4][2], const Unit& u, int wr, int wc, int fr, int fq) const {
        const int row0 = u.pm * BM + wr * 64 + fr; const int col0 = u.pn * BM + wc * 32 + 8 * fq;
        float rr[2][4];
#pragma unroll
        for (int ai = 0; ai < 2; ++ai)
#pragma unroll
            for (int m = 0; m < 4; ++m) rr[ai][m] = (float)ss[row0 + ai * HALF + m * 16] * (1.0f / 1048576.0f);
#pragma unroll
        for (int ai = 0; ai < 2; ++ai)
#pragma unroll
            for (int m = 0; m < 4; ++m) { const int row = row0 + ai * HALF + m * 16; const float r = rsqrtf(rr[ai][m] * (1.0f / 1024.0f) + RMS_EPS);
                bf16_t* rowp = O + (size_t)row * ldc + col0;
#pragma unroll
                for (int bj = 0; bj < 2; ++bj) { f32x4 v0 = acc[ai][bj][m][0] * r, v1 = acc[ai][bj][m][1] * r;
                    if (ACT == 1) {
#pragma unroll
                        for (int e = 0; e < 4; ++e) { float a = fmaxf(v0[e], 0.f), b = fmaxf(v1[e], 0.f); v0[e] = a * a; v1[e] = b * b; } }
                    u32x4 w; w.x = cvt_pk_bf16(v0[0], v0[1]); w.y = cvt_pk_bf16(v0[2], v0[3]); w.z = cvt_pk_bf16(v1[0], v1[1]); w.w = cvt_pk_bf16(v1[2], v1[3]);
                    *(u32x4*)(rowp + bj * HALF) = w; }
                asm volatile("" ::: "memory"); }
    }
};
struct EpiPe {
    static constexpr bool PERM = true, AFTER_DRAIN = false;
    bf16_t* O; int ldc;
    __device__ __forceinline__ void operator()(const f32x4 (&acc)[2][2][4][2], const Unit& u, int wr, int wc, int fr, int fq) const {
        const int col0 = u.pn * BM + wc * 32 + 8 * fq;
#pragma unroll
        for (int ai = 0; ai < 2; ++ai)
#pragma unroll
            for (int m = 0; m < 4; ++m) { const size_t off = (size_t)(u.pm * BM + ai * HALF + wr * 64 + m * 16 + fr) * ldc + col0;
#pragma unroll
                for (int bj = 0; bj < 2; ++bj) { const f32x4 v0 = acc[ai][bj][m][0], v1 = acc[ai][bj][m][1];
                    u32x4 w; w.x = cvt_pk_bf16(v0[0], v0[1]); w.y = cvt_pk_bf16(v0[2], v0[3]); w.z = cvt_pk_bf16(v1[0], v1[1]); w.w = cvt_pk_bf16(v1[2], v1[3]);
                    *(u32x4*)(O + off + bj * HALF) = w; } }
    }
};
template <int GATE, int BB, int WF, int WB> struct EpiRes {
    static constexpr bool PERM = true, AFTER_DRAIN = false;
    const float* base; const bf16_t* baseb; float* out; bf16_t* xb; unsigned long long* ssout; int ldc; const bf16_t* pe; const unsigned long long* ss;
    __device__ __forceinline__ void operator()(const f32x4 (&acc)[2][2][4][2], const Unit& u, int wr, int wc, int fr, int fq) const {
        const int col0 = u.pn * BM + wc * 32 + 8 * fq;
        float rr[2][4];
        if (GATE) {
#pragma unroll
            for (int ai = 0; ai < 2; ++ai)
#pragma unroll
                for (int m = 0; m < 4; ++m) rr[ai][m] = (float)ss[u.pm * BM + ai * HALF + wr * 64 + m * 16 + fr] * (1.0f / 1048576.0f);
        }
#pragma unroll
        for (int aim = 0; aim < 4; ++aim) { const int ai = aim >> 1, mh = (aim & 1) * 2;
            f32x4 bs[4][2][2]; u32x4 bw[4][2]; u32x4 pw[4][2];
#pragma unroll
            for (int m = mh; m < mh + 2; ++m) { const size_t off = (size_t)(u.pm * BM + ai * HALF + wr * 64 + m * 16 + fr) * ldc + col0;
#pragma unroll
                for (int bj = 0; bj < 2; ++bj) { if (BB) bw[m][bj] = *(const u32x4*)(baseb + off + bj * HALF); else { bs[m][bj][0] = *(const f32x4*)(base + off + bj * HALF); bs[m][bj][1] = *(const f32x4*)(base + off + bj * HALF + 4); }
                    if (GATE) pw[m][bj] = *(const u32x4*)(pe + off + bj * HALF); } }
#pragma unroll
            for (int m = mh; m < mh + 2; ++m) { const int row = u.pm * BM + ai * HALF + wr * 64 + m * 16 + fr; const size_t off = (size_t)row * ldc + col0; float s = 0.f;
                float r = 1.f; if (GATE) r = rsqrtf(rr[ai][m] * (1.0f / 1024.0f) + RMS_EPS);
#pragma unroll
                for (int bj = 0; bj < 2; ++bj) { const size_t o2 = off + bj * HALF; f32x4 a0 = acc[ai][bj][m][0], a1 = acc[ai][bj][m][1];
                    if (GATE) { const u32x4 pq = pw[m][bj];
                        const float p0 = __uint_as_float(pq.x << 16), p1 = __uint_as_float(pq.x & 0xffff0000u), p2 = __uint_as_float(pq.y << 16), p3 = __uint_as_float(pq.y & 0xffff0000u);
                        const float p4 = __uint_as_float(pq.z << 16), p5 = __uint_as_float(pq.z & 0xffff0000u), p6 = __uint_as_float(pq.w << 16), p7 = __uint_as_float(pq.w & 0xffff0000u);
                        a0[0] = p0 / (1.f + __expf(-a0[0] * r)); a0[1] = p1 / (1.f + __expf(-a0[1] * r)); a0[2] = p2 / (1.f + __expf(-a0[2] * r)); a0[3] = p3 / (1.f + __expf(-a0[3] * r));
                        a1[0] = p4 / (1.f + __expf(-a1[0] * r)); a1[1] = p5 / (1.f + __expf(-a1[1] * r)); a1[2] = p6 / (1.f + __expf(-a1[2] * r)); a1[3] = p7 / (1.f + __expf(-a1[3] * r)); }
                    f32x4 b0, b1; if (BB) { const u32x4 q4 = bw[m][bj]; b0 = (f32x4){__uint_as_float(q4.x << 16), __uint_as_float(q4.x & 0xffff0000u), __uint_as_float(q4.y << 16), __uint_as_float(q4.y & 0xffff0000u)};
                        b1 = (f32x4){__uint_as_float(q4.z << 16), __uint_as_float(q4.z & 0xffff0000u), __uint_as_float(q4.w << 16), __uint_as_float(q4.w & 0xffff0000u)}; } else { b0 = bs[m][bj][0]; b1 = bs[m][bj][1]; }
                    const f32x4 o0 = b0 + a0, o1 = b1 + a1; if (WF) { *(f32x4*)(out + o2) = o0; *(f32x4*)(out + o2 + 4) = o1; }
                    if (WB) { u32x4 w; w.x = cvt_pk_bf16(o0[0], o0[1]); w.y = cvt_pk_bf16(o0[2], o0[3]); w.z = cvt_pk_bf16(o1[0], o1[1]); w.w = cvt_pk_bf16(o1[2], o1[3]); *(u32x4*)(xb + o2) = w;
                        s += ((o0[0] * o0[0] + o0[1] * o0[1]) + (o0[2] * o0[2] + o0[3] * o0[3])) + ((o1[0] * o1[0] + o1[1] * o1[1]) + (o1[2] * o1[2] + o1[3] * o1[3])); } }
                if (WB) { s += __shfl_xor(s, 16); s += __shfl_xor(s, 32);
                    if (fq == 0) atomicAdd(ssout + row, (unsigned long long)(s * 1048576.0f + 0.5f)); } }
            asm volatile("" ::: "memory"); }
    }
};
template <class Epi, class Sched, bool ALIGN_EPI = false, bool SP2 = false>
__device__ __forceinline__ void gemm_phase(PG8_LAS unsigned char* lds, const Gemm g, const Sched& S, const Epi& E, int tid_) {
    const int tid = tid_, wid = __builtin_amdgcn_readfirstlane(tid >> 6), lane = tid & 63, wr = wid >> 2, wc = wid & 3, fr = lane & 15, fq = lane >> 4;
    const int K = g.K, nt = K / BK;
    unsigned voffA[2], voffB[2];
#pragma unroll
    for (int i = 0; i < 2; ++i) { int R, C; stage_rc(tid * 16 + i * 8192, R, C); const int Rb = Epi::PERM ? ((R & ~31) + perm32(R & 31)) : R;
        voffA[i] = (unsigned)(R * K + C) * 2u; voffB[i] = (unsigned)(Rb * K + C) * 2u; }
    const size_t kstep = (size_t)(BK * 2);
    const size_t hstep = (size_t)HALF * K * 2;
    const size_t tstep = 2 * hstep;
    const unsigned ldsw = (unsigned)wid * 1024u;
    const int aoff = lds_byte(wr * 64 + fr, fq * 8), boff = lds_byte(wc * 32 + fr, fq * 8);
#define PG8_SA(b, h) (((b) * 2 + (h)) * HTB)
#define PG8_SB(b, h) ((4 + (b) * 2 + (h)) * HTB)
#define PG8_STAGE(bufoff, gbase, voff) do { _Pragma("unroll") for (int _i = 0; _i < 2; ++_i) \
        __builtin_amdgcn_global_load_lds((const unsigned*)((const char*)(gbase) + (voff)[_i]), (PG8_LAS unsigned*)(lds + (bufoff) + ldsw + _i * 8192), 16, 0, 0); } while (0)
#define PG8_LDA(dst, b, h) do { _Pragma("unroll") for (int m = 0; m < 4; ++m) _Pragma("unroll") for (int k = 0; k < 2; ++k) dst[m][k] = *(const PG8_LAS bf16x8*)(lds + PG8_SA(b, h) + aoff + m * 2048 + k * 1024); } while (0)
#define PG8_LDB(dst, b, h) do { _Pragma("unroll") for (int n = 0; n < 2; ++n) _Pragma("unroll") for (int k = 0; k < 2; ++k) dst[n][k] = *(const PG8_LAS bf16x8*)(lds + PG8_SB(b, h) + boff + n * 2048 + k * 1024); } while (0)
#define PG8_MMA(ai, bj, At, Bt) do { __builtin_amdgcn_s_setprio(1); _Pragma("unroll") for (int m = 0; m < 4; ++m) _Pragma("unroll") for (int n = 0; n < 2; ++n) _Pragma("unroll") for (int k = 0; k < 2; ++k) \
        acc[ai][bj][m][n] = __builtin_amdgcn_mfma_f32_16x16x32_bf16(Bt[n][k], At[m][k], acc[ai][bj][m][n], 0, 0, 0); __builtin_amdgcn_s_setprio(0); } while (0)
#define PG8_WAIT_V(n) asm volatile("s_waitcnt vmcnt(" #n ")" ::: "memory")
#define PG8_WAIT_L(n) asm volatile("s_waitcnt lgkmcnt(" #n ")" ::: "memory")
#define PG8_BAR __builtin_amdgcn_s_barrier()
#define PG8_SCHED __builtin_amdgcn_sched_barrier(0)
    Unit cur, nxt; int ui = 0;
    if (!S.next(0, cur)) return;
    f32x4 acc[2][2][4][2];
#pragma unroll
    for (int a = 0; a < 2; ++a)
#pragma unroll
        for (int b = 0; b < 2; ++b)
#pragma unroll
            for (int m = 0; m < 4; ++m)
#pragma unroll
                for (int n = 0; n < 2; ++n) acc[a][b][m][n] = (f32x4){0.f, 0.f, 0.f, 0.f};
    bf16x8 At[4][2], B0[2][2], B1[2][2];
    const char* cA = (const char*)g.A + (size_t)cur.pm * tstep; const char* cB = (const char*)g.Bt + (size_t)cur.pn * tstep;
    S.a_ready(cur);
    if constexpr (SP2) {
        PG8_STAGE(PG8_SB(0, 0), cB, voffB); PG8_STAGE(PG8_SB(0, 1), cB + hstep, voffB); PG8_STAGE(PG8_SA(0, 0), cA, voffA); PG8_STAGE(PG8_SA(0, 1), cA + hstep, voffA);
        if (wr == 1) PG8_BAR;
        PG8_WAIT_V(2); PG8_BAR;
        PG8_STAGE(PG8_SB(1, 0), cB + kstep, voffB); PG8_STAGE(PG8_SA(1, 0), cA + kstep, voffA); PG8_STAGE(PG8_SB(1, 1), cB + hstep + kstep, voffB);
        PG8_WAIT_V(6); PG8_BAR;
    } else {
        PG8_STAGE(PG8_SB(0, 0), cB, voffB); PG8_STAGE(PG8_SA(0, 0), cA, voffA); PG8_STAGE(PG8_SB(0, 1), cB + hstep, voffB); PG8_STAGE(PG8_SA(0, 1), cA + hstep, voffA);
        if (wr == 1) PG8_BAR;
        PG8_WAIT_V(4); PG8_BAR;
        PG8_STAGE(PG8_SB(1, 0), cB + kstep, voffB); PG8_STAGE(PG8_SA(1, 0), cA + kstep, voffA); PG8_STAGE(PG8_SB(1, 1), cB + hstep + kstep, voffB);
        PG8_WAIT_V(6); PG8_BAR;
    }
    for (;;) {
        const bool has_next = S.next(ui + 1, nxt);
        const char* nA = has_next ? (const char*)g.A + (size_t)nxt.pm * tstep : cA; const char* nB = has_next ? (const char*)g.Bt + (size_t)nxt.pn * tstep : cB;
        for (int t = 0; t < nt; t += 2) {
            const bool last = (t == nt - 2);
            const char* a1 = cA + (size_t)(t + 1) * kstep;
            const char* a2 = last ? nA : cA + (size_t)(t + 2) * kstep; const char* b2 = last ? nB : cB + (size_t)(t + 2) * kstep;
            const char* a3 = a2 + kstep; const char* b3 = b2 + kstep;
            if (last && has_next) S.a_ready(nxt);
            if constexpr (SP2) {
            PG8_LDB(B0, 0, 0); PG8_LDB(B1, 0, 1); PG8_SCHED; PG8_LDA(At, 0, 0); PG8_STAGE(PG8_SA(1, 1), a1 + hstep, voffA);
            PG8_WAIT_V(8); PG8_WAIT_L(0); PG8_BAR; PG8_MMA(0, 0, At, B0); PG8_MMA(0, 1, At, B1); PG8_BAR; PG8_SCHED;
            PG8_LDA(At, 0, 1); PG8_STAGE(PG8_SB(0, 0), b2, voffB); PG8_STAGE(PG8_SB(0, 1), b2 + hstep, voffB); PG8_STAGE(PG8_SA(0, 0), a2, voffA);
            PG8_WAIT_V(8); PG8_WAIT_L(0); PG8_BAR; PG8_MMA(1, 0, At, B0); PG8_MMA(1, 1, At, B1); PG8_BAR; PG8_SCHED;
            PG8_LDB(B0, 1, 0); PG8_LDB(B1, 1, 1); PG8_SCHED; PG8_LDA(At, 1, 0); PG8_STAGE(PG8_SA(0, 1), a2 + hstep, voffA);
            PG8_WAIT_V(8); PG8_WAIT_L(0); PG8_BAR; PG8_MMA(0, 0, At, B0); PG8_MMA(0, 1, At, B1); PG8_BAR; PG8_SCHED;
            PG8_LDA(At, 1, 1); PG8_STAGE(PG8_SB(1, 0), b3, voffB); PG8_STAGE(PG8_SB(1, 1), b3 + hstep, voffB); PG8_STAGE(PG8_SA(1, 0), a3, voffA);
            PG8_WAIT_V(8); PG8_WAIT_L(0); PG8_BAR; PG8_MMA(1, 0, At, B0); PG8_MMA(1, 1, At, B1); PG8_BAR; PG8_SCHED;
            } else {
            PG8_LDB(B0, 0, 0); PG8_SCHED; PG8_LDA(At, 0, 0); PG8_STAGE(PG8_SA(1, 1), a1 + hstep, voffA);
            PG8_WAIT_L(8); PG8_BAR; PG8_WAIT_L(0); PG8_MMA(0, 0, At, B0); PG8_BAR; PG8_SCHED;
            PG8_LDB(B1, 0, 1); PG8_STAGE(PG8_SB(0, 0), b2, voffB);
            PG8_BAR; PG8_WAIT_L(0); PG8_MMA(0, 1, At, B1); PG8_BAR;
            PG8_LDA(At, 0, 1); PG8_STAGE(PG8_SA(0, 0), a2, voffA);
            PG8_BAR; PG8_WAIT_L(0); PG8_MMA(1, 0, At, B0); PG8_BAR; PG8_SCHED;
            PG8_STAGE(PG8_SB(0, 1), b2 + hstep, voffB);
            PG8_WAIT_V(6); PG8_BAR; PG8_MMA(1, 1, At, B1); PG8_BAR;
            PG8_LDB(B0, 1, 0); PG8_SCHED; PG8_LDA(At, 1, 0); PG8_STAGE(PG8_SA(0, 1), a2 + hstep, voffA);
            PG8_WAIT_L(8); PG8_BAR; PG8_WAIT_L(0); PG8_MMA(0, 0, At, B0); PG8_BAR; PG8_SCHED;
            PG8_LDB(B1, 1, 1); PG8_STAGE(PG8_SB(1, 0), b3, voffB);
            PG8_BAR; PG8_WAIT_L(0); PG8_MMA(0, 1, At, B1); PG8_BAR;
            PG8_LDA(At, 1, 1); PG8_STAGE(PG8_SA(1, 0), a3, voffA);
            PG8_BAR; PG8_WAIT_L(0); PG8_MMA(1, 0, At, B0); PG8_BAR; PG8_SCHED;
            PG8_STAGE(PG8_SB(1, 1), b3 + hstep, voffB);
            PG8_WAIT_V(6); PG8_BAR; PG8_MMA(1, 1, At, B1); PG8_BAR;
            }
        }
        if constexpr (ALIGN_EPI) { if (wr == 0) PG8_BAR; }
        if constexpr (!Epi::AFTER_DRAIN) { E(acc, cur, wr, wc, fr, fq); S.done(cur); }
        if (!has_next) break;
#pragma unroll
        for (int a = 0; a < 2; ++a)
#pragma unroll
            for (int b = 0; b < 2; ++b)
#pragma unroll
                for (int m = 0; m < 4; ++m)
#pragma unroll
                    for (int n = 0; n < 2; ++n) acc[a][b][m][n] = (f32x4){0.f, 0.f, 0.f, 0.f};
        cur = nxt; cA = nA; cB = nB; ++ui;
        if constexpr (ALIGN_EPI) { if (wr == 1) PG8_BAR; }
    }
    PG8_WAIT_V(0);
    if constexpr (!ALIGN_EPI) { if (wr == 0) PG8_BAR; }
    PG8_BAR;
    if constexpr (Epi::AFTER_DRAIN) { E.fused(acc, cur, wr, wc, fr, fq, lds, wid, lane); S.done(cur); }
#undef PG8_SA
#undef PG8_SB
#undef PG8_STAGE
#undef PG8_LDA
#undef PG8_LDB
#undef PG8_MMA
#undef PG8_WAIT_V
#undef PG8_WAIT_L
#undef PG8_BAR
#undef PG8_SCHED
}
}

#include <hip/hip_cooperative_groups.h>
namespace cg = cooperative_groups;
#define LAS __attribute__((address_space(3)))
#define DI __device__ __forceinline__
typedef unsigned short bf16_t;
typedef unsigned u32x4 __attribute__((ext_vector_type(4)));
typedef unsigned u32x2 __attribute__((ext_vector_type(2)));
typedef float f32x4 __attribute__((ext_vector_type(4)));

constexpr int SEQ = 4096, NB = 4, M = NB * SEQ, DM = 1024, FF = 4096, PLE = 256;
constexpr int PN = 3584;
constexpr int PP = 3584;
constexpr int IN_ORIG = 3332;
constexpr int AQ = 0, AK = 256, AV = 512, BZ = 768, BX = 1024, BDT = 1792, CQ = 2048, CK = 2304, CV = 2560, CG = 2816, DV = 3072, DG = 3328;
constexpr float EPS = 1e-6f;
constexpr int NTHR = 512, NWV = 8;
constexpr int LDS_BYTES = 147456;
constexpr size_t MiB = 1u << 20;
constexpr size_t WS_SS = 0;
constexpr size_t WS_CDEC = 940 * 1024; constexpr size_t WS_BAR = 960 * 1024;
constexpr size_t WS_TAB = 1 * MiB;
constexpr size_t WS_PB0 = 3 * MiB;
constexpr size_t WS_WIN = 11 * MiB, WS_WOUT = 18 * MiB, WS_WUP = 20 * MiB, WS_WDOWN = 28 * MiB, WS_WPLE0 = 36 * MiB, WS_WGATE0 = 37 * MiB;
constexpr size_t WS_XB = 39 * MiB, WS_YCAT = 71 * MiB, WS_PROJ = 103 * MiB, WS_SST = 215 * MiB, WS_RST = 231 * MiB;
constexpr size_t WS_H = 103 * MiB, WS_PE = 103 * MiB;
constexpr size_t WS_VT = 39 * MiB;
constexpr size_t WS_LSE = 250 * MiB;
constexpr size_t WS_WPLE1 = 239 * MiB, WS_WGATE1 = 240 * MiB, WS_PB1 = 242 * MiB, WS_END = 256 * MiB;

struct Params {
    const float* in[23]; float* out; unsigned char* ws;
};

DI float bf2f(bf16_t u) { return __uint_as_float((unsigned)u << 16); }
DI unsigned f2bf(float f) { unsigned u = __float_as_uint(f); return (u + 0x7fffu + ((u >> 16) & 1u)) >> 16; }
DI unsigned pk2(float lo, float hi) { return f2bf(lo) | (f2bf(hi) << 16); }
DI float lo16(unsigned w) { return __uint_as_float(w << 16); }
DI float hi16(unsigned w) { return __uint_as_float(w & 0xffff0000u); }
DI float wave_sum(float v) {
#pragma unroll
    for (int o = 1; o < 64; o <<= 1) v += __shfl_xor(v, o);
    return v;
}
DI float wave_max(float v) {
#pragma unroll
    for (int o = 1; o < 64; o <<= 1) v = fmaxf(v, __shfl_xor(v, o));
    return v;
}
DI float silu_f(float v) { return v / (1.f + __expf(-v)); }
DI float sigm_f(float v) { return 1.f / (1.f + __expf(-v)); }
DI void unpack8(const u32x4 w, float (&f)[8]) { f[0] = lo16(w.x); f[1] = hi16(w.x); f[2] = lo16(w.y); f[3] = hi16(w.y); f[4] = lo16(w.z); f[5] = hi16(w.z); f[6] = lo16(w.w); f[7] = hi16(w.w); }

DI void tr_item(const float* W, int K, int Norig, bf16_t* WT, const float* g, bool gap, LAS float* scr, int item, int nblk, int lane) {
    const int kb = item / nblk, nb = item % nblk, k0 = 64 * kb, n0 = 32 * nb;
    const int n = n0 + (lane & 31);
    int orig = n; if (gap) orig = (n < 1796) ? n : (n < 2048 ? -1 : n - 252);
#pragma unroll
    for (int i = 0; i < 32; ++i) { const int kk = 2 * i + (lane >> 5); float v = 0.f;
        if (orig >= 0) { v = W[(size_t)(k0 + kk) * Norig + orig]; if (g) v *= g[k0 + kk]; }
        scr[kk * 33 + (lane & 31)] = v; }
    asm volatile("s_waitcnt lgkmcnt(0)" ::: "memory");
    const int c = lane & 7;
#pragma unroll
    for (int j = 0; j < 4; ++j) { const int nn = (lane >> 3) + 8 * j; const LAS float* s = scr + (8 * c) * 33 + nn;
        u32x4 o; o.x = pk2(s[0 * 33], s[1 * 33]); o.y = pk2(s[2 * 33], s[3 * 33]); o.z = pk2(s[4 * 33], s[5 * 33]); o.w = pk2(s[6 * 33], s[7 * 33]);
        *(u32x4*)(WT + (size_t)(n0 + nn) * K + k0 + 8 * c) = o; }
    asm volatile("s_waitcnt lgkmcnt(0)" ::: "memory");
}
DI void tr_block_item(const float* W, int K, int Norig, bf16_t* WT, const float* g, bool gap, int kb, int nb, LAS float* T, int tid) {
    const int k0 = 64 * kb, n0 = 256 * nb, c4 = tid & 63, kr = tid >> 6;
    const int n = n0 + 4 * c4; int orig = n; if (gap) orig = (n < 1796) ? n : (n < 2048 ? -1 : n - 252);
    f32x4 v[8];
#pragma unroll
    for (int ps = 0; ps < 8; ++ps) { const int k = ps * 8 + kr; v[ps] = (f32x4){0.f, 0.f, 0.f, 0.f}; if (orig >= 0) v[ps] = *(const f32x4*)(W + (size_t)(k0 + k) * Norig + orig); }
#pragma unroll
    for (int ps = 0; ps < 8; ++ps) { const int k = ps * 8 + kr; const float gk = g ? g[k0 + k] : 1.0f; *(LAS f32x4*)(T + k * 260 + 4 * c4) = v[ps] * gk; }
    __syncthreads();
    const int nn = tid & 255, kh = tid >> 8; const LAS float* s = T + (kh * 32) * 260 + nn;
    bf16_t* dst = WT + (size_t)(n0 + nn) * K + k0 + kh * 32;
#pragma unroll
    for (int c = 0; c < 4; ++c) { u32x4 o; o.x = pk2(s[(8 * c) * 260], s[(8 * c + 1) * 260]); o.y = pk2(s[(8 * c + 2) * 260], s[(8 * c + 3) * 260]); o.z = pk2(s[(8 * c + 4) * 260], s[(8 * c + 5) * 260]); o.w = pk2(s[(8 * c + 6) * 260], s[(8 * c + 7) * 260]);
        *(u32x4*)(dst + 8 * c) = o; }
    __syncthreads();
}
DI void convert_weights(const Params& p, int l, int which, LAS unsigned char* lds, int blk, int G, int tid) {
    LAS float* T = (LAS float*)lds; unsigned char* ws = p.ws;
    constexpr int I_IN = 16 * 14, I_OUT = 16 * 4, I_UP = 16 * 16, I_DN = 64 * 4, I_PLE = 4 * 4, I_GATE = 16 * 4;
    const int n_items = ((which & 1) ? (I_IN + I_OUT + I_UP + I_DN) : 0) + ((which & 2) ? (I_PLE + I_GATE) : 0);
    for (int it = blk; it < n_items; it += G) {
        int r = it;
        if (which & 1) {
            if (r < I_IN) { tr_block_item(p.in[3] + (size_t)l * DM * IN_ORIG, DM, IN_ORIG, (bf16_t*)(ws + WS_WIN), p.in[2] + l * DM, true, r / 14, r % 14, T, tid); continue; } r -= I_IN;
            if (r < I_OUT) { tr_block_item(p.in[16] + (size_t)l * DM * DM, DM, DM, (bf16_t*)(ws + WS_WOUT), nullptr, false, r / 4, r % 4, T, tid); continue; } r -= I_OUT;
            if (r < I_UP) { tr_block_item(p.in[18] + (size_t)l * DM * FF, DM, FF, (bf16_t*)(ws + WS_WUP), p.in[17] + l * DM, false, r / 16, r % 16, T, tid); continue; } r -= I_UP;
            if (r < I_DN) { tr_block_item(p.in[19] + (size_t)l * FF * DM, FF, DM, (bf16_t*)(ws + WS_WDOWN), nullptr, false, r / 4, r % 4, T, tid); continue; } r -= I_DN;
        }
        if (r < I_PLE) { tr_block_item(p.in[21] + (size_t)l * PLE * DM, PLE, DM, (bf16_t*)(ws + (l ? WS_WPLE1 : WS_WPLE0)), nullptr, false, r / 4, r % 4, T, tid); continue; } r -= I_PLE;
        tr_block_item(p.in[22] + (size_t)l * DM * DM, DM, DM, (bf16_t*)(ws + (l ? WS_WGATE1 : WS_WGATE0)), p.in[20] + l * DM, false, r / 4, r % 4, T, tid);
    }
    if (which & 2) {
        const f32x4* src = (const f32x4*)(p.in[1] + (size_t)l * M * PLE); u32x2* dst = (u32x2*)(ws + (l ? WS_PB1 : WS_PB0));
        const int gt = blk * NTHR + tid, NT = G * NTHR;
        for (int i = gt; i < M * PLE / 4; i += NT) { const f32x4 v = src[i]; u32x2 o; o.x = pk2(v[0], v[1]); o.y = pk2(v[2], v[3]); dst[i] = o; }
    }
}

DI void prologue(const Params& p, int gw, int NGW, int lane) {
    unsigned char* ws = p.ws;
    const int gt = gw * 64 + lane, NT = NGW * 64;
    unsigned long long* ss = (unsigned long long*)(ws + WS_SS);
    for (int i = gt; i < 6 * M; i += NT) ss[M + i] = 0ull;
    float* tab = (float*)(ws + WS_TAB);
    for (int idx = gt; idx < 2 * SEQ * 32; idx += NT) {
        const int t = idx / (SEQ * 32), e = idx % (SEQ * 32), pos = e >> 5, i = e & 31;
        const double base = t ? 0.7429639507594948 : 0.7498942093324559;
        double a = 1.0;
        for (int k = 0; k < 31; ++k) a = (k < i) ? a * base : a;
        const double ang = (double)pos * a;
        const double kk = rint(ang * 0.15915494309189535);
        const double r = ang - kk * 6.283185307179586477;
        const double r2 = r * r; double s = r, c = 1.0, ts = r, tc = 1.0;
        for (int n = 1; n <= 14; ++n) { tc *= -r2 / (double)((2 * n - 1) * (2 * n)); c += tc; ts *= -r2 / (double)((2 * n) * (2 * n + 1)); s += ts; }
        tab[(size_t)(2 * t) * SEQ * 32 + e] = (float)c; tab[(size_t)(2 * t + 1) * SEQ * 32 + e] = (float)s;
    }
    const float* x = p.in[0]; bf16_t* xb = (bf16_t*)(ws + WS_XB);
    for (int m = gw; m < M; m += NGW) {
        const f32x4* xr = (const f32x4*)(x + (size_t)m * DM) + lane; f32x4 v[4]; float s = 0.f;
#pragma unroll
        for (int j = 0; j < 4; ++j) { v[j] = xr[64 * j]; s += (v[j][0] * v[j][0] + v[j][1] * v[j][1]) + (v[j][2] * v[j][2] + v[j][3] * v[j][3]); }
        s = wave_sum(s);
        if (lane == 0) ss[m] = (unsigned long long)(s * 1048576.0f + 0.5f);
        u32x2* o = (u32x2*)(xb + (size_t)m * DM) + lane;
#pragma unroll
        for (int j = 0; j < 4; ++j) { u32x2 w; w.x = pk2(v[j][0], v[j][1]); w.y = pk2(v[j][2], v[j][3]); o[64 * j] = w; }
    }
}

DI void e1_tokens(const Params& p, int l, int tok_lo, int tok_hi, int lane) {
    bf16_t* proj = (bf16_t*)(p.ws + WS_PROJ); const float* tab = (const float*)(p.ws + WS_TAB);
    const int sub = lane >> 5, l5 = lane & 31, which = l5 >> 2, hq = which & 3, isk = which >> 2, i0 = (l5 & 3) * 8;
    const int col = (sub == 0 ? (isk ? AK : AQ) : (isk ? CK : CQ)) + hq * 64;
    const float* gain = (isk ? p.in[5] : p.in[4]) + l * 64;
    const float sc = ((sub == 0 && !isk) || (sub == 1 && isk)) ? 0.125f : 1.0f;
    const float* ct = tab + (size_t)(2 * sub) * SEQ * 32; const float* st = tab + (size_t)(2 * sub + 1) * SEQ * 32;
    for (int tok0 = tok_lo; tok0 < tok_hi; tok0 += 4) {
        u32x4 a1[4], a2[4]; f32x4 c0[4], c1[4], s0[4], s1[4]; u32x2 vw[4], gwd[4];
#pragma unroll
        for (int t = 0; t < 4; ++t) { const int tok = tok0 + t, pos = tok & (SEQ - 1); const bf16_t* ptr = proj + (size_t)tok * PP + col;
            a1[t] = *(const u32x4*)(ptr + i0); a2[t] = *(const u32x4*)(ptr + 32 + i0);
            c0[t] = *(const f32x4*)(ct + pos * 32 + i0); c1[t] = *(const f32x4*)(ct + pos * 32 + i0 + 4); s0[t] = *(const f32x4*)(st + pos * 32 + i0); s1[t] = *(const f32x4*)(st + pos * 32 + i0 + 4);
            vw[t] = *(const u32x2*)(proj + (size_t)tok * PP + DV + lane * 4); gwd[t] = *(const u32x2*)(proj + (size_t)tok * PP + DG + lane * 4); }
#pragma unroll
        for (int t = 0; t < 4; ++t) { const int tok = tok0 + t; bf16_t* ptr = proj + (size_t)tok * PP + col;
            float x1[8], x2[8]; unpack8(a1[t], x1); unpack8(a2[t], x2);
            float s2 = 0.f;
#pragma unroll
            for (int i = 0; i < 8; ++i) s2 += x1[i] * x1[i] + x2[i] * x2[i];
            s2 += __shfl_xor(s2, 1); s2 += __shfl_xor(s2, 2);
            if (sub == 0) { const float r = rsqrtf(s2 * (1.0f / 64.0f) + EPS);
#pragma unroll
                for (int i = 0; i < 8; ++i) { x1[i] *= r * gain[i0 + i]; x2[i] *= r * gain[32 + i0 + i]; } }
            float o1[8], o2[8];
#pragma unroll
            for (int i = 0; i < 8; ++i) { const float c = i < 4 ? c0[t][i & 3] : c1[t][i & 3], s = i < 4 ? s0[t][i & 3] : s1[t][i & 3]; o1[i] = (x1[i] * c - x2[i] * s) * sc; o2[i] = (x2[i] * c + x1[i] * s) * sc; }
            u32x4 w1, w2; w1.x = pk2(o1[0], o1[1]); w1.y = pk2(o1[2], o1[3]); w1.z = pk2(o1[4], o1[5]); w1.w = pk2(o1[6], o1[7]);
            w2.x = pk2(o2[0], o2[1]); w2.y = pk2(o2[2], o2[3]); w2.z = pk2(o2[4], o2[5]); w2.w = pk2(o2[6], o2[7]);
            *(u32x4*)(ptr + i0) = w1; *(u32x4*)(ptr + 32 + i0) = w2;
            u32x2 o; o.x = pk2(lo16(vw[t].x) * sigm_f(lo16(gwd[t].x)), hi16(vw[t].x) * sigm_f(hi16(gwd[t].x))); o.y = pk2(lo16(vw[t].y) * sigm_f(lo16(gwd[t].y)), hi16(vw[t].y) * sigm_f(hi16(gwd[t].y)));
            *(u32x2*)(proj + (size_t)tok * PP + DV + lane * 4) = o; }
    }
}


DI void e1_tile(const Params& p, int l, int tile, LAS unsigned char* lds, int tid, int wave, int lane) {
    const int T0 = tile * 64; const int b = T0 >> 12, s0 = T0 & (SEQ - 1);
    LAS bf16_t* Vs = (LAS bf16_t*)lds;
    const bf16_t* proj = (const bf16_t*)(p.ws + WS_PROJ);
    LAS bf16_t* Vr = Vs + 64 * 264;
    for (int e = tid; e < 64 * 32; e += NTHR) { const int j = e >> 5, c8 = (e & 31) * 8;
        *(LAS u32x4*)(Vs + j * 264 + c8) = *(const u32x4*)(proj + (size_t)(T0 + j) * PP + AV + c8);
        *(LAS u32x4*)(Vr + j * 264 + c8) = *(const u32x4*)(proj + (size_t)(T0 + j) * PP + CV + c8); }
    e1_tokens(p, l, T0 + wave * 8, T0 + wave * 8 + 8, lane);
    __syncthreads();
    bf16_t* vt = (bf16_t*)(p.ws + WS_VT);
    const int col = tid & 255, half = tid >> 8, h = col >> 6, dim = col & 63;
    {
      bf16_t* dst = vt + ((size_t)((b * 4 + h) * 64 + dim)) * SEQ + s0 + half * 32;
#pragma unroll
      for (int c8 = 0; c8 < 32; c8 += 8) { u32x4 w; const LAS bf16_t* s = Vs + (half * 32 + c8) * 264 + col;
          w.x = (unsigned)s[0] | ((unsigned)s[264] << 16); w.y = (unsigned)s[2 * 264] | ((unsigned)s[3 * 264] << 16); w.z = (unsigned)s[4 * 264] | ((unsigned)s[5 * 264] << 16); w.w = (unsigned)s[6 * 264] | ((unsigned)s[7 * 264] << 16);
          *(u32x4*)(dst + c8) = w; } }
    {
      bf16_t* dst = vt + (size_t)12 * 1024 * 1024 + ((size_t)((b * 4 + h) * 64 + dim)) * SEQ + s0 + half * 32;
#pragma unroll
      for (int c8 = 0; c8 < 32; c8 += 8) { u32x4 w; const LAS bf16_t* s = Vr + (half * 32 + c8) * 264 + col;
          w.x = (unsigned)s[0] | ((unsigned)s[264] << 16); w.y = (unsigned)s[2 * 264] | ((unsigned)s[3 * 264] << 16); w.z = (unsigned)s[4 * 264] | ((unsigned)s[5 * 264] << 16); w.w = (unsigned)s[6 * 264] | ((unsigned)s[7 * 264] << 16);
          *(u32x4*)(dst + c8) = w; } }
    {
      bf16_t* base = vt + (size_t)4 * 1024 * 1024;
#pragma unroll
      for (int r = 0; r < 4; ++r) { const LAS bf16_t* s = Vs + (half * 32 + r) * 264 + col; u32x4 w;
          w.x = (unsigned)s[0] | ((unsigned)s[4 * 264] << 16); w.y = (unsigned)s[8 * 264] | ((unsigned)s[12 * 264] << 16); w.z = (unsigned)s[16 * 264] | ((unsigned)s[20 * 264] << 16); w.w = (unsigned)s[24 * 264] | ((unsigned)s[28 * 264] << 16);
          *(u32x4*)(base + ((size_t)(((b * 4 + h) * 4 + r) * 64 + dim)) * 1024 + (s0 >> 2) + half * 8) = w; } }
    {
      bf16_t* base = vt + (size_t)8 * 1024 * 1024;
#pragma unroll
      for (int r8 = 0; r8 < 8; ++r8) { const int r = half * 8 + r8; const LAS bf16_t* s = Vs + r * 264 + col;
          u32x2 w; w.x = (unsigned)s[0] | ((unsigned)s[16 * 264] << 16); w.y = (unsigned)s[32 * 264] | ((unsigned)s[48 * 264] << 16);
          *(u32x2*)(base + ((size_t)(((b * 4 + h) * 16 + r) * 64 + dim)) * 256 + (s0 >> 4)) = w; } }
    __syncthreads();
}

typedef short bf16x8_t __attribute__((ext_vector_type(8)));
DI void attn_tile(const Params& p, int b, int h, int pat, int r, int i0, int lane) {
    const int dsh = 2 * pat, L = SEQ >> dsh;
    const int fr = lane & 15, quad = lane >> 4;
    const bf16_t* projb = (const bf16_t*)(p.ws + WS_PROJ) + (size_t)(b * SEQ) * PP + h * 64 + quad * 8;
    const int tq = ((i0 + fr) << dsh) + r;
    bf16x8_t qf[2];
    qf[0] = *(const bf16x8_t*)(projb + (size_t)tq * PP + AQ); qf[1] = *(const bf16x8_t*)(projb + (size_t)tq * PP + AQ + 32);
    f32x4 acc[5][2];
    bf16x8_t kfr[5][2][2];
#pragma unroll
    for (int s = 0; s < 5; ++s)
#pragma unroll
        for (int u = 0; u < 2; ++u) {
            const int krel = 32 * s + 8 * (fr >> 2) + 4 * u + (fr & 3);
            int kap = i0 - 128 + krel; kap = kap < 0 ? 0 : (kap > L - 1 ? L - 1 : kap);
            const bf16_t* kp = projb + (size_t)((kap << dsh) + r) * PP + AK;
            kfr[s][u][0] = *(const bf16x8_t*)kp; kfr[s][u][1] = *(const bf16x8_t*)(kp + 32); }
    const bf16_t* vtb = (const bf16_t*)(p.ws + WS_VT) + (size_t)pat * 4 * 1024 * 1024 + ((size_t)((((b * 4 + h) << dsh) + r) * 64 + fr)) * L;
    bf16x8_t vfr[5][4];
#pragma unroll
    for (int s = 0; s < 5; ++s) { int st = i0 - 128 + 32 * s + 8 * quad; st = st < 0 ? 0 : (st > L - 8 ? L - 8 : st);
#pragma unroll
        for (int dt = 0; dt < 4; ++dt) vfr[s][dt] = *(const bf16x8_t*)(vtb + (size_t)(dt * 16) * L + st); }
    __builtin_amdgcn_sched_barrier(0);
#pragma unroll
    for (int s = 0; s < 5; ++s)
#pragma unroll
        for (int u = 0; u < 2; ++u) {
            f32x4 a = (f32x4){0.f, 0.f, 0.f, 0.f};
            a = __builtin_amdgcn_mfma_f32_16x16x32_bf16(kfr[s][u][0], qf[0], a, 0, 0, 0);
            a = __builtin_amdgcn_mfma_f32_16x16x32_bf16(kfr[s][u][1], qf[1], a, 0, 0, 0);
            acc[s][u] = a; }
    float mx = -INFINITY;
#pragma unroll
    for (int s = 0; s < 5; ++s)
#pragma unroll
        for (int u = 0; u < 2; ++u)
#pragma unroll
            for (int j = 0; j < 4; ++j) { const int k = 32 * s + 8 * quad + 4 * u + j; const bool valid = (k >= fr) && (k <= 128 + fr) && (i0 - 128 + k >= 0);
                const float v = valid ? acc[s][u][j] : -INFINITY; acc[s][u][j] = v; mx = fmaxf(mx, v); }
    mx = fmaxf(mx, __shfl_xor(mx, 16)); mx = fmaxf(mx, __shfl_xor(mx, 32));
    float sum = 0.f; bf16x8_t pb[5];
#pragma unroll
    for (int s = 0; s < 5; ++s) { float e[8];
#pragma unroll
        for (int u = 0; u < 2; ++u)
#pragma unroll
            for (int j = 0; j < 4; ++j) { const float v = acc[s][u][j]; const float ev = (v == -INFINITY) ? 0.f : __expf(v - mx); e[u * 4 + j] = ev; sum += ev; }
        u32x4 w; w.x = pk2(e[0], e[1]); w.y = pk2(e[2], e[3]); w.z = pk2(e[4], e[5]); w.w = pk2(e[6], e[7]); pb[s] = __builtin_bit_cast(bf16x8_t, w); }
    sum += __shfl_xor(sum, 16); sum += __shfl_xor(sum, 32);
    f32x4 o[4];
#pragma unroll
    for (int dt = 0; dt < 4; ++dt) o[dt] = (f32x4){0.f, 0.f, 0.f, 0.f};
#pragma unroll
    for (int s = 0; s < 5; ++s)
#pragma unroll
        for (int dt = 0; dt < 4; ++dt) o[dt] = __builtin_amdgcn_mfma_f32_16x16x32_bf16(vfr[s][dt], pb[s], o[dt], 0, 0, 0);
    const float inv = 1.0f / sum; const size_t tok = (size_t)(b * SEQ + tq);
    bf16_t* yo = (bf16_t*)(p.ws + WS_YCAT) + tok * DM + pat * 256 + h * 64 + quad * 4;
#pragma unroll
    for (int dt = 0; dt < 4; ++dt) { u32x2 w; w.x = pk2(o[dt][0] * inv, o[dt][1] * inv); w.y = pk2(o[dt][2] * inv, o[dt][3] * inv); *(u32x2*)(yo + dt * 16) = w; }
    if (quad == 0) ((float*)(p.ws + WS_LSE))[((size_t)pat * M + tok) * 4 + h] = mx + __logf(sum);
}
typedef float f32x16_t __attribute__((ext_vector_type(16)));
#define MFMA32(a, b, c) __builtin_amdgcn_mfma_f32_32x32x16_bf16((a), (b), (c), 0, 0, 0)
DI void attn_tile32(const Params& p, int b, int h, int pat, int r, int i0, int lane) {
    const int dsh = 2 * pat, L = SEQ >> dsh;
    const int q = lane & 31, hf = lane >> 5;
    const bf16_t* projb = (const bf16_t*)(p.ws + WS_PROJ) + (size_t)(b * SEQ) * PP + h * 64 + hf * 8;
    const int tq = ((i0 + q) << dsh) + r;
    bf16x8_t qf[4];
#pragma unroll
    for (int ks = 0; ks < 4; ++ks) qf[ks] = *(const bf16x8_t*)(projb + (size_t)tq * PP + AQ + ks * 16);
    const int kk = (q & 0x13) | ((q & 4) << 1) | ((q & 8) >> 1);
    bf16x8_t kfr[5][4];
#pragma unroll
    for (int g = 0; g < 5; ++g) { int kap = i0 - 128 + 32 * g + kk; kap = kap < 0 ? 0 : (kap > L - 1 ? L - 1 : kap);
        const bf16_t* kp = projb + (size_t)((kap << dsh) + r) * PP + AK;
#pragma unroll
        for (int ks = 0; ks < 4; ++ks) kfr[g][ks] = *(const bf16x8_t*)(kp + ks * 16); }
    __builtin_amdgcn_sched_barrier(0);
    f32x16_t acc[5];
#pragma unroll
    for (int g = 0; g < 5; ++g) { f32x16_t a;
#pragma unroll
        for (int i = 0; i < 16; ++i) a[i] = 0.f;
#pragma unroll
        for (int ks = 0; ks < 4; ++ks) a = MFMA32(kfr[g][ks], qf[ks], a);
        acc[g] = a; }
    const bf16_t* vtb = (const bf16_t*)(p.ws + WS_VT) + (size_t)pat * 4 * 1024 * 1024 + ((size_t)((((b * 4 + h) << dsh) + r) * 64 + q)) * L;
    bf16x8_t vfr[10][2];
#pragma unroll
    for (int s = 0; s < 10; ++s) { int st = i0 - 128 + 16 * s + 8 * hf; st = st < 0 ? 0 : (st > L - 8 ? L - 8 : st);
#pragma unroll
        for (int dt = 0; dt < 2; ++dt) vfr[s][dt] = *(const bf16x8_t*)(vtb + (size_t)(dt * 32) * L + st); }
    __builtin_amdgcn_sched_barrier(0);
    float mx = -INFINITY;
    { int qv = q - 8 * hf; asm volatile("" : "+v"(qv));
      const int lb = (q > 128 - i0 ? q : 128 - i0) - 8 * hf, ub = 128 + qv;
#pragma unroll
      for (int g = 0; g < 5; ++g) {
#pragma unroll
        for (int i = 0; i < 16; ++i) { const int kc = 32 * g + 16 * (i >> 3) + (i & 7); const int t = min(kc - lb, ub - kc);
            const float v = t >= 0 ? acc[g][i] : -INFINITY; acc[g][i] = v; mx = fmaxf(mx, v); }
        __builtin_amdgcn_sched_barrier(0); } }
    mx = fmaxf(mx, __shfl_xor(mx, 32));
    float sum = 0.f; bf16x8_t pb[10];
#pragma unroll
    for (int g = 0; g < 5; ++g)
#pragma unroll
        for (int s = 0; s < 2; ++s) { float e[8];
#pragma unroll
            for (int j = 0; j < 8; ++j) { const float v = acc[g][8 * s + j]; const float ev = (v == -INFINITY) ? 0.f : __expf(v - mx); e[j] = ev; sum += ev; }
            u32x4 w; w.x = pk2(e[0], e[1]); w.y = pk2(e[2], e[3]); w.z = pk2(e[4], e[5]); w.w = pk2(e[6], e[7]); pb[2 * g + s] = __builtin_bit_cast(bf16x8_t, w); }
    sum += __shfl_xor(sum, 32);
    f32x16_t o[2];
#pragma unroll
    for (int dt = 0; dt < 2; ++dt)
#pragma unroll
        for (int i = 0; i < 16; ++i) o[dt][i] = 0.f;
#pragma unroll
    for (int s = 0; s < 10; ++s)
#pragma unroll
        for (int dt = 0; dt < 2; ++dt) o[dt] = MFMA32(vfr[s][dt], pb[s], o[dt]);
    const float inv = 1.0f / sum; const size_t tok = (size_t)(b * SEQ + tq);
    bf16_t* yo = (bf16_t*)(p.ws + WS_YCAT) + tok * DM + pat * 256 + h * 64 + 4 * hf;
#pragma unroll
    for (int dt = 0; dt < 2; ++dt)
#pragma unroll
        for (int i4 = 0; i4 < 4; ++i4) { u32x2 w; w.x = pk2(o[dt][4 * i4] * inv, o[dt][4 * i4 + 1] * inv); w.y = pk2(o[dt][4 * i4 + 2] * inv, o[dt][4 * i4 + 3] * inv); *(u32x2*)(yo + dt * 32 + 8 * i4) = w; }
    if (hf == 0) ((float*)(p.ws + WS_LSE))[((size_t)pat * M + tok) * 4 + h] = mx + __logf(sum);
}
DI void attn_combine(const Params& p, int gt, int NT) {
    bf16_t* yc = (bf16_t*)(p.ws + WS_YCAT); const float* lse = (const float*)(p.ws + WS_LSE);
    for (int i = gt; i < M * 32; i += NT) { const int tok = i >> 5, c8 = (i & 31) * 8, h = c8 >> 6;
        const float l0 = lse[((size_t)0 * M + tok) * 4 + h], l1 = lse[((size_t)1 * M + tok) * 4 + h], l2 = lse[((size_t)2 * M + tok) * 4 + h];
        const float mm = fmaxf(l0, fmaxf(l1, l2)); float w0 = __expf(l0 - mm), w1 = __expf(l1 - mm), w2 = __expf(l2 - mm); const float iz = 1.0f / (w0 + w1 + w2); w0 *= iz; w1 *= iz; w2 *= iz;
        bf16_t* pp = yc + (size_t)tok * DM + c8; float a[8], bq[8], c[8];
        unpack8(*(const u32x4*)pp, a); unpack8(*(const u32x4*)(pp + 256), bq); unpack8(*(const u32x4*)(pp + 512), c);
        u32x4 w; w.x = pk2(w0 * a[0] + w1 * bq[0] + w2 * c[0], w0 * a[1] + w1 * bq[1] + w2 * c[1]); w.y = pk2(w0 * a[2] + w1 * bq[2] + w2 * c[2], w0 * a[3] + w1 * bq[3] + w2 * c[3]);
        w.z = pk2(w0 * a[4] + w1 * bq[4] + w2 * c[4], w0 * a[5] + w1 * bq[5] + w2 * c[5]); w.w = pk2(w0 * a[6] + w1 * bq[6] + w2 * c[6], w0 * a[7] + w1 * bq[7] + w2 * c[7]);
        *(u32x4*)pp = w; }
}

template <int NC, int K> DI void nt_acc(float (&acc)[NC], const LAS bf16_t* Ap, const LAS bf16_t* Bp, int ldb) {
    for (int k = 0; k < K; k += 8) {
        float a[8]; unpack8(*(const LAS u32x4*)(Ap + k), a);
#pragma unroll
        for (int c = 0; c < NC; ++c) { float b[8]; unpack8(*(const LAS u32x4*)(Bp + c * ldb + k), b);
            acc[c] += (a[0] * b[0] + a[1] * b[1]) + (a[2] * b[2] + a[3] * b[3]) + (a[4] * b[4] + a[5] * b[5]) + (a[6] * b[6] + a[7] * b[7]); }
    }
}
template <int NC> DI void axpy_row(float (&acc)[NC], float coef, const LAS bf16_t* Bp) {
#pragma unroll
    for (int c8 = 0; c8 < NC; c8 += 8) { float b[8]; unpack8(*(const LAS u32x4*)(Bp + c8), b);
#pragma unroll
        for (int e = 0; e < 8; ++e) acc[c8 + e] += coef * b[e]; }
}

DI void ssd_dt_acum(const Params& p, int l, int tok0, int g, LAS float* dts, LAS float* acs, int wave, int lane) {
    if (wave < 2) {
        const int h = 2 * g + wave; const bf16_t* proj = (const bf16_t*)(p.ws + WS_PROJ);
        const float bias = p.in[8][l * 4 + h], a = -__expf(p.in[9][l * 4 + h]);
        float d[2];
#pragma unroll
        for (int e = 0; e < 2; ++e) { const float raw = bf2f(proj[(size_t)(tok0 + 2 * lane + e) * PP + BDT + h]) + bias; d[e] = raw > 20.f ? raw : log1pf(__expf(raw)); }
        const float v0 = d[0] * a, v1 = d[1] * a; float s = v0 + v1;
#pragma unroll
        for (int off = 1; off < 64; off <<= 1) { const float t = __shfl_up(s, off); if (lane >= off) s += t; }
        dts[wave * 128 + 2 * lane] = d[0]; dts[wave * 128 + 2 * lane + 1] = d[1];
        acs[wave * 128 + 2 * lane] = s - v1; acs[wave * 128 + 2 * lane + 1] = s;
    }
}
DI void stage_conv(const Params& p, int l, LAS bf16_t* dst, int ld, int tok0, int seqpos0, int choff, int tid) {
    const bf16_t* src = (const bf16_t*)(p.ws + WS_PROJ) + (size_t)tok0 * PP + BX + choff;
    const float* cw = p.in[6] + (size_t)l * 4 * 768 + choff; const float* cb = p.in[7] + l * 768 + choff;
    for (int e = tid; e < 128 * 128; e += NTHR) { const int j = e >> 7, ch = e & 127;
        float v = cb[ch];
#pragma unroll
        for (int k = 0; k < 4; ++k) { const int s = j - 3 + k; if (seqpos0 + s >= 0) v += cw[k * 768 + ch] * bf2f(src[(long)s * PP + ch]); }
        dst[j * ld + ch] = (bf16_t)f2bf(silu_f(v)); }
}


DI void stage_conv_t(const Params& p, int l, LAS bf16_t* dst, int ld, int tok0, int seqpos0, int choff, const LAS float* wsc, int tid) {
    const bf16_t* src = (const bf16_t*)(p.ws + WS_PROJ) + (size_t)tok0 * PP + BX + choff;
    const float* cw = p.in[6] + (size_t)l * 4 * 768 + choff; const float* cb = p.in[7] + l * 768 + choff;
    for (int e = tid; e < 128 * 128; e += NTHR) { const int j = e >> 7, ch = e & 127;
        float v = cb[ch];
#pragma unroll
        for (int k = 0; k < 4; ++k) { const int s = j - 3 + k; if (seqpos0 + s >= 0) v += cw[k * 768 + ch] * bf2f(src[(long)s * PP + ch]); }
        v = silu_f(v); if (wsc) v *= wsc[(ch >> 6) * 128 + j];
        dst[ch * ld + j] = (bf16_t)f2bf(v); }
}
template <bool TR> DI void stage_conv_v(const Params& p, int l, LAS bf16_t* dst, int ld, int tok0, int seqpos0, int choff, const LAS float* wsc, int tid) {
    const int cc = tid & 15, j0 = (tid >> 4) * 4;
    const bf16_t* src = (const bf16_t*)(p.ws + WS_PROJ) + (size_t)tok0 * PP + BX + choff + cc * 8;
    const float* cw = p.in[6] + (size_t)l * 4 * 768 + choff + cc * 8; const float* cb = p.in[7] + l * 768 + choff + cc * 8;
    float w[4][8], bias[8];
#pragma unroll
    for (int k = 0; k < 4; ++k) { const f32x4 a = *(const f32x4*)(cw + k * 768), b2 = *(const f32x4*)(cw + k * 768 + 4);
        w[k][0] = a[0]; w[k][1] = a[1]; w[k][2] = a[2]; w[k][3] = a[3]; w[k][4] = b2[0]; w[k][5] = b2[1]; w[k][6] = b2[2]; w[k][7] = b2[3]; }
    { const f32x4 a = *(const f32x4*)cb, b2 = *(const f32x4*)(cb + 4); bias[0] = a[0]; bias[1] = a[1]; bias[2] = a[2]; bias[3] = a[3]; bias[4] = b2[0]; bias[5] = b2[1]; bias[6] = b2[2]; bias[7] = b2[3]; }
    float x[7][8];
#pragma unroll
    for (int rr = 0; rr < 7; ++rr) { const int s = j0 - 3 + rr; u32x4 v = (u32x4){0u, 0u, 0u, 0u}; if (seqpos0 + s >= 0) v = *(const u32x4*)(src + (long)s * PP); unpack8(v, x[rr]); }
    float o[4][8];
#pragma unroll
    for (int r = 0; r < 4; ++r)
#pragma unroll
        for (int e = 0; e < 8; ++e) { float v = bias[e];
#pragma unroll
            for (int k = 0; k < 4; ++k) v += w[k][e] * x[r + k][e];
            v = silu_f(v); if (TR && wsc) v *= wsc[(((choff + cc * 8 + e) & 64) ? 128 : 0) + j0 + r]; o[r][e] = v; }
    if (!TR) {
#pragma unroll
        for (int r = 0; r < 4; ++r) { u32x4 wv; wv.x = pk2(o[r][0], o[r][1]); wv.y = pk2(o[r][2], o[r][3]); wv.z = pk2(o[r][4], o[r][5]); wv.w = pk2(o[r][6], o[r][7]); *(LAS u32x4*)(dst + (j0 + r) * ld + cc * 8) = wv; }
    } else {
#pragma unroll
        for (int e = 0; e < 8; ++e) { u32x2 wv; wv.x = pk2(o[0][e], o[1][e]); wv.y = pk2(o[2][e], o[3][e]); *(LAS u32x2*)(dst + (cc * 8 + e) * ld + j0) = wv; }
    }
}
typedef short bf16x8_t __attribute__((ext_vector_type(8)));
#define MFMA16(a, b, c) __builtin_amdgcn_mfma_f32_16x16x32_bf16((a), (b), (c), 0, 0, 0)
DI void ssd_states_mfma(const Params& p, int l, int b, int c, int g, LAS unsigned char* lds, int tid, int wave, int lane) {
    LAS bf16_t* XT = (LAS bf16_t*)lds; LAS bf16_t* BT = XT + 128 * 136;
    LAS float* dts = (LAS float*)(BT + 128 * 136); LAS float* acs = dts + 256; LAS float* wsc = acs + 256;
    const int tok0 = b * SEQ + c * 128;
    ssd_dt_acum(p, l, tok0, g, dts, acs, wave, lane);
    __syncthreads();
    if (tid < 256) { const int hh = tid >> 7, j = tid & 127; wsc[tid] = __expf(acs[hh * 128 + 127] - acs[hh * 128 + j]) * dts[hh * 128 + j]; }
    if (tid < 2) ((float*)(p.ws + WS_CDEC))[(b * 32 + c) * 4 + 2 * g + tid] = __expf(acs[tid * 128 + 127]);
    __syncthreads();
    stage_conv_v<true>(p, l, XT, 136, tok0, c * 128, g * 128, wsc, tid);
    stage_conv_v<true>(p, l, BT, 136, tok0, c * 128, 256 + g * 128, nullptr, tid);
    __syncthreads();
    const int fr = lane & 15, quad = lane >> 4, hh = wave >> 2, pt = wave & 3;
    bf16x8_t af[4];
#pragma unroll
    for (int ks = 0; ks < 4; ++ks) af[ks] = *(const LAS bf16x8_t*)(XT + (hh * 64 + pt * 16 + fr) * 136 + ks * 32 + quad * 8);
    float* dst = (float*)(p.ws + WS_SST) + ((size_t)((b * 32 + c) * 4 + 2 * g + hh)) * 8192 + (pt * 16 + quad * 4) * 128 + fr;
#pragma unroll
    for (int nt = 0; nt < 8; ++nt) { f32x4 acc = (f32x4){0.f, 0.f, 0.f, 0.f};
#pragma unroll
        for (int ks = 0; ks < 4; ++ks) { const bf16x8_t bfv = *(const LAS bf16x8_t*)(BT + (nt * 16 + fr) * 136 + ks * 32 + quad * 8); acc = MFMA16(af[ks], bfv, acc); }
#pragma unroll
        for (int jj = 0; jj < 4; ++jj) dst[jj * 128 + nt * 16] = acc[jj]; }
    __syncthreads();
}
DI void ssd_y_mfma(const Params& p, int l, int b, int c, int g, LAS unsigned char* lds, int tid, int wave, int lane) {
    LAS bf16_t* Cs = (LAS bf16_t*)lds; LAS bf16_t* Bs = Cs + 128 * 136; LAS bf16_t* XT = Bs + 128 * 136; LAS bf16_t* Pv = XT + 128 * 136;
    LAS float* dts = (LAS float*)(Pv + 128 * 136); LAS float* acs = dts + 256;
    const int tok0 = b * SEQ + c * 128; const bf16_t* proj = (const bf16_t*)(p.ws + WS_PROJ);
    ssd_dt_acum(p, l, tok0, g, dts, acs, wave, lane);
    stage_conv_v<false>(p, l, Cs, 136, tok0, c * 128, 512 + g * 128, nullptr, tid);
    stage_conv_v<false>(p, l, Bs, 136, tok0, c * 128, 256 + g * 128, nullptr, tid);
    stage_conv_v<true>(p, l, XT, 136, tok0, c * 128, g * 128, nullptr, tid);
    { const float* prev = (const float*)(p.ws + WS_SST) + ((size_t)((b * 32 + c) * 4 + 2 * g)) * 8192;
      for (int e = tid; e < 128 * 32; e += NTHR) { const int r = e >> 5, n4 = (e & 31) * 4; const f32x4 v = *(const f32x4*)(prev + r * 128 + n4);
          u32x2 w; w.x = pk2(v[0], v[1]); w.y = pk2(v[2], v[3]); *(LAS u32x2*)(Pv + r * 136 + n4) = w; } }
    __syncthreads();
    const int fr = lane & 15, quad = lane >> 4, i = wave * 16 + fr, smax = (wave * 16 + 15) >> 5;
    const int dq = 8 * quad - fr; const LAS float* acq = acs + 8 * quad; const LAS float* dtq = dts + 8 * quad;
    bf16x8_t cf[4];
#pragma unroll
    for (int ks = 0; ks < 4; ++ks) cf[ks] = *(const LAS bf16x8_t*)(Cs + i * 136 + ks * 32 + quad * 8);
    f32x4 cbt[4][2];
#pragma unroll
    for (int s = 0; s < 4; ++s)
#pragma unroll
        for (int u = 0; u < 2; ++u) { f32x4 a = (f32x4){0.f, 0.f, 0.f, 0.f};
            if (s <= smax) { const int j = 32 * s + 8 * (fr >> 2) + 4 * u + (fr & 3);
#pragma unroll
                for (int ks = 0; ks < 4; ++ks) { const bf16x8_t bfv = *(const LAS bf16x8_t*)(Bs + j * 136 + ks * 32 + quad * 8); a = MFMA16(bfv, cf[ks], a); } }
#pragma unroll
            for (int jj = 0; jj < 4; ++jj) a[jj] = (dq <= 16 * wave - 32 * s - 4 * u - jj) ? a[jj] : 0.f;
            cbt[s][u] = a; asm volatile("" ::: "memory"); }
    float y[2][4][4];
#pragma unroll
    for (int hh = 0; hh < 2; ++hh) {
        const float ai = acs[hh * 128 + i];
        f32x4 o[4], o2[4];
#pragma unroll
        for (int pt = 0; pt < 4; ++pt) { o[pt] = (f32x4){0.f, 0.f, 0.f, 0.f}; o2[pt] = (f32x4){0.f, 0.f, 0.f, 0.f}; }
#pragma unroll
        for (int s = 0; s < 4; ++s) if (s <= smax) { float e[8];
#pragma unroll
            for (int u = 0; u < 2; ++u)
#pragma unroll
                for (int jj = 0; jj < 4; ++jj) { const int jo = hh * 128 + 32 * s + 4 * u + jj;
                    e[u * 4 + jj] = cbt[s][u][jj] * __expf(fminf(ai - acq[jo], 0.f)) * dtq[jo]; }
            u32x4 w; w.x = pk2(e[0], e[1]); w.y = pk2(e[2], e[3]); w.z = pk2(e[4], e[5]); w.w = pk2(e[6], e[7]); const bf16x8_t pb = __builtin_bit_cast(bf16x8_t, w);
#pragma unroll
            for (int pt = 0; pt < 4; ++pt) { const bf16x8_t xf = *(const LAS bf16x8_t*)(XT + (hh * 64 + pt * 16 + fr) * 136 + 32 * s + 8 * quad); o[pt] = MFMA16(xf, pb, o[pt]); } asm volatile("" ::: "memory"); }
#pragma unroll
        for (int ks = 0; ks < 4; ++ks) {
#pragma unroll
            for (int pt = 0; pt < 4; ++pt) { const bf16x8_t pf = *(const LAS bf16x8_t*)(Pv + (hh * 64 + pt * 16 + fr) * 136 + ks * 32 + quad * 8); o2[pt] = MFMA16(pf, cf[ks], o2[pt]); }
            asm volatile("" ::: "memory"); }
        const float ea = __expf(ai);
#pragma unroll
        for (int pt = 0; pt < 4; ++pt)
#pragma unroll
            for (int jj = 0; jj < 4; ++jj) y[hh][pt][jj] = o[pt][jj] + ea * o2[pt][jj];
    }
    float s2 = 0.f;
#pragma unroll
    for (int hh = 0; hh < 2; ++hh) { const float dsk = p.in[10][l * 4 + 2 * g + hh];
#pragma unroll
        for (int pt = 0; pt < 4; ++pt) { const int ch = hh * 64 + pt * 16 + quad * 4;
            const u32x2 zw = *(const u32x2*)(proj + (size_t)(tok0 + i) * PP + BZ + g * 128 + ch);
            const float z4[4] = {lo16(zw.x), hi16(zw.x), lo16(zw.y), hi16(zw.y)};
#pragma unroll
            for (int jj = 0; jj < 4; ++jj) { const float xv = bf2f(XT[(ch + jj) * 136 + i]); const float v = (y[hh][pt][jj] + dsk * xv) * silu_f(z4[jj]); y[hh][pt][jj] = v; s2 += v * v; } } }
    s2 += __shfl_xor(s2, 16); s2 += __shfl_xor(s2, 32);
    const float rs = rsqrtf(s2 * (1.0f / 128.0f) + EPS);
    bf16_t* yo = (bf16_t*)(p.ws + WS_YCAT) + (size_t)(tok0 + i) * DM + 256 + g * 128;
#pragma unroll
    for (int hh = 0; hh < 2; ++hh)
#pragma unroll
        for (int pt = 0; pt < 4; ++pt) { const int ch = hh * 64 + pt * 16 + quad * 4; const f32x4 ng = *(const f32x4*)(p.in[11] + l * 256 + g * 128 + ch);
            u32x2 w; w.x = pk2(y[hh][pt][0] * rs * ng[0], y[hh][pt][1] * rs * ng[1]); w.y = pk2(y[hh][pt][2] * rs * ng[2], y[hh][pt][3] * rs * ng[3]); *(u32x2*)(yo + ch) = w; }
    __syncthreads();
}

DI void ssd_states_unit(const Params& p, int l, int b, int c, int g, LAS unsigned char* lds, int tid, int wave, int lane) {
    LAS bf16_t* Xs = (LAS bf16_t*)lds; LAS bf16_t* Bs = Xs + 128 * 136;
    LAS float* dts = (LAS float*)(Bs + 128 * 136); LAS float* acs = dts + 256; LAS float* wsc = acs + 256;
    const int tok0 = b * SEQ + c * 128;
    ssd_dt_acum(p, l, tok0, g, dts, acs, wave, lane);
    stage_conv(p, l, Xs, 136, tok0, c * 128, g * 128, tid);
    stage_conv(p, l, Bs, 136, tok0, c * 128, 256 + g * 128, tid);
    __syncthreads();
    if (tid < 256) { const int hh = tid >> 7, j = tid & 127; wsc[tid] = __expf(acs[hh * 128 + 127] - acs[hh * 128 + j]) * dts[hh * 128 + j]; }
    if (tid < 2) ((float*)(p.ws + WS_CDEC))[(b * 32 + c) * 4 + 2 * g + tid] = __expf(acs[tid * 128 + 127]);
    __syncthreads();
    const int r = tid >> 2, q = tid & 3, hh = r >> 6;
    float acc[32];
#pragma unroll
    for (int i = 0; i < 32; ++i) acc[i] = 0.f;
    for (int j = 0; j < 128; ++j) { const float coef = bf2f(Xs[j * 136 + r]) * wsc[hh * 128 + j]; axpy_row<32>(acc, coef, Bs + j * 136 + q * 32); }
    float* dst = (float*)(p.ws + WS_SST) + ((size_t)((b * 32 + c) * 4 + 2 * g + hh)) * 8192 + (r & 63) * 128 + q * 32;
#pragma unroll
    for (int i = 0; i < 32; i += 4) *(f32x4*)(dst + i) = (f32x4){acc[i], acc[i + 1], acc[i + 2], acc[i + 3]};
    __syncthreads();
}

DI void ret_states_unit(const Params& p, int b, int c, LAS unsigned char* lds, int tid) {
    LAS bf16_t* Ks = (LAS bf16_t*)lds; LAS bf16_t* Vs = Ks + 128 * 264;
    const int tok0 = b * SEQ + c * 128; const bf16_t* proj = (const bf16_t*)(p.ws + WS_PROJ);
    for (int e = tid; e < 128 * 32; e += NTHR) { const int j = e >> 5, c8 = (e & 31) * 8;
        *(LAS u32x4*)(Ks + j * 264 + c8) = *(const u32x4*)(proj + (size_t)(tok0 + j) * PP + CK + c8);
        *(LAS u32x4*)(Vs + j * 264 + c8) = *(const u32x4*)(proj + (size_t)(tok0 + j) * PP + CV + c8); }
    __syncthreads();
    const int h = tid >> 7, d = (tid >> 1) & 63, eh = tid & 1;
    const float lg = log2f(1.0f - exp2f(-5.0f - (float)h));
    float acc[32];
#pragma unroll
    for (int i = 0; i < 32; ++i) acc[i] = 0.f;
    for (int j = 0; j < 128; ++j) { const float coef = bf2f(Ks[j * 264 + h * 64 + d]) * exp2f((float)(127 - j) * lg); axpy_row<32>(acc, coef, Vs + j * 264 + h * 64 + eh * 32); }
    float* dst = (float*)(p.ws + WS_RST) + ((size_t)((b * 32 + c) * 4 + h)) * 4096 + d * 64 + eh * 32;
#pragma unroll
    for (int i = 0; i < 32; i += 4) *(f32x4*)(dst + i) = (f32x4){acc[i], acc[i + 1], acc[i + 2], acc[i + 3]};
    __syncthreads();
}

DI void conv_unit(const Params& p, int l, int b, int s0, LAS unsigned char* lds, int tid, int wave, int lane) {
    LAS bf16_t* Hs = (LAS bf16_t*)lds;
    LAS float* Os = (LAS float*)(lds + 94 * 256 * 2);
    const bf16_t* proj = (const bf16_t*)(p.ws + WS_PROJ);
    for (int e = tid; e < 94 * 32; e += NTHR) { const int r = e >> 5, c8 = (e & 31) * 8; const int s = s0 - 30 + r;
        u32x4 v = (u32x4){0u, 0u, 0u, 0u};
        if (s >= 0) v = *(const u32x4*)(proj + (size_t)(b * SEQ + s) * PP + DV + c8);
        *(LAS u32x4*)(Hs + r * 256 + c8) = v; }
    __syncthreads();
    { const int ch = tid & 255, half = tid >> 8;
      const float* w = p.in[12] + (size_t)l * 31 * 256 + ch; const float bias = p.in[13][l * 256 + ch];
      float wr[31];
#pragma unroll
      for (int k = 0; k < 31; ++k) wr[k] = w[k * 256];
      for (int tt = 0; tt < 32; ++tt) { const int t = half * 32 + tt; float a = bias;
#pragma unroll
          for (int k = 0; k < 31; ++k) a += wr[k] * bf2f(Hs[(t + k) * 256 + ch]);
          Os[t * 256 + ch] = a; } }
    __syncthreads();
    const f32x4 lg = *(const f32x4*)(p.in[14] + l * 256 + lane * 4), lb = *(const f32x4*)(p.in[15] + l * 256 + lane * 4);
    bf16_t* ycat = (bf16_t*)(p.ws + WS_YCAT);
    for (int tt = 0; tt < 8; ++tt) { const int t = wave * 8 + tt; const f32x4 v = *(const LAS f32x4*)(Os + t * 256 + lane * 4);
        const float mean = wave_sum((v[0] + v[1]) + (v[2] + v[3])) * (1.0f / 256.0f);
        const f32x4 d = v - mean; const float var = wave_sum((d[0] * d[0] + d[1] * d[1]) + (d[2] * d[2] + d[3] * d[3])) * (1.0f / 256.0f);
        const float rs = rsqrtf(var + EPS); f32x4 o = d * rs * lg + lb;
        u32x2 w; w.x = pk2(silu_f(o[0]), silu_f(o[1])); w.y = pk2(silu_f(o[2]), silu_f(o[3]));
        *(u32x2*)(ycat + (size_t)(b * SEQ + s0 + t) * DM + 768 + lane * 4) = w; }
    __syncthreads();
}

DI void attn_task(const Params& p, int tok, int hd, int lane, LAS float* qs) {
    const bf16_t* proj = (const bf16_t*)(p.ws + WS_PROJ);
    const int pos = tok & (SEQ - 1); const size_t rowbase = (size_t)(tok - pos);
    qs[lane] = bf2f(proj[(size_t)tok * PP + AQ + hd * 64 + lane]);
    float sc[7];
#pragma unroll
    for (int ps = 0; ps < 7; ++ps) { const int e = ps * 64 + lane; const int pat = e / 129, j = e - pat * 129; const int kp = pos - (j << (2 * pat));
        const bool valid = (e < 387) && (kp >= 0); float s = 0.f;
        if (valid) { const u32x4* kr = (const u32x4*)(proj + (rowbase + kp) * PP + AK + hd * 64);
#pragma unroll
            for (int c = 0; c < 8; ++c) { float kf[8]; unpack8(kr[c], kf); const f32x4 q0 = *(const LAS f32x4*)(qs + c * 8), q1 = *(const LAS f32x4*)(qs + c * 8 + 4);
                s += (q0[0] * kf[0] + q0[1] * kf[1]) + (q0[2] * kf[2] + q0[3] * kf[3]) + (q1[0] * kf[4] + q1[1] * kf[5]) + (q1[2] * kf[6] + q1[3] * kf[7]); } }
        sc[ps] = valid ? s : -INFINITY; }
    float mx = sc[0];
#pragma unroll
    for (int ps = 1; ps < 7; ++ps) mx = fmaxf(mx, sc[ps]);
    mx = wave_max(mx);
    float z = 0.f; int pr[7];
#pragma unroll
    for (int ps = 0; ps < 7; ++ps) { const float e = (sc[ps] == -INFINITY) ? 0.f : __expf(sc[ps] - mx); z += e; pr[ps] = __float_as_int(e); }
    z = wave_sum(z);
    float o = 0.f;
    const bf16_t* vb = proj + rowbase * PP + AV + hd * 64 + lane;
#pragma unroll
    for (int ps = 0; ps < 7; ++ps) {
        const int nl = ps == 6 ? 3 : 64;
#pragma unroll 8
        for (int ln = 0; ln < nl; ++ln) { const int e = ps * 64 + ln; const int pat = e / 129, j = e - pat * 129; int kp = pos - (j << (2 * pat));
            const bool ok = kp >= 0; kp = ok ? kp : pos;
            const float pe = ok ? __int_as_float(__builtin_amdgcn_readlane(pr[ps], ln)) : 0.f;
            o += pe * bf2f(vb[(size_t)kp * PP]); } }
    ((bf16_t*)(p.ws + WS_YCAT))[(size_t)tok * DM + hd * 64 + lane] = (bf16_t)f2bf(o / z);
}

DI void ret_states_mfma(const Params& p, int b, int c, int h, LAS unsigned char* lds, int tid, int wave, int lane) {
    LAS bf16_t* KT = (LAS bf16_t*)lds;
    const int tok0 = b * SEQ + c * 128; const bf16_t* proj = (const bf16_t*)(p.ws + WS_PROJ);
    const float lg = log2f(1.0f - exp2f(-5.0f - (float)h));
    { const int cc = tid & 7, j0 = (tid >> 3) * 2; float k0[8], k1[8];
      unpack8(*(const u32x4*)(proj + (size_t)(tok0 + j0) * PP + CK + h * 64 + cc * 8), k0); unpack8(*(const u32x4*)(proj + (size_t)(tok0 + j0 + 1) * PP + CK + h * 64 + cc * 8), k1);
      const float z0 = exp2f((float)(127 - j0) * lg), z1 = exp2f((float)(126 - j0) * lg);
#pragma unroll
      for (int e = 0; e < 8; ++e) *(LAS unsigned*)(KT + (cc * 8 + e) * 136 + j0) = pk2(k0[e] * z0, k1[e] * z1); }
    __syncthreads();
    const int fr = lane & 15, quad = lane >> 4, et = wave >> 1;
    const bf16_t* vtr = (const bf16_t*)(p.ws + WS_VT) + (size_t)12 * 1024 * 1024 + ((size_t)((b * 4 + h) * 64 + et * 16 + fr)) * SEQ + c * 128 + quad * 8;
    bf16x8_t vf[4];
#pragma unroll
    for (int ks = 0; ks < 4; ++ks) vf[ks] = *(const bf16x8_t*)(vtr + ks * 32);
    float* dst = (float*)(p.ws + WS_RST) + ((size_t)((b * 32 + c) * 4 + h)) * 4096 + (et * 16 + quad * 4) * 64 + fr;
#pragma unroll
    for (int d2 = 0; d2 < 2; ++d2) { const int dt = (wave & 1) * 2 + d2; f32x4 acc = (f32x4){0.f, 0.f, 0.f, 0.f};
#pragma unroll
        for (int ks = 0; ks < 4; ++ks) { const bf16x8_t kf = *(const LAS bf16x8_t*)(KT + (dt * 16 + fr) * 136 + ks * 32 + quad * 8); acc = MFMA16(vf[ks], kf, acc); }
#pragma unroll
        for (int jj = 0; jj < 4; ++jj) dst[jj * 64 + dt * 16] = acc[jj]; }
    __syncthreads();
}
DI void ret_y_tile(const Params& p, int b, int c, int h, int I, int lane) {
    const int fr = lane & 15, quad = lane >> 4, smax = (I * 16 + 15) >> 5, i = I * 16 + fr;
    const int tok0 = b * SEQ + c * 128;
    const bf16_t* projb = (const bf16_t*)(p.ws + WS_PROJ) + (size_t)tok0 * PP + h * 64 + quad * 8;
    const float lg = log2f(1.0f - exp2f(-5.0f - (float)h));
    bf16x8_t qf[2];
    qf[0] = *(const bf16x8_t*)(projb + (size_t)i * PP + CQ); qf[1] = *(const bf16x8_t*)(projb + (size_t)i * PP + CQ + 32);
    const int dq = 8 * quad - fr;
    bf16x8_t kfr[4][2][2];
#pragma unroll
    for (int s = 0; s < 4; ++s)
#pragma unroll
        for (int u = 0; u < 2; ++u) if (s <= smax) { const int j = 32 * s + 8 * (fr >> 2) + 4 * u + (fr & 3); const bf16_t* kp = projb + (size_t)j * PP + CK;
            kfr[s][u][0] = *(const bf16x8_t*)kp; kfr[s][u][1] = *(const bf16x8_t*)(kp + 32); }
    const float* prevT = (const float*)(p.ws + WS_RST) + ((size_t)((b * 32 + c) * 4 + h)) * 4096 + fr * 64 + quad * 8;
    f32x4 pa[2][4], pb2[2][4];
#pragma unroll
    for (int ks = 0; ks < 2; ++ks)
#pragma unroll
        for (int et = 0; et < 4; ++et) { const float* pp = prevT + (et * 16) * 64 + ks * 32; pa[ks][et] = *(const f32x4*)pp; pb2[ks][et] = *(const f32x4*)(pp + 4); }
    __builtin_amdgcn_sched_barrier(0);
    f32x4 sacc[4][2];
#pragma unroll
    for (int s = 0; s < 4; ++s)
#pragma unroll
        for (int u = 0; u < 2; ++u) { f32x4 a = (f32x4){0.f, 0.f, 0.f, 0.f};
            if (s <= smax) { a = MFMA16(kfr[s][u][0], qf[0], a); a = MFMA16(kfr[s][u][1], qf[1], a); }
            sacc[s][u] = a; }
    const bf16_t* vtr = (const bf16_t*)(p.ws + WS_VT) + (size_t)12 * 1024 * 1024 + ((size_t)((b * 4 + h) * 64 + fr)) * SEQ + c * 128 + quad * 8;
    bf16x8_t vfr[4][4];
#pragma unroll
    for (int s = 0; s < 4; ++s) if (s <= smax) {
#pragma unroll
        for (int et = 0; et < 4; ++et) vfr[s][et] = *(const bf16x8_t*)(vtr + (size_t)(et * 16) * SEQ + s * 32); }
    __builtin_amdgcn_sched_barrier(0);
    f32x4 o[4], o2[4];
#pragma unroll
    for (int et = 0; et < 4; ++et) { o[et] = (f32x4){0.f, 0.f, 0.f, 0.f}; o2[et] = (f32x4){0.f, 0.f, 0.f, 0.f}; }
#pragma unroll
    for (int ks = 0; ks < 2; ++ks)
#pragma unroll
        for (int et = 0; et < 4; ++et) { const f32x4 a = pa[ks][et], b2 = pb2[ks][et];
            u32x4 w; w.x = pk2(a[0], a[1]); w.y = pk2(a[2], a[3]); w.z = pk2(b2[0], b2[1]); w.w = pk2(b2[2], b2[3]);
            o2[et] = MFMA16(__builtin_bit_cast(bf16x8_t, w), qf[ks], o2[et]); }
    bf16x8_t pb[4];
#pragma unroll
    for (int s = 0; s < 4; ++s) { float e[8];
#pragma unroll
        for (int u = 0; u < 2; ++u) { const f32x4 a = sacc[s][u];
#pragma unroll
            for (int jj = 0; jj < 4; ++jj) { const int cst = 16 * I - 32 * s - 4 * u - jj;
                e[u * 4 + jj] = (dq <= cst) ? a[jj] * exp2f((float)(cst - dq) * lg) : 0.f; } }
        u32x4 w; w.x = pk2(e[0], e[1]); w.y = pk2(e[2], e[3]); w.z = pk2(e[4], e[5]); w.w = pk2(e[6], e[7]); pb[s] = __builtin_bit_cast(bf16x8_t, w); }
#pragma unroll
    for (int s = 0; s < 4; ++s) if (s <= smax) {
#pragma unroll
        for (int et = 0; et < 4; ++et) o[et] = MFMA16(vfr[s][et], pb[s], o[et]); }
    const float xi = exp2f((float)(i + 1) * lg);
    float s2 = 0.f;
#pragma unroll
    for (int et = 0; et < 4; ++et)
#pragma unroll
        for (int jj = 0; jj < 4; ++jj) { const float v = o[et][jj] + xi * o2[et][jj]; o[et][jj] = v; s2 += v * v; }
    s2 += __shfl_xor(s2, 16); s2 += __shfl_xor(s2, 32);
    const float rs = rsqrtf(s2 * (1.0f / 64.0f) + EPS);
    const bf16_t* gp = (const bf16_t*)(p.ws + WS_PROJ) + (size_t)(tok0 + i) * PP + CG + h * 64 + quad * 4;
    bf16_t* yo = (bf16_t*)(p.ws + WS_YCAT) + (size_t)(tok0 + i) * DM + 512 + h * 64 + quad * 4;
#pragma unroll
    for (int et = 0; et < 4; ++et) { const u32x2 gw2 = *(const u32x2*)(gp + et * 16);
        u32x2 w; w.x = pk2(o[et][0] * rs * silu_f(lo16(gw2.x)), o[et][1] * rs * silu_f(hi16(gw2.x))); w.y = pk2(o[et][2] * rs * silu_f(lo16(gw2.y)), o[et][3] * rs * silu_f(hi16(gw2.y)));
        *(u32x2*)(yo + et * 16) = w; }
}

DI void ret_y_tile32(const Params& p, int b, int c, int h, int I, int lane) {
    const int q = lane & 31, hf = lane >> 5, i = I * 32 + q;
    const int tok0 = b * SEQ + c * 128;
    const bf16_t* projb = (const bf16_t*)(p.ws + WS_PROJ) + (size_t)tok0 * PP + h * 64 + hf * 8;
    const float lg = log2f(1.0f - exp2f(-5.0f - (float)h));
    bf16x8_t qf[4];
#pragma unroll
    for (int ks = 0; ks < 4; ++ks) qf[ks] = *(const bf16x8_t*)(projb + (size_t)i * PP + CQ + ks * 16);
    const int kk = (q & 0x13) | ((q & 4) << 1) | ((q & 8) >> 1);
    bf16x8_t kfr[4][4];
#pragma unroll
    for (int g = 0; g < 4; ++g) if (g <= I) { const bf16_t* kp = projb + (size_t)(32 * g + kk) * PP + CK;
#pragma unroll
        for (int ks = 0; ks < 4; ++ks) kfr[g][ks] = *(const bf16x8_t*)(kp + ks * 16); }
    const float* prevT = (const float*)(p.ws + WS_RST) + ((size_t)((b * 32 + c) * 4 + h)) * 4096 + q * 64 + hf * 8;
    f32x4 pa[2][4], pc[2][4];
#pragma unroll
    for (int dt = 0; dt < 2; ++dt)
#pragma unroll
        for (int ks = 0; ks < 4; ++ks) { const float* pp = prevT + (dt * 32) * 64 + ks * 16; pa[dt][ks] = *(const f32x4*)pp; pc[dt][ks] = *(const f32x4*)(pp + 4); }
    __builtin_amdgcn_sched_barrier(0);
    f32x16_t acc[4];
#pragma unroll
    for (int g = 0; g < 4; ++g) { f32x16_t a;
#pragma unroll
        for (int x = 0; x < 16; ++x) a[x] = 0.f;
        if (g <= I) {
#pragma unroll
            for (int ks = 0; ks < 4; ++ks) a = MFMA32(kfr[g][ks], qf[ks], a); }
        acc[g] = a; }
    const bf16_t* vtr = (const bf16_t*)(p.ws + WS_VT) + (size_t)12 * 1024 * 1024 + ((size_t)((b * 4 + h) * 64 + q)) * SEQ + c * 128 + hf * 8;
    bf16x8_t vfr[8][2];
#pragma unroll
    for (int s = 0; s < 8; ++s) if ((s >> 1) <= I) {
#pragma unroll
        for (int dt = 0; dt < 2; ++dt) vfr[s][dt] = *(const bf16x8_t*)(vtr + (size_t)(dt * 32) * SEQ + 16 * s); }
    __builtin_amdgcn_sched_barrier(0);
    f32x16_t o[2], o2[2];
#pragma unroll
    for (int dt = 0; dt < 2; ++dt)
#pragma unroll
        for (int x = 0; x < 16; ++x) { o[dt][x] = 0.f; o2[dt][x] = 0.f; }
#pragma unroll
    for (int dt = 0; dt < 2; ++dt)
#pragma unroll
        for (int ks = 0; ks < 4; ++ks) { const f32x4 a = pa[dt][ks], b2 = pc[dt][ks];
            u32x4 w; w.x = pk2(a[0], a[1]); w.y = pk2(a[2], a[3]); w.z = pk2(b2[0], b2[1]); w.w = pk2(b2[2], b2[3]);
            o2[dt] = MFMA32(__builtin_bit_cast(bf16x8_t, w), qf[ks], o2[dt]); }
    { int qv = q - 8 * hf; asm volatile("" : "+v"(qv));
#pragma unroll
      for (int g = 0; g < 4; ++g) if (g <= I) {
#pragma unroll
        for (int s = 0; s < 2; ++s) { float e[8];
#pragma unroll
            for (int j = 0; j < 8; ++j) { const int dd = qv + (32 * (I - g) - 16 * s - j); e[j] = dd >= 0 ? acc[g][8 * s + j] * exp2f((float)dd * lg) : 0.f; }
            u32x4 w; w.x = pk2(e[0], e[1]); w.y = pk2(e[2], e[3]); w.z = pk2(e[4], e[5]); w.w = pk2(e[6], e[7]); const bf16x8_t pb = __builtin_bit_cast(bf16x8_t, w);
#pragma unroll
            for (int dt = 0; dt < 2; ++dt) o[dt] = MFMA32(vfr[2 * g + s][dt], pb, o[dt]); }
        __builtin_amdgcn_sched_barrier(0); } }
    const float xi = exp2f((float)(i + 1) * lg);
    float s2 = 0.f;
#pragma unroll
    for (int dt = 0; dt < 2; ++dt)
#pragma unroll
        for (int x = 0; x < 16; ++x) { const float v = o[dt][x] + xi * o2[dt][x]; o[dt][x] = v; s2 += v * v; }
    s2 += __shfl_xor(s2, 32);
    const float rs = rsqrtf(s2 * (1.0f / 64.0f) + EPS);
    const bf16_t* gp = (const bf16_t*)(p.ws + WS_PROJ) + (size_t)(tok0 + i) * PP + CG + h * 64 + 4 * hf;
    bf16_t* yo = (bf16_t*)(p.ws + WS_YCAT) + (size_t)(tok0 + i) * DM + 512 + h * 64 + 4 * hf;
#pragma unroll
    for (int dt = 0; dt < 2; ++dt)
#pragma unroll
        for (int i4 = 0; i4 < 4; ++i4) { const u32x2 gw2 = *(const u32x2*)(gp + dt * 32 + 8 * i4);
            u32x2 w; w.x = pk2(o[dt][4 * i4] * rs * silu_f(lo16(gw2.x)), o[dt][4 * i4 + 1] * rs * silu_f(hi16(gw2.x))); w.y = pk2(o[dt][4 * i4 + 2] * rs * silu_f(lo16(gw2.y)), o[dt][4 * i4 + 3] * rs * silu_f(hi16(gw2.y)));
            *(u32x2*)(yo + dt * 32 + 8 * i4) = w; }
}

DI void scan_phase(const Params& p, int gt, int NT) {
    float* sst = (float*)(p.ws + WS_SST); const float* cdec = (const float*)(p.ws + WS_CDEC);
    for (int i = gt; i < NB * 4 * 8192; i += NT) { const int b = i >> 15, rem = i & 32767, h = rem >> 13, pn = rem & 8191; float run = 0.f;
#pragma unroll
        for (int c = 0; c < 32; ++c) { const size_t idx = ((size_t)((b * 32 + c) * 4 + h)) * 8192 + pn; const float st = sst[idx]; sst[idx] = run; run = cdec[(b * 32 + c) * 4 + h] * run + st; } }
    float* rst = (float*)(p.ws + WS_RST);
    for (int i = gt; i < NB * 4 * 4096; i += NT) { const int b = i >> 14, rem = i & 16383, h = rem >> 12, de = rem & 4095; float run = 0.f;
        const float gc = exp2f(128.0f * log2f(1.0f - exp2f(-5.0f - (float)h)));
#pragma unroll
        for (int c = 0; c < 32; ++c) { const size_t idx = ((size_t)((b * 32 + c) * 4 + h)) * 4096 + de; const float st = rst[idx]; rst[idx] = run; run = gc * run + st; } }
}

DI void ssd_y_unit(const Params& p, int l, int b, int c, int g, LAS unsigned char* lds, int tid, int wave, int lane) {
    LAS bf16_t* Cs = (LAS bf16_t*)lds; LAS bf16_t* Bs = Cs + 128 * 136;
    LAS float* CB = (LAS float*)(Bs + 128 * 136); LAS bf16_t* Pv = (LAS bf16_t*)CB;
    LAS float* dts = CB + 128 * 132; LAS float* acs = dts + 256;
    const int tok0 = b * SEQ + c * 128; const bf16_t* proj = (const bf16_t*)(p.ws + WS_PROJ);
    ssd_dt_acum(p, l, tok0, g, dts, acs, wave, lane);
    stage_conv(p, l, Cs, 136, tok0, c * 128, 512 + g * 128, tid);
    { const float* prev = (const float*)(p.ws + WS_SST) + ((size_t)((b * 32 + c) * 4 + 2 * g)) * 8192;
      for (int e = tid; e < 128 * 32; e += NTHR) { const int r = e >> 5, n4 = (e & 31) * 4; const f32x4 v = *(const f32x4*)(prev + r * 128 + n4);
          u32x2 w; w.x = pk2(v[0], v[1]); w.y = pk2(v[2], v[3]); *(LAS u32x2*)(Pv + r * 136 + (r >> 5) * 8 + n4) = w; } }
    __syncthreads();
    const int i = tid >> 2, q = tid & 3, hh = q >> 1;
    float y[32];
#pragma unroll
    for (int cc = 0; cc < 32; ++cc) y[cc] = 0.f;
    nt_acc<32, 128>(y, Cs + i * 136, Pv + (q * 32) * 136 + q * 8, 136);
    { const float ea = __expf(acs[hh * 128 + i]);
#pragma unroll
      for (int cc = 0; cc < 32; ++cc) y[cc] *= ea; }
    __syncthreads();
    stage_conv(p, l, Bs, 136, tok0, c * 128, 256 + g * 128, tid);
    __syncthreads();
    { float cb[32];
#pragma unroll
      for (int cc = 0; cc < 32; ++cc) cb[cc] = 0.f;
      nt_acc<32, 128>(cb, Cs + i * 136, Bs + q * 136, 4 * 136);
#pragma unroll
      for (int cc = 0; cc < 32; ++cc) CB[i * 132 + cc * 4 + q] = cb[cc]; }
    __syncthreads();
    stage_conv(p, l, Bs, 136, tok0, c * 128, g * 128, tid);
    __syncthreads();
    { const float ai = acs[hh * 128 + i]; const int jmax = wave * 16 + 15;
      for (int j = 0; j <= jmax; ++j) { const float m = (j <= i) ? CB[i * 132 + j] * __expf(ai - acs[hh * 128 + j]) * dts[hh * 128 + j] : 0.f; axpy_row<32>(y, m, Bs + j * 136 + q * 32); } }
    { const int head = 2 * g + hh; const float dsk = p.in[10][l * 4 + head]; float xs[32];
#pragma unroll
      for (int c8 = 0; c8 < 32; c8 += 8) { float t8[8]; unpack8(*(const LAS u32x4*)(Bs + i * 136 + q * 32 + c8), t8);
#pragma unroll
          for (int e = 0; e < 8; ++e) xs[c8 + e] = t8[e]; }
      const bf16_t* zp = proj + (size_t)(tok0 + i) * PP + BZ + g * 128 + q * 32; float s2 = 0.f;
#pragma unroll
      for (int c8 = 0; c8 < 32; c8 += 8) { float z8[8]; unpack8(*(const u32x4*)(zp + c8), z8);
#pragma unroll
          for (int e = 0; e < 8; ++e) { const float v = (y[c8 + e] + dsk * xs[c8 + e]) * silu_f(z8[e]); y[c8 + e] = v; s2 += v * v; } }
      s2 += __shfl_xor(s2, 1); s2 += __shfl_xor(s2, 2);
      const float rs = rsqrtf(s2 * (1.0f / 128.0f) + EPS);
      const float* ng = p.in[11] + l * 256 + g * 128 + q * 32;
      bf16_t* yo = (bf16_t*)(p.ws + WS_YCAT) + (size_t)(tok0 + i) * DM + 256 + g * 128 + q * 32;
#pragma unroll
      for (int c8 = 0; c8 < 32; c8 += 8) { u32x4 w; w.x = pk2(y[c8] * rs * ng[c8], y[c8 + 1] * rs * ng[c8 + 1]); w.y = pk2(y[c8 + 2] * rs * ng[c8 + 2], y[c8 + 3] * rs * ng[c8 + 3]);
          w.z = pk2(y[c8 + 4] * rs * ng[c8 + 4], y[c8 + 5] * rs * ng[c8 + 5]); w.w = pk2(y[c8 + 6] * rs * ng[c8 + 6], y[c8 + 7] * rs * ng[c8 + 7]); *(u32x4*)(yo + c8) = w; } }
    __syncthreads();
}

DI void ret_y_unit(const Params& p, int b, int c, int h, LAS unsigned char* lds, int tid, int wave) {
    LAS bf16_t* Qs = (LAS bf16_t*)lds; LAS bf16_t* Ks = Qs + 128 * 72; LAS bf16_t* Vs = Ks + 128 * 72;
    LAS float* Pr = (LAS float*)(Vs + 128 * 72); LAS float* S = Pr + 64 * 64;
    const int tok0 = b * SEQ + c * 128; const bf16_t* proj = (const bf16_t*)(p.ws + WS_PROJ);
    for (int e = tid; e < 128 * 8; e += NTHR) { const int j = e >> 3, c8 = (e & 7) * 8; const bf16_t* rp = proj + (size_t)(tok0 + j) * PP + h * 64 + c8;
        *(LAS u32x4*)(Qs + j * 72 + c8) = *(const u32x4*)(rp + CQ); *(LAS u32x4*)(Ks + j * 72 + c8) = *(const u32x4*)(rp + CK); *(LAS u32x4*)(Vs + j * 72 + c8) = *(const u32x4*)(rp + CV); }
    { const float* prev = (const float*)(p.ws + WS_RST) + ((size_t)((b * 32 + c) * 4 + h)) * 4096;
      for (int e = tid; e < 1024; e += NTHR) *(LAS f32x4*)(Pr + e * 4) = *(const f32x4*)(prev + e * 4); }
    __syncthreads();
    const int i = tid >> 2, q = tid & 3; const float lg = log2f(1.0f - exp2f(-5.0f - (float)h));
    { float s[32];
#pragma unroll
      for (int cc = 0; cc < 32; ++cc) s[cc] = 0.f;
      nt_acc<32, 64>(s, Qs + i * 72, Ks + q * 72, 4 * 72);
#pragma unroll
      for (int cc = 0; cc < 32; ++cc) { const int j = cc * 4 + q; S[i * 132 + j] = (j <= i) ? s[cc] * exp2f((float)(i - j) * lg) : 0.f; } }
    __syncthreads();
    float y[16];
#pragma unroll
    for (int cc = 0; cc < 16; ++cc) y[cc] = 0.f;
    for (int d = 0; d < 64; ++d) { const float qv = bf2f(Qs[i * 72 + d]);
#pragma unroll
        for (int c4 = 0; c4 < 16; c4 += 4) { const f32x4 pv = *(const LAS f32x4*)(Pr + d * 64 + q * 16 + c4); y[c4] += qv * pv[0]; y[c4 + 1] += qv * pv[1]; y[c4 + 2] += qv * pv[2]; y[c4 + 3] += qv * pv[3]; } }
    { const float xi = exp2f((float)(i + 1) * lg);
#pragma unroll
      for (int cc = 0; cc < 16; ++cc) y[cc] *= xi; }
    { const int jmax = wave * 16 + 15;
      for (int j = 0; j <= jmax; ++j) axpy_row<16>(y, S[i * 132 + j], Vs + j * 72 + q * 16); }
    float s2 = 0.f;
#pragma unroll
    for (int cc = 0; cc < 16; ++cc) s2 += y[cc] * y[cc];
    s2 += __shfl_xor(s2, 1); s2 += __shfl_xor(s2, 2);
    const float rs = rsqrtf(s2 * (1.0f / 64.0f) + EPS);
    const bf16_t* gp = proj + (size_t)(tok0 + i) * PP + CG + h * 64 + q * 16;
    bf16_t* yo = (bf16_t*)(p.ws + WS_YCAT) + (size_t)(tok0 + i) * DM + 512 + h * 64 + q * 16;
#pragma unroll
    for (int c8 = 0; c8 < 16; c8 += 8) { float g8[8]; unpack8(*(const u32x4*)(gp + c8), g8); u32x4 w;
        w.x = pk2(y[c8] * rs * silu_f(g8[0]), y[c8 + 1] * rs * silu_f(g8[1])); w.y = pk2(y[c8 + 2] * rs * silu_f(g8[2]), y[c8 + 3] * rs * silu_f(g8[3]));
        w.z = pk2(y[c8 + 4] * rs * silu_f(g8[4]), y[c8 + 5] * rs * silu_f(g8[5])); w.w = pk2(y[c8 + 6] * rs * silu_f(g8[6]), y[c8 + 7] * rs * silu_f(g8[7])); *(u32x4*)(yo + c8) = w; }
    __syncthreads();
}

#define SSB ((unsigned long long*)(ws + WS_SS))
#define XB ((bf16_t*)(ws + WS_XB))
#define YC ((bf16_t*)(ws + WS_YCAT))
#define PROJ ((bf16_t*)(ws + WS_PROJ))
#define HB ((bf16_t*)(ws + WS_H))
#define PE ((bf16_t*)(ws + WS_PE))

#define CAS4 __attribute__((address_space(4)))
#define RELOAD_P() const CAS4 Params* kp_ = (const CAS4 Params*)__builtin_amdgcn_kernarg_segment_ptr(); asm volatile("" : "+s"(kp_)); const Params& p = *(const Params*)kp_; unsigned char* ws = p.ws; (void)ws
#define FRESH_LANE(v) int v; asm volatile("v_mbcnt_lo_u32_b32 %0, -1, 0\n\tv_mbcnt_hi_u32_b32 %0, -1, %0" : "=v"(v))
#define RELOAD_IDS() RELOAD_P(); FRESH_LANE(lane_); const int lane = lane_, wave = wave_s, tid = wave_s * 64 + lane_; const int gw = blk * NWV + wave, gt = blk * NTHR + tid; (void)gw; (void)gt; (void)lane
#define GEMM_TID() ({ FRESH_LANE(l_); wave_s * 64 + l_; })
#define GBAR() do { ++nbar; asm volatile("s_waitcnt vmcnt(0)" ::: "memory"); __syncthreads(); { FRESH_LANE(l_); if (wave_s == 0 && l_ == 0) { RELOAD_P(); unsigned* bar = (unsigned*)(ws + WS_BAR); \
        if (nbar == 1u) {     \
            __builtin_amdgcn_fence(__ATOMIC_RELEASE, "agent"); asm volatile("s_waitcnt vmcnt(0)" ::: "memory"); \
            __hip_atomic_fetch_add(bar + 32, 1u, __ATOMIC_RELAXED, __HIP_MEMORY_SCOPE_AGENT); \
            while (__hip_atomic_load(bar + 32, __ATOMIC_RELAXED, __HIP_MEMORY_SCOPE_AGENT) < (unsigned)G) __builtin_amdgcn_s_sleep(1); \
        } else {              \
            const unsigned rnd = nbar - 1u; \
            const unsigned old = __hip_atomic_fetch_add(bar + 64 + 64 * xcc_s, 1u, __ATOMIC_RELAXED, __HIP_MEMORY_SCOPE_AGENT); \
            if (old + 1u == rnd * nloc_s) { __builtin_amdgcn_fence(__ATOMIC_RELEASE, "agent"); asm volatile("s_waitcnt vmcnt(0)" ::: "memory"); \
                __hip_atomic_fetch_add(bar, 1u, __ATOMIC_RELAXED, __HIP_MEMORY_SCOPE_AGENT); } \
            const unsigned target = rnd * nx_s; \
            while (__hip_atomic_load(bar, __ATOMIC_RELAXED, __HIP_MEMORY_SCOPE_AGENT) < target) __builtin_amdgcn_s_sleep(1); } \
        __builtin_amdgcn_fence(__ATOMIC_ACQUIRE, "agent"); asm volatile("s_waitcnt vmcnt(0)" ::: "memory"); } } __syncthreads(); \
        if (nbar == 1u) { RELOAD_P(); const unsigned* cn = (const unsigned*)(ws + WS_BAR) + 1536; unsigned nl = 1u, nxx = 0u; \
            for (unsigned j = 0; j < 16u; ++j) { const unsigned cj = __hip_atomic_load(cn + j, __ATOMIC_RELAXED, __HIP_MEMORY_SCOPE_AGENT); if (j == xcc_s) nl = cj; nxx += cj > 0u ? 1u : 0u; } \
            nloc_s = (unsigned)__builtin_amdgcn_readfirstlane((int)nl); nx_s = (unsigned)__builtin_amdgcn_readfirstlane((int)nxx); } \
    } while (0)
#define SS_IN (SSB + (l == 0 ? 0 : 3 * M))
#define SSA (SSB + (1 + 3 * l) * M)
#define SSBB (SSB + (2 + 3 * l) * M)
#define SSC (SSB + (3 + 3 * l) * M)
#ifdef PROBE_MASK
#define TIC() do { t0_ = __builtin_amdgcn_s_memrealtime(); } while (0)
#define TOC(ph) do { if ((PROBE_MASK >> (ph)) & 1) tacc += __builtin_amdgcn_s_memrealtime() - t0_; t0_ = __builtin_amdgcn_s_memrealtime(); } while (0)
#else
#define TIC() do { } while (0)
#define TOC(ph) do { } while (0)
#endif
template <int l> DI void run_layer(LAS unsigned char* lds, const int G, const int blk, const int NGW, const int NT, const int wave_s, unsigned& nbar, unsigned long long& tacc, unsigned long long& t0_, const unsigned xcc_s, unsigned& nloc_s, unsigned& nx_s) {

        { RELOAD_P(); pg8::Gemm g{l == 0 ? XB : (const bf16_t*)p.out, (const bf16_t*)(ws + WS_WIN), M, PN, DM};        pg8::StaticOrder S; S.init(M, PN, G, blk);
          pg8::EpiScale<0> E{PROJ, PP, SS_IN};
          pg8::gemm_phase<pg8::EpiScale<0>, pg8::StaticOrder, true, true>(lds, g, S, E, GEMM_TID()); }
        GBAR(); TOC(1);
        { RELOAD_IDS(); for (int t0 = blk; t0 < 256; t0 += G) { const int t = (G == 256) ? (((t0 & 7) << 5) | (t0 >> 3)) : t0; e1_tile(p, l, t, lds, tid, wave, lane); } }
        GBAR(); TOC(2);
        { RELOAD_IDS(); for (int u = blk; u < 256; u += G) ssd_states_mfma(p, l, u >> 6, (u >> 1) & 31, u & 1, lds, tid, wave, lane); }
        TOC(13);
        { RELOAD_IDS(); for (int u = blk; u < 512; u += G) ret_states_mfma(p, u >> 7, (u >> 2) & 31, u & 3, lds, tid, wave, lane); }
        TOC(14);
        { RELOAD_IDS(); for (int u = blk; u < 256; u += G) conv_unit(p, l, u >> 6, (u & 63) * 64, lds, tid, wave, lane); }
        TOC(15);
        { RELOAD_IDS(); for (int ub0 = blk; ub0 < 256; ub0 += G) { const int ub = (G == 256) ? (((ub0 & 7) << 5) | (ub0 >> 3)) : ub0; const int bh = ub >> 4, seg = ub & 15;
            for (int pat = 0; pat < 3; ++pat) {
                int r, i0;
                if (pat == 0) { r = 0; i0 = seg * 256 + wave * 32; }
                else if (pat == 1) { r = wave >> 1; i0 = seg * 64 + (wave & 1) * 32; }
                else { r = (seg & 1) * 8 + wave; i0 = (seg >> 1) * 32; }
                attn_tile32(p, bh >> 2, bh & 3, pat, r, i0, lane); } } }
        GBAR(); TOC(3);
        { RELOAD_IDS(); scan_phase(p, gt, NT); attn_combine(p, gt, NT); }
        GBAR(); TOC(4);
        { RELOAD_IDS(); for (int u = blk; u < 256; u += G) ssd_y_mfma(p, l, u >> 6, (u >> 1) & 31, u & 1, lds, tid, wave, lane); }
        TOC(16);
        { RELOAD_IDS(); for (int u0 = blk; u0 < 256; u0 += G) { const int u = u0 + 256 * (wave >> 2); ret_y_tile32(p, u >> 7, (u >> 2) & 31, u & 3, wave & 3, lane); } }
        GBAR(); TOC(5);
        { RELOAD_P(); pg8::Gemm g{YC, (const bf16_t*)(ws + WS_WOUT), M, DM, DM}; pg8::StaticOrder S; S.init(M, DM, G, blk);
          pg8::EpiRes<0, l == 0 ? 0 : 1, 0, 1> E{p.in[0], (const bf16_t*)p.out, nullptr, XB, SSA, DM, nullptr, nullptr};
          pg8::gemm_phase<pg8::EpiRes<0, l == 0 ? 0 : 1, 0, 1>, pg8::StaticOrder, true, true>(lds, g, S, E, GEMM_TID()); }
        GBAR(); TOC(6);
        { RELOAD_P(); pg8::Gemm g{XB, (const bf16_t*)(ws + WS_WUP), M, FF, DM}; pg8::StaticOrder S; S.init(M, FF, G, blk);
          pg8::EpiScale<1> E{HB, FF, SSA};
          pg8::gemm_phase<pg8::EpiScale<1>, pg8::StaticOrder, true, true>(lds, g, S, E, GEMM_TID()); }
        GBAR(); TOC(7);
        { RELOAD_P(); pg8::Gemm g{HB, (const bf16_t*)(ws + WS_WDOWN), M, DM, FF}; pg8::StaticOrder S; S.init(M, DM, G, blk);
          pg8::EpiRes<0, 1, 0, 1> E{nullptr, XB, nullptr, XB, SSBB, DM, nullptr, nullptr};
          pg8::gemm_phase<pg8::EpiRes<0, 1, 0, 1>, pg8::StaticOrder, true, true>(lds, g, S, E, GEMM_TID()); }
        GBAR(); TOC(8);
        if (l == 0) { RELOAD_IDS(); convert_weights(p, 1, 1, lds, blk, G, tid); __syncthreads(); }
        { RELOAD_P(); pg8::Gemm g{(const bf16_t*)(ws + (l ? WS_PB1 : WS_PB0)), (const bf16_t*)(ws + (l ? WS_WPLE1 : WS_WPLE0)), M, DM, PLE}; pg8::StaticOrder S; S.init(M, DM, G, blk);
          pg8::EpiPe E{PE, DM};
          pg8::gemm_phase<pg8::EpiPe, pg8::StaticOrder, true, true>(lds, g, S, E, GEMM_TID()); }
        { RELOAD_P(); pg8::Gemm g{XB, (const bf16_t*)(ws + (l ? WS_WGATE1 : WS_WGATE0)), M, DM, DM}; pg8::StaticOrder S; S.init(M, DM, G, blk);
          pg8::EpiRes<1, 1, l == 0 ? 0 : 1, l == 0 ? 1 : 0> E{nullptr, XB, p.out, (bf16_t*)p.out, SSC, DM, PE, SSBB};
          pg8::gemm_phase<pg8::EpiRes<1, 1, l == 0 ? 0 : 1, l == 0 ? 1 : 0>, pg8::StaticOrder, true, true>(lds, g, S, E, GEMM_TID()); }
        if (l == 0) { GBAR(); } TOC(9);
    }

__global__ void __launch_bounds__(NTHR, 2) fwd_kernel(Params p_unused) {
    extern __shared__ __attribute__((aligned(16))) unsigned char lds_raw[];
    LAS unsigned char* lds = (LAS unsigned char*)lds_raw;
    cg::grid_group grid = cg::this_grid();
    const int G = gridDim.x, blk = blockIdx.x;
    const int NGW = G * NWV, NT = G * NTHR;
    const int wave_s = __builtin_amdgcn_readfirstlane(threadIdx.x >> 6);
    unsigned nbar = 0; unsigned long long tacc = 0, t0_ = 0; (void)tacc; (void)t0_;
    const unsigned xcc_s = (unsigned)__builtin_amdgcn_s_getreg((3 << 11) | 20) & 0xFu;
    unsigned nloc_s = 1u, nx_s = 1u;
    TIC();
    { RELOAD_IDS();
    if (blk == 0) for (int i = tid; i < 2048; i += NTHR) ((unsigned*)(ws + WS_BAR))[i] = 0u;
    prologue(p, gw, NGW, lane); TOC(10);
    convert_weights(p, 0, 3, lds, blk, G, tid); TOC(11);
    convert_weights(p, 1, 2, lds, blk, G, tid); TOC(12); }
    grid.sync();
    { RELOAD_IDS(); if (tid == 0) __hip_atomic_fetch_add((unsigned*)(ws + WS_BAR) + 1536 + xcc_s, 1u, __ATOMIC_RELAXED, __HIP_MEMORY_SCOPE_AGENT); }
    TOC(0);

    run_layer<0>(lds, G, blk, NGW, NT, wave_s, nbar, tacc, t0_, xcc_s, nloc_s, nx_s);
    run_layer<1>(lds, G, blk, NGW, NT, wave_s, nbar, tacc, t0_, xcc_s, nloc_s, nx_s);
#ifdef PROBE_MASK
    { RELOAD_IDS(); if (blk == 0 && tid == 0) *(volatile float*)(ws + WS_BAR + 16384) = (float)tacc * PROBE_K; }
    GBAR();
    { RELOAD_IDS(); const float sc = 1.0f + __hip_atomic_load((float*)(ws + WS_BAR + 16384), __ATOMIC_RELAXED, __HIP_MEMORY_SCOPE_AGENT); for (int i = gt; i < M * DM; i += NT) p.out[i] *= sc; }
#endif
}

extern "C" void kernel_launch(void* const* d_in, const int* in_sizes, int n_in, void* d_out, int out_size, void* d_ws, size_t ws_size, hipStream_t stream) {
    static int grid = 0;
    if (grid == 0) {
        int dev = 0, cus = 0, per_cu = 0;
        hipGetDevice(&dev); hipDeviceGetAttribute(&cus, hipDeviceAttributeMultiprocessorCount, dev);
        if (hipFuncSetAttribute((const void*)fwd_kernel, hipFuncAttributeMaxDynamicSharedMemorySize, LDS_BYTES) != hipSuccess) { fprintf(stderr, "kernel_launch: hipFuncSetAttribute failed\n"); }
        if (hipOccupancyMaxActiveBlocksPerMultiprocessor(&per_cu, (const void*)fwd_kernel, NTHR, LDS_BYTES) != hipSuccess || per_cu < 1) { fprintf(stderr, "kernel_launch: occupancy query says %d\n", per_cu); per_cu = 1; }
        (void)hipGetLastError();
        grid = cus * (per_cu > 1 ? 1 : per_cu);
        if (n_in != 23 || ws_size < WS_END) { fprintf(stderr, "kernel_launch: unexpected n_in %d / ws %zu\n", n_in, ws_size); }
    }
    Params p{};
    for (int i = 0; i < 23; ++i) p.in[i] = (const float*)d_in[i];
    p.out = (float*)d_out; p.ws = (unsigned char*)d_ws;
    void* args[] = {&p};
    hipError_t e = hipLaunchCooperativeKernel((const void*)fwd_kernel, dim3(grid), dim3(NTHR), args, LDS_BYTES, stream);
    if (e != hipSuccess) fprintf(stderr, "cooperative launch failed: %s (grid %d)\n", hipGetErrorString(e), grid);
}
```

```cpp
#include <hip/hip_runtime.h>
#include <cstdio>
#include <cstdint>
namespace pg8 {
#define PG8_LAS __attribute__((address_space(3)))
typedef unsigned short bf16_t;
typedef short bf16x8 __attribute__((ext_vector_type(8)));
typedef float f32x4 __attribute__((ext_vector_type(4)));
typedef unsigned u32x4 __attribute__((ext_vector_type(4)));
constexpr int BM = 256, BK = 64, HALF = 128, HTB = HALF * BK * 2  , STAGE_BYTES = 8 * HTB, NXCD = 8, WGM = 8;

__host__ __device__ __forceinline__ int lds_byte(int r, int c) { const int st = (r >> 4) * 2 + (c >> 5), rr = r & 15, cc = c & 31, ob = rr * 64 + cc * 2; return st * 1024 + (ob ^ (((ob >> 9) & 1) << 5)); }
__host__ __device__ __forceinline__ void stage_rc(int b, int& R, int& C) { const int st = b / 1024, sb = b % 1024, swz = sb ^ (((sb >> 9) & 1) << 5); R = (st >> 1) * 16 + swz / 64; C = (st & 1) * 32 + (swz % 64) / 2; }
__host__ __device__ __forceinline__ int perm32(int rho) { const int n = rho >> 4, i = rho & 15; return 8 * (i >> 2) + 4 * n + (i & 3); }

struct Unit { int pm, pn; };
struct Gemm { const bf16_t* A; const bf16_t* Bt; int M, N, K; };

struct StaticOrder {
    int nM, nN, nwg, G, c;
    __host__ __device__ void init(int M, int N, int G_, int c_) { nM = M / BM; nN = N / BM; nwg = nM * nN; G = G_; c = c_; }
    __host__ __device__ bool next(int i, Unit& u) const {
        const long L = (long)i * G + c; if (L >= nwg) return false;
        int wgid = (int)L; { const int q = nwg / NXCD, r = nwg % NXCD, xcd = wgid % NXCD, off = wgid / NXCD; wgid = (xcd < r ? xcd * (q + 1) : r * (q + 1) + (xcd - r) * q) + off; }
        const int nig = WGM * nN, gid = wgid / nig, fm = gid * WGM, gsz = (nM - fm) < WGM ? (nM - fm) : WGM;
        u.pm = fm + ((wgid % nig) % gsz); u.pn = (wgid % nig) / gsz; return true;
    }
    __device__ __forceinline__ void a_ready(const Unit&) const {}
    __device__ __forceinline__ void done(const Unit&) const {}
};

__device__ __forceinline__ unsigned cvt_pk_bf16(float lo, float hi) { unsigned r; asm volatile("v_cvt_pk_bf16_f32 %0, %1, %2" : "=v"(r) : "v"(lo), "v"(hi)); return r; }

typedef unsigned u32x2 __attribute__((ext_vector_type(2)));
constexpr float RMS_EPS = 1e-6f;
template <int ACT> struct EpiScale {
    static constexpr bool PERM = true, AFTER_DRAIN = false;
    bf16_t* O; int ldc; const unsigned long long* ss;
    __device__ __forceinline__ void operator()(const f32x4 (&acc)[2][2][4][2], const Unit& u, int wr, int wc, int fr, int fq) const {
        const int row0 = u.pm * BM + wr * 64 + fr; const int col0 = u.pn * BM + wc * 32 + 8 * fq;
        float rr[2][4];
#pragma unroll
        for (int ai = 0; ai < 2; ++ai)
#pragma unroll
            for (int m = 0; m < 4; ++m) rr[ai][m] = (float)ss[row0 + ai * HALF + m * 16] * (1.0f / 1048576.0f);
#pragma unroll
        for (int ai = 0; ai < 2; ++ai)
#pragma unroll
            for (int m = 0; m < 4; ++m) { const int row = row0 + ai * HALF + m * 16; const float r = rsqrtf(rr[ai][m] * (1.0f / 1024.0f) + RMS_EPS);
                bf16_t* rowp = O + (size_t)row * ldc + col0;
#pragma unroll
                for (int bj = 0; bj < 2; ++bj) { f32x4 v0 = acc[ai][bj][m][0] * r, v1 = acc[ai][bj][m][1] * r;
                    if (ACT == 1) {
#pragma unroll
                        for (int e = 0; e < 4; ++e) { float a = fmaxf(v0[e], 0.f), b = fmaxf(v1[e], 0.f); v0[e] = a * a; v1[e] = b * b; } }
                    u32x4 w; w.x = cvt_pk_bf16(v0[0], v0[1]); w.y = cvt_pk_bf16(v0[2], v0[3]); w.z = cvt_pk_bf16(v1[0], v1[1]); w.w = cvt_pk_bf16(v1[2], v1[3]);
                    *(u32x4*)(rowp + bj * HALF) = w; }
                asm volatile("" ::: "memory"); }
    }
};
struct EpiPe {
    static constexpr bool PERM = true, AFTER_DRAIN = false;
    bf16_t* O; int ldc;
    __device__ __forceinline__ void operator()(const f32x4 (&acc)[2][2][4][2], const Unit& u, int wr, int wc, int fr, int fq) const {
        const int col0 = u.pn * BM + wc * 32 + 8 * fq;
#pragma unroll
        for (int ai = 0; ai < 2; ++ai)
#pragma unroll
            for (int m = 0; m < 4; ++m) { const size_t off = (size_t)(u.pm * BM + ai * HALF + wr * 64 + m * 16 + fr) * ldc + col0;
#pragma unroll
                for (int bj = 0; bj < 2; ++bj) { const f32x4 v0 = acc[ai][bj][m][0], v1 = acc[ai][bj][m][1];
                    u32x4 w; w.x = cvt_pk_bf16(v0[0], v0[1]); w.y = cvt_pk_bf16(v0[2], v0[3]); w.z = cvt_pk_bf16(v1[0], v1[1]); w.w = cvt_pk_bf16(v1[2], v1[3]);
                    *(u32x4*)(O + off + bj * HALF) = w; } }
    }
};
template <int GATE, int BB, int WF, int WB> struct EpiRes {
    static constexpr bool PERM = true, AFTER_DRAIN = false;
    const float* base; const bf16_t* baseb; float* out; bf16_t* xb; unsigned long long* ssout; int ldc; const bf16_t* pe; const unsigned long long* ss;
    __device__ __forceinline__ void operator()(const f32x4 (&acc)[2][2][4][2], const Unit& u, int wr, int wc, int fr, int fq) const {
        const int col0 = u.pn * BM + wc * 32 + 8 * fq;
        float rr[2][4];
        if (GATE) {
#pragma unroll
            for (int ai = 0; ai < 2; ++ai)
#pragma unroll
                for (int m = 0; m < 4; ++m) rr[ai][m] = (float)ss[u.pm * BM + ai * HALF + wr * 64 + m * 16 + fr] * (1.0f / 1048576.0f);
        }
#pragma unroll
        for (int aim = 0; aim < 4; ++aim) { const int ai = aim >> 1, mh = (aim & 1) * 2;
            f32x4 bs[4][2][2]; u32x4 bw[4][2]; u32x4 pw[4][2];
#pragma unroll
            for (int m = mh; m < mh + 2; ++m) { const size_t off = (size_t)(u.pm * BM + ai * HALF + wr * 64 + m * 16 + fr) * ldc + col0;
#pragma unroll
                for (int bj = 0; bj < 2; ++bj) { if (BB) bw[m][bj] = *(const u32x4*)(baseb + off + bj * HALF); else { bs[m][bj][0] = *(const f32x4*)(base + off + bj * HALF); bs[m][bj][1] = *(const f32x4*)(base + off + bj * HALF + 4); }
                    if (GATE) pw[m][bj] = *(const u32x4*)(pe + off + bj * HALF); } }
#pragma unroll
            for (int m = mh; m < mh + 2; ++m) { const int row = u.pm * BM + ai * HALF + wr * 64 + m * 16 + fr; const size_t off = (size_t)row * ldc + col0; float s = 0.f;
                float r = 1.f; if (GATE) r = rsqrtf(rr[ai][m] * (1.0f / 1024.0f) + RMS_EPS);
#pragma unroll
                for (int bj = 0; bj < 2; ++bj) { const size_t o2 = off + bj * HALF; f32x4 a0 = acc[ai][bj][m][0], a1 = acc[ai][bj][m][1];
                    if (GATE) { const u32x4 pq = pw[m][bj];
                        const float p0 = __uint_as_float(pq.x << 16), p1 = __uint_as_float(pq.x & 0xffff0000u), p2 = __uint_as_float(pq.y << 16), p3 = __uint_as_float(pq.y & 0xffff0000u);
                        const float p4 = __uint_as_float(pq.z << 16), p5 = __uint_as_float(pq.z & 0xffff0000u), p6 = __uint_as_float(pq.w << 16), p7 = __uint_as_float(pq.w & 0xffff0000u);
                        a0[0] = p0 / (1.f + __expf(-a0[0] * r)); a0[1] = p1 / (1.f + __expf(-a0[1] * r)); a0[2] = p2 / (1.f + __expf(-a0[2] * r)); a0[3] = p3 / (1.f + __expf(-a0[3] * r));
                        a1[0] = p4 / (1.f + __expf(-a1[0] * r)); a1[1] = p5 / (1.f + __expf(-a1[1] * r)); a1[2] = p6 / (1.f + __expf(-a1[2] * r)); a1[3] = p7 / (1.f + __expf(-a1[3] * r)); }
                    f32x4 b0, b1; if (BB) { const u32x4 q4 = bw[m][bj]; b0 = (f32x4){__uint_as_float(q4.x << 16), __uint_as_float(q4.x & 0xffff0000u), __uint_as_float(q4.y << 16), __uint_as_float(q4.y & 0xffff0000u)};
                        b1 = (f32x4){__uint_as_float(q4.z << 16), __uint_as_float(q4.z & 0xffff0000u), __uint_as_float(q4.w << 16), __uint_as_float(q4.w & 0xffff0000u)}; } else { b0 = bs[m][bj][0]; b1 = bs[m][bj][1]; }
                    const f32x4 o0 = b0 + a0, o1 = b1 + a1; if (WF) { *(f32x4*)(out + o2) = o0; *(f32x4*)(out + o2 + 4) = o1; }
                    if (WB) { u32x4 w; w.x = cvt_pk_bf16(o0[0], o0[1]); w.y = cvt_pk_bf16(o0[2], o0[3]); w.z = cvt_pk_bf16(o1[0], o1[1]); w.w = cvt_pk_bf16(o1[2], o1[3]); *(u32x4*)(xb + o2) = w;
                        s += ((o0[0] * o0[0] + o0[1] * o0[1]) + (o0[2] * o0[2] + o0[3] * o0[3])) + ((o1[0] * o1[0] + o1[1] * o1[1]) + (o1[2] * o1[2] + o1[3] * o1[3])); } }
                if (WB) { s += __shfl_xor(s, 16); s += __shfl_xor(s, 32);
                    if (fq == 0) atomicAdd(ssout + row, (unsigned long long)(s * 1048576.0f + 0.5f)); } }
            asm volatile("" ::: "memory"); }
    }
};
template <class Epi, class Sched, bool ALIGN_EPI = false, bool SP2 = false>
__device__ __forceinline__ void gemm_phase(PG8_LAS unsigned char* lds, const Gemm g, const Sched& S, const Epi& E, int tid_) {
    const int tid = tid_, wid = __builtin_amdgcn_readfirstlane(tid >> 6), lane = tid & 63, wr = wid >> 2, wc = wid & 3, fr = lane & 15, fq = lane >> 4;
    const int K = g.K, nt = K / BK;
    unsigned voffA[2], voffB[2];
#pragma unroll
    for (int i = 0; i < 2; ++i) { int R, C; stage_rc(tid * 16 + i * 8192, R, C); const int Rb = Epi::PERM ? ((R & ~31) + perm32(R & 31)) : R;
        voffA[i] = (unsigned)(R * K + C) * 2u; voffB[i] = (unsigned)(Rb * K + C) * 2u; }
    const size_t kstep = (size_t)(BK * 2);
    const size_t hstep = (size_t)HALF * K * 2;
    const size_t tstep = 2 * hstep;
    const unsigned ldsw = (unsigned)wid * 1024u;
    const int aoff = lds_byte(wr * 64 + fr, fq * 8), boff = lds_byte(wc * 32 + fr, fq * 8);
#define PG8_SA(b, h) (((b) * 2 + (h)) * HTB)
#define PG8_SB(b, h) ((4 + (b) * 2 + (h)) * HTB)
#define PG8_STAGE(bufoff, gbase, voff) do { _Pragma("unroll") for (int _i = 0; _i < 2; ++_i) \
        __builtin_amdgcn_global_load_lds((const unsigned*)((const char*)(gbase) + (voff)[_i]), (PG8_LAS unsigned*)(lds + (bufoff) + ldsw + _i * 8192), 16, 0, 0); } while (0)
#define PG8_LDA(dst, b, h) do { _Pragma("unroll") for (int m = 0; m < 4; ++m) _Pragma("unroll") for (int k = 0; k < 2; ++k) dst[m][k] = *(const PG8_LAS bf16x8*)(lds + PG8_SA(b, h) + aoff + m * 2048 + k * 1024); } while (0)
#define PG8_LDB(dst, b, h) do { _Pragma("unroll") for (int n = 0; n < 2; ++n) _Pragma("unroll") for (int k = 0; k < 2; ++k) dst[n][k] = *(const PG8_LAS bf16x8*)(lds + PG8_SB(b, h) + boff + n * 2048 + k * 1024); } while (0)
#define PG8_MMA(ai, bj, At, Bt) do { __builtin_amdgcn_s_setprio(1); _Pragma("unroll") for (int m = 0; m < 4; ++m) _Pragma("unroll") for (int n = 0; n < 2; ++n) _Pragma("unroll") for (int k = 0; k < 2; ++k) \
        acc[ai][bj][m][n] = __builtin_amdgcn_mfma_f32_16x16x32_bf16(Bt[n][k], At[m][k], acc[ai][bj][m][n], 0, 0, 0); __builtin_amdgcn_s_setprio(0); } while (0)
#define PG8_WAIT_V(n) asm volatile("s_waitcnt vmcnt(" #n ")" ::: "memory")
#define PG8_WAIT_L(n) asm volatile("s_waitcnt lgkmcnt(" #n ")" ::: "memory")
#define PG8_BAR __builtin_amdgcn_s_barrier()
#define PG8_SCHED __builtin_amdgcn_sched_barrier(0)
    Unit cur, nxt; int ui = 0;
    if (!S.next(0, cur)) return;
    f32x4 acc[2][2][4][2];
#pragma unroll
    for (int a = 0; a < 2; ++a)
#pragma unroll
        for (int b = 0; b < 2; ++b)
#pragma unroll
            for (int m = 0; m < 4; ++m)
#pragma unroll
                for (int n = 0; n < 2; ++n) acc[a][b][m][n] = (f32x4){0.f, 0.f, 0.f, 0.f};
    bf16x8 At[4][2], B0[2][2], B1[2][2];
    const char* cA = (const char*)g.A + (size_t)cur.pm * tstep; const char* cB = (const char*)g.Bt + (size_t)cur.pn * tstep;
    S.a_ready(cur);
    if constexpr (SP2) {
        PG8_STAGE(PG8_SB(0, 0), cB, voffB); PG8_STAGE(PG8_SB(0, 1), cB + hstep, voffB); PG8_STAGE(PG8_SA(0, 0), cA, voffA); PG8_STAGE(PG8_SA(0, 1), cA + hstep, voffA);
        if (wr == 1) PG8_BAR;
        PG8_WAIT_V(2); PG8_BAR;
        PG8_STAGE(PG8_SB(1, 0), cB + kstep, voffB); PG8_STAGE(PG8_SA(1, 0), cA + kstep, voffA); PG8_STAGE(PG8_SB(1, 1), cB + hstep + kstep, voffB);
        PG8_WAIT_V(6); PG8_BAR;
    } else {
        PG8_STAGE(PG8_SB(0, 0), cB, voffB); PG8_STAGE(PG8_SA(0, 0), cA, voffA); PG8_STAGE(PG8_SB(0, 1), cB + hstep, voffB); PG8_STAGE(PG8_SA(0, 1), cA + hstep, voffA);
        if (wr == 1) PG8_BAR;
        PG8_WAIT_V(4); PG8_BAR;
        PG8_STAGE(PG8_SB(1, 0), cB + kstep, voffB); PG8_STAGE(PG8_SA(1, 0), cA + kstep, voffA); PG8_STAGE(PG8_SB(1, 1), cB + hstep + kstep, voffB);
        PG8_WAIT_V(6); PG8_BAR;
    }
    for (;;) {
        const bool has_next = S.next(ui + 1, nxt);
        const char* nA = has_next ? (const char*)g.A + (size_t)nxt.pm * tstep : cA; const char* nB = has_next ? (const char*)g.Bt + (size_t)nxt.pn * tstep : cB;
        for (int t = 0; t < nt; t += 2) {
            const bool last = (t == nt - 2);
            const char* a1 = cA + (size_t)(t + 1) * kstep;
            const char* a2 = last ? nA : cA + (size_t)(t + 2) * kstep; const char* b2 = last ? nB : cB + (size_t)(t + 2) * kstep;
            const char* a3 = a2 + kstep; const char* b3 = b2 + kstep;
            if (last && has_next) S.a_ready(nxt);
            if constexpr (SP2) {
            PG8_LDB(B0, 0, 0); PG8_LDB(B1, 0, 1); PG8_SCHED; PG8_LDA(At, 0, 0); PG8_STAGE(PG8_SA(1, 1), a1 + hstep, voffA);
            PG8_WAIT_V(8); PG8_WAIT_L(0); PG8_BAR; PG8_MMA(0, 0, At, B0); PG8_MMA(0, 1, At, B1); PG8_BAR; PG8_SCHED;
            PG8_LDA(At, 0, 1); PG8_STAGE(PG8_SB(0, 0), b2, voffB); PG8_STAGE(PG8_SB(0, 1), b2 + hstep, voffB); PG8_STAGE(PG8_SA(0, 0), a2, voffA);
            PG8_WAIT_V(8); PG8_WAIT_L(0); PG8_BAR; PG8_MMA(1, 0, At, B0); PG8_MMA(1, 1, At, B1); PG8_BAR; PG8_SCHED;
            PG8_LDB(B0, 1, 0); PG8_LDB(B1, 1, 1); PG8_SCHED; PG8_LDA(At, 1, 0); PG8_STAGE(PG8_SA(0, 1), a2 + hstep, voffA);
            PG8_WAIT_V(8); PG8_WAIT_L(0); PG8_BAR; PG8_MMA(0, 0, At, B0); PG8_MMA(0, 1, At, B1); PG8_BAR; PG8_SCHED;
            PG8_LDA(At, 1, 1); PG8_STAGE(PG8_SB(1, 0), b3, voffB); PG8_STAGE(PG8_SB(1, 1), b3 + hstep, voffB); PG8_STAGE(PG8_SA(1, 0), a3, voffA);
            PG8_WAIT_V(8); PG8_WAIT_L(0); PG8_BAR; PG8_MMA(1, 0, At, B0); PG8_MMA(1, 1, At, B1); PG8_BAR; PG8_SCHED;
            } else {
            PG8_LDB(B0, 0, 0); PG8_SCHED; PG8_LDA(At, 0, 0); PG8_STAGE(PG8_SA(1, 1), a1 + hstep, voffA);
            PG8_WAIT_L(8); PG8_BAR; PG8_WAIT_L(0); PG8_MMA(0, 0, At, B0); PG8_BAR; PG8_SCHED;
            PG8_LDB(B1, 0, 1); PG8_STAGE(PG8_SB(0, 0), b2, voffB);
            PG8_BAR; PG8_WAIT_L(0); PG8_MMA(0, 1, At, B1); PG8_BAR;
            PG8_LDA(At, 0, 1); PG8_STAGE(PG8_SA(0, 0), a2, voffA);
            PG8_BAR; PG8_WAIT_L(0); PG8_MMA(1, 0, At, B0); PG8_BAR; PG8_SCHED;
            PG8_STAGE(PG8_SB(0, 1), b2 + hstep, voffB);
            PG8_WAIT_V(6); PG8_BAR; PG8_MMA(1, 1, At, B1); PG8_BAR;
            PG8_LDB(B0, 1, 0); PG8_SCHED; PG8_LDA(At, 1, 0); PG8_STAGE(PG8_SA(0, 1), a2 + hstep, voffA);
            PG8_WAIT_L(8); PG8_BAR; PG8_WAIT_L(0); PG8_MMA(0, 0, At, B0); PG8_BAR; PG8_SCHED;
            PG8_LDB(B1, 1, 1); PG8_STAGE(PG8_SB(1, 0), b3, voffB);
            PG8_BAR; PG8_WAIT_L(0); PG8_MMA(0, 1, At, B1); PG8_BAR;
            PG8_LDA(At, 1, 1); PG8_STAGE(PG8_SA(1, 0), a3, voffA);
            PG8_BAR; PG8_WAIT_L(0); PG8_MMA(1, 0, At, B0); PG8_BAR; PG8_SCHED;
            PG8_STAGE(PG8_SB(1, 1), b3 + hstep, voffB);
            PG8_WAIT_V(6); PG8_BAR; PG8_MMA(1, 1, At, B1); PG8_BAR;
            }
        }
        if constexpr (ALIGN_EPI) { if (wr == 0) PG8_BAR; }
        if constexpr (!Epi::AFTER_DRAIN) { E(acc, cur, wr, wc, fr, fq); S.done(cur); }
        if (!has_next) break;
#pragma unroll
        for (int a = 0; a < 2; ++a)
#pragma unroll
            for (int b = 0; b < 2; ++b)
#pragma unroll
                for (int m = 0; m < 4; ++m)
#pragma unroll
                    for (int n = 0; n < 2; ++n) acc[a][b][m][n] = (f32x4){0.f, 0.f, 0.f, 0.f};
        cur = nxt; cA = nA; cB = nB; ++ui;
        if constexpr (ALIGN_EPI) { if (wr == 1) PG8_BAR; }
    }
    PG8_WAIT_V(0);
    if constexpr (!ALIGN_EPI) { if (wr == 0) PG8_BAR; }
    PG8_BAR;
    if constexpr (Epi::AFTER_DRAIN) { E.fused(acc, cur, wr, wc, fr, fq, lds, wid, lane); S.done(cur); }
#undef PG8_SA
#undef PG8_SB
#undef PG8_STAGE
#undef PG8_LDA
#undef PG8_LDB
#undef PG8_MMA
#undef PG8_WAIT_V
#undef PG8_WAIT_L
#undef PG8_BAR
#undef PG8_SCHED
}
}

#include <hip/hip_cooperative_groups.h>
namespace cg = cooperative_groups;
#define LAS __attribute__((address_space(3)))
#define DI __device__ __forceinline__
typedef unsigned short bf16_t;
typedef unsigned u32x4 __attribute__((ext_vector_type(4)));
typedef unsigned u32x2 __attribute__((ext_vector_type(2)));
typedef float f32x4 __attribute__((ext_vector_type(4)));

constexpr int SEQ = 4096, NB = 4, M = NB * SEQ, DM = 1024, FF = 4096, PLE = 256;
constexpr int PN = 3584;
constexpr int PP = 3584;
constexpr int IN_ORIG = 3332;
constexpr int AQ = 0, AK = 256, AV = 512, BZ = 768, BX = 1024, BDT = 1792, CQ = 2048, CK = 2304, CV = 2560, CG = 2816, DV = 3072, DG = 3328;
constexpr float EPS = 1e-6f;
constexpr int NTHR = 512, NWV = 8;
constexpr int LDS_BYTES = 147456;
constexpr size_t MiB = 1u << 20;
constexpr size_t WS_SS = 0;
constexpr size_t WS_CDEC = 940 * 1024; constexpr size_t WS_BAR = 960 * 1024;
constexpr size_t WS_TAB = 1 * MiB;
constexpr size_t WS_PB0 = 3 * MiB;
constexpr size_t WS_WIN = 11 * MiB, WS_WOUT = 18 * MiB, WS_WUP = 20 * MiB, WS_WDOWN = 28 * MiB, WS_WPLE0 = 36 * MiB, WS_WGATE0 = 37 * MiB;
constexpr size_t WS_XB = 39 * MiB, WS_YCAT = 71 * MiB, WS_PROJ = 103 * MiB, WS_SST = 215 * MiB, WS_RST = 231 * MiB;
constexpr size_t WS_H = 103 * MiB, WS_PE = 103 * MiB;
constexpr size_t WS_VT = 39 * MiB;
constexpr size_t WS_LSE = 250 * MiB;
constexpr size_t WS_WPLE1 = 239 * MiB, WS_WGATE1 = 240 * MiB, WS_PB1 = 242 * MiB, WS_END = 256 * MiB;

struct Params {
    const float* in[23]; float* out; unsigned char* ws;
};

DI float bf2f(bf16_t u) { return __uint_as_float((unsigned)u << 16); }
DI unsigned f2bf(float f) { unsigned u = __float_as_uint(f); return (u + 0x7fffu + ((u >> 16) & 1u)) >> 16; }
DI unsigned pk2(float lo, float hi) { return f2bf(lo) | (f2bf(hi) << 16); }
DI float lo16(unsigned w) { return __uint_as_float(w << 16); }
DI float hi16(unsigned w) { return __uint_as_float(w & 0xffff0000u); }
DI float wave_sum(float v) {
#pragma unroll
    for (int o = 1; o < 64; o <<= 1) v += __shfl_xor(v, o);
    return v;
}
DI float wave_max(float v) {
#pragma unroll
    for (int o = 1; o < 64; o <<= 1) v = fmaxf(v, __shfl_xor(v, o));
    return v;
}
DI float silu_f(float v) { return v / (1.f + __expf(-v)); }
DI float sigm_f(float v) { return 1.f / (1.f + __expf(-v)); }
DI void unpack8(const u32x4 w, float (&f)[8]) { f[0] = lo16(w.x); f[1] = hi16(w.x); f[2] = lo16(w.y); f[3] = hi16(w.y); f[4] = lo16(w.z); f[5] = hi16(w.z); f[6] = lo16(w.w); f[7] = hi16(w.w); }

DI void tr_block_item(const float* W, int K, int Norig, bf16_t* WT, const float* g, bool gap, int kb, int nb, LAS float* T, int tid) {
    const int k0 = 64 * kb, n0 = 256 * nb, c4 = tid & 63, kr = tid >> 6;
    const int n = n0 + 4 * c4; int orig = n; if (gap) orig = (n < 1796) ? n : (n < 2048 ? -1 : n - 252);
    f32x4 v[8];
#pragma unroll
    for (int ps = 0; ps < 8; ++ps) { const int k = ps * 8 + kr; v[ps] = (f32x4){0.f, 0.f, 0.f, 0.f}; if (orig >= 0) v[ps] = *(const f32x4*)(W + (size_t)(k0 + k) * Norig + orig); }
#pragma unroll
    for (int ps = 0; ps < 8; ++ps) { const int k = ps * 8 + kr; const float gk = g ? g[k0 + k] : 1.0f; *(LAS f32x4*)(T + k * 260 + 4 * c4) = v[ps] * gk; }
    __syncthreads();
    const int nn = tid & 255, kh = tid >> 8; const LAS float* s = T + (kh * 32) * 260 + nn;
    bf16_t* dst = WT + (size_t)(n0 + nn) * K + k0 + kh * 32;
#pragma unroll
    for (int c = 0; c < 4; ++c) { u32x4 o; o.x = pk2(s[(8 * c) * 260], s[(8 * c + 1) * 260]); o.y = pk2(s[(8 * c + 2) * 260], s[(8 * c + 3) * 260]); o.z = pk2(s[(8 * c + 4) * 260], s[(8 * c + 5) * 260]); o.w = pk2(s[(8 * c + 6) * 260], s[(8 * c + 7) * 260]);
        *(u32x4*)(dst + 8 * c) = o; }
    __syncthreads();
}
DI void convert_weights(const Params& p, int l, int which, LAS unsigned char* lds, int blk, int G, int tid) {
    LAS float* T = (LAS float*)lds; unsigned char* ws = p.ws;
    constexpr int I_IN = 16 * 14, I_OUT = 16 * 4, I_UP = 16 * 16, I_DN = 64 * 4, I_PLE = 4 * 4, I_GATE = 16 * 4;
    const int n_items = ((which & 1) ? (I_IN + I_OUT + I_UP + I_DN) : 0) + ((which & 2) ? (I_PLE + I_GATE) : 0);
    for (int it = blk; it < n_items; it += G) {
        int r = it;
        if (which & 1) {
            if (r < I_IN) { tr_block_item(p.in[3] + (size_t)l * DM * IN_ORIG, DM, IN_ORIG, (bf16_t*)(ws + WS_WIN), p.in[2] + l * DM, true, r / 14, r % 14, T, tid); continue; } r -= I_IN;
            if (r < I_OUT) { tr_block_item(p.in[16] + (size_t)l * DM * DM, DM, DM, (bf16_t*)(ws + WS_WOUT), nullptr, false, r / 4, r % 4, T, tid); continue; } r -= I_OUT;
            if (r < I_UP) { tr_block_item(p.in[18] + (size_t)l * DM * FF, DM, FF, (bf16_t*)(ws + WS_WUP), p.in[17] + l * DM, false, r / 16, r % 16, T, tid); continue; } r -= I_UP;
            if (r < I_DN) { tr_block_item(p.in[19] + (size_t)l * FF * DM, FF, DM, (bf16_t*)(ws + WS_WDOWN), nullptr, false, r / 4, r % 4, T, tid); continue; } r -= I_DN;
        }
        if (r < I_PLE) { tr_block_item(p.in[21] + (size_t)l * PLE * DM, PLE, DM, (bf16_t*)(ws + (l ? WS_WPLE1 : WS_WPLE0)), nullptr, false, r / 4, r % 4, T, tid); continue; } r -= I_PLE;
        tr_block_item(p.in[22] + (size_t)l * DM * DM, DM, DM, (bf16_t*)(ws + (l ? WS_WGATE1 : WS_WGATE0)), p.in[20] + l * DM, false, r / 4, r % 4, T, tid);
    }
    if (which & 2) {
        const f32x4* src = (const f32x4*)(p.in[1] + (size_t)l * M * PLE); u32x2* dst = (u32x2*)(ws + (l ? WS_PB1 : WS_PB0));
        const int gt = blk * NTHR + tid, NT = G * NTHR;
        for (int i = gt; i < M * PLE / 4; i += NT) { const f32x4 v = src[i]; u32x2 o; o.x = pk2(v[0], v[1]); o.y = pk2(v[2], v[3]); dst[i] = o; }
    }
}

DI void prologue(const Params& p, int gw, int NGW, int lane) {
    unsigned char* ws = p.ws;
    const int gt = gw * 64 + lane, NT = NGW * 64;
    unsigned long long* ss = (unsigned long long*)(ws + WS_SS);
    for (int i = gt; i < 6 * M; i += NT) ss[M + i] = 0ull;
    float* tab = (float*)(ws + WS_TAB);
    for (int idx = gt; idx < 2 * SEQ * 32; idx += NT) {
        const int t = idx / (SEQ * 32), e = idx % (SEQ * 32), pos = e >> 5, i = e & 31;
        const double base = t ? 0.7429639507594948 : 0.7498942093324559;
        double a = 1.0;
        for (int k = 0; k < 31; ++k) a = (k < i) ? a * base : a;
        const double ang = (double)pos * a;
        const double kk = rint(ang * 0.15915494309189535);
        const double r = ang - kk * 6.283185307179586477;
        const double r2 = r * r; double s = r, c = 1.0, ts = r, tc = 1.0;
        for (int n = 1; n <= 14; ++n) { tc *= -r2 / (double)((2 * n - 1) * (2 * n)); c += tc; ts *= -r2 / (double)((2 * n) * (2 * n + 1)); s += ts; }
        tab[(size_t)(2 * t) * SEQ * 32 + e] = (float)c; tab[(size_t)(2 * t + 1) * SEQ * 32 + e] = (float)s;
    }
    const float* x = p.in[0]; bf16_t* xb = (bf16_t*)(ws + WS_XB);
    for (int m = gw; m < M; m += NGW) {
        const f32x4* xr = (const f32x4*)(x + (size_t)m * DM) + lane; f32x4 v[4]; float s = 0.f;
#pragma unroll
        for (int j = 0; j < 4; ++j) { v[j] = xr[64 * j]; s += (v[j][0] * v[j][0] + v[j][1] * v[j][1]) + (v[j][2] * v[j][2] + v[j][3] * v[j][3]); }
        s = wave_sum(s);
        if (lane == 0) ss[m] = (unsigned long long)(s * 1048576.0f + 0.5f);
        u32x2* o = (u32x2*)(xb + (size_t)m * DM) + lane;
#pragma unroll
        for (int j = 0; j < 4; ++j) { u32x2 w; w.x = pk2(v[j][0], v[j][1]); w.y = pk2(v[j][2], v[j][3]); o[64 * j] = w; }
    }
}

DI void e1_tokens(const Params& p, int l, int tok_lo, int tok_hi, int lane) {
    bf16_t* proj = (bf16_t*)(p.ws + WS_PROJ); const float* tab = (const float*)(p.ws + WS_TAB);
    const int sub = lane >> 5, l5 = lane & 31, which = l5 >> 2, hq = which & 3, isk = which >> 2, i0 = (l5 & 3) * 8;
    const int col = (sub == 0 ? (isk ? AK : AQ) : (isk ? CK : CQ)) + hq * 64;
    const float* gain = (isk ? p.in[5] : p.in[4]) + l * 64;
    const float sc = ((sub == 0 && !isk) || (sub == 1 && isk)) ? 0.125f : 1.0f;
    const float* ct = tab + (size_t)(2 * sub) * SEQ * 32; const float* st = tab + (size_t)(2 * sub + 1) * SEQ * 32;
    for (int tok0 = tok_lo; tok0 < tok_hi; tok0 += 4) {
        u32x4 a1[4], a2[4]; f32x4 c0[4], c1[4], s0[4], s1[4]; u32x2 vw[4], gwd[4];
#pragma unroll
        for (int t = 0; t < 4; ++t) { const int tok = tok0 + t, pos = tok & (SEQ - 1); const bf16_t* ptr = proj + (size_t)tok * PP + col;
            a1[t] = *(const u32x4*)(ptr + i0); a2[t] = *(const u32x4*)(ptr + 32 + i0);
            c0[t] = *(const f32x4*)(ct + pos * 32 + i0); c1[t] = *(const f32x4*)(ct + pos * 32 + i0 + 4); s0[t] = *(const f32x4*)(st + pos * 32 + i0); s1[t] = *(const f32x4*)(st + pos * 32 + i0 + 4);
            vw[t] = *(const u32x2*)(proj + (size_t)tok * PP + DV + lane * 4); gwd[t] = *(const u32x2*)(proj + (size_t)tok * PP + DG + lane * 4); }
#pragma unroll
        for (int t = 0; t < 4; ++t) { const int tok = tok0 + t; bf16_t* ptr = proj + (size_t)tok * PP + col;
            float x1[8], x2[8]; unpack8(a1[t], x1); unpack8(a2[t], x2);
            float s2 = 0.f;
#pragma unroll
            for (int i = 0; i < 8; ++i) s2 += x1[i] * x1[i] + x2[i] * x2[i];
            s2 += __shfl_xor(s2, 1); s2 += __shfl_xor(s2, 2);
            if (sub == 0) { const float r = rsqrtf(s2 * (1.0f / 64.0f) + EPS);
#pragma unroll
                for (int i = 0; i < 8; ++i) { x1[i] *= r * gain[i0 + i]; x2[i] *= r * gain[32 + i0 + i]; } }
            float o1[8], o2[8];
#pragma unroll
            for (int i = 0; i < 8; ++i) { const float c = i < 4 ? c0[t][i & 3] : c1[t][i & 3], s = i < 4 ? s0[t][i & 3] : s1[t][i & 3]; o1[i] = (x1[i] * c - x2[i] * s) * sc; o2[i] = (x2[i] * c + x1[i] * s) * sc; }
            u32x4 w1, w2; w1.x = pk2(o1[0], o1[1]); w1.y = pk2(o1[2], o1[3]); w1.z = pk2(o1[4], o1[5]); w1.w = pk2(o1[6], o1[7]);
            w2.x = pk2(o2[0], o2[1]); w2.y = pk2(o2[2], o2[3]); w2.z = pk2(o2[4], o2[5]); w2.w = pk2(o2[6], o2[7]);
            *(u32x4*)(ptr + i0) = w1; *(u32x4*)(ptr + 32 + i0) = w2;
            u32x2 o; o.x = pk2(lo16(vw[t].x) * sigm_f(lo16(gwd[t].x)), hi16(vw[t].x) * sigm_f(hi16(gwd[t].x))); o.y = pk2(lo16(vw[t].y) * sigm_f(lo16(gwd[t].y)), hi16(vw[t].y) * sigm_f(hi16(gwd[t].y)));
            *(u32x2*)(proj + (size_t)tok * PP + DV + lane * 4) = o; }
    }
}


DI void e1_tile(const Params& p, int l, int tile, LAS unsigned char* lds, int tid, int wave, int lane) {
    const int T0 = tile * 64; const int b = T0 >> 12, s0 = T0 & (SEQ - 1);
    LAS bf16_t* Vs = (LAS bf16_t*)lds;
    const bf16_t* proj = (const bf16_t*)(p.ws + WS_PROJ);
    LAS bf16_t* Vr = Vs + 64 * 264;
    for (int e = tid; e < 64 * 32; e += NTHR) { const int j = e >> 5, c8 = (e & 31) * 8;
        *(LAS u32x4*)(Vs + j * 264 + c8) = *(const u32x4*)(proj + (size_t)(T0 + j) * PP + AV + c8);
        *(LAS u32x4*)(Vr + j * 264 + c8) = *(const u32x4*)(proj + (size_t)(T0 + j) * PP + CV + c8); }
    e1_tokens(p, l, T0 + wave * 8, T0 + wave * 8 + 8, lane);
    __syncthreads();
    bf16_t* vt = (bf16_t*)(p.ws + WS_VT);
    const int col = tid & 255, half = tid >> 8, h = col >> 6, dim = col & 63;
    {
      bf16_t* dst = vt + ((size_t)((b * 4 + h) * 64 + dim)) * SEQ + s0 + half * 32;
#pragma unroll
      for (int c8 = 0; c8 < 32; c8 += 8) { u32x4 w; const LAS bf16_t* s = Vs + (half * 32 + c8) * 264 + col;
          w.x = (unsigned)s[0] | ((unsigned)s[264] << 16); w.y = (unsigned)s[2 * 264] | ((unsigned)s[3 * 264] << 16); w.z = (unsigned)s[4 * 264] | ((unsigned)s[5 * 264] << 16); w.w = (unsigned)s[6 * 264] | ((unsigned)s[7 * 264] << 16);
          *(u32x4*)(dst + c8) = w; } }
    {
      bf16_t* dst = vt + (size_t)12 * 1024 * 1024 + ((size_t)((b * 4 + h) * 64 + dim)) * SEQ + s0 + half * 32;
#pragma unroll
      for (int c8 = 0; c8 < 32; c8 += 8) { u32x4 w; const LAS bf16_t* s = Vr + (half * 32 + c8) * 264 + col;
          w.x = (unsigned)s[0] | ((unsigned)s[264] << 16); w.y = (unsigned)s[2 * 264] | ((unsigned)s[3 * 264] << 16); w.z = (unsigned)s[4 * 264] | ((unsigned)s[5 * 264] << 16); w.w = (unsigned)s[6 * 264] | ((unsigned)s[7 * 264] << 16);
          *(u32x4*)(dst + c8) = w; } }
    {
      bf16_t* base = vt + (size_t)4 * 1024 * 1024;
#pragma unroll
      for (int r = 0; r < 4; ++r) { const LAS bf16_t* s = Vs + (half * 32 + r) * 264 + col; u32x4 w;
          w.x = (unsigned)s[0] | ((unsigned)s[4 * 264] << 16); w.y = (unsigned)s[8 * 264] | ((unsigned)s[12 * 264] << 16); w.z = (unsigned)s[16 * 264] | ((unsigned)s[20 * 264] << 16); w.w = (unsigned)s[24 * 264] | ((unsigned)s[28 * 264] << 16);
          *(u32x4*)(base + ((size_t)(((b * 4 + h) * 4 + r) * 64 + dim)) * 1024 + (s0 >> 2) + half * 8) = w; } }
    {
      bf16_t* base = vt + (size_t)8 * 1024 * 1024;
#pragma unroll
      for (int r8 = 0; r8 < 8; ++r8) { const int r = half * 8 + r8; const LAS bf16_t* s = Vs + r * 264 + col;
          u32x2 w; w.x = (unsigned)s[0] | ((unsigned)s[16 * 264] << 16); w.y = (unsigned)s[32 * 264] | ((unsigned)s[48 * 264] << 16);
          *(u32x2*)(base + ((size_t)(((b * 4 + h) * 16 + r) * 64 + dim)) * 256 + (s0 >> 4)) = w; } }
    __syncthreads();
}

typedef short bf16x8_t __attribute__((ext_vector_type(8)));
typedef float f32x16_t __attribute__((ext_vector_type(16)));
#define MFMA32(a, b, c) __builtin_amdgcn_mfma_f32_32x32x16_bf16((a), (b), (c), 0, 0, 0)
DI void attn_tile32(const Params& p, int b, int h, int pat, int r, int i0, int lane) {
    const int dsh = 2 * pat, L = SEQ >> dsh;
    const int q = lane & 31, hf = lane >> 5;
    const bf16_t* projb = (const bf16_t*)(p.ws + WS_PROJ) + (size_t)(b * SEQ) * PP + h * 64 + hf * 8;
    const int tq = ((i0 + q) << dsh) + r;
    bf16x8_t qf[4];
#pragma unroll
    for (int ks = 0; ks < 4; ++ks) qf[ks] = *(const bf16x8_t*)(projb + (size_t)tq * PP + AQ + ks * 16);
    const int kk = (q & 0x13) | ((q & 4) << 1) | ((q & 8) >> 1);
    bf16x8_t kfr[5][4];
#pragma unroll
    for (int g = 0; g < 5; ++g) { int kap = i0 - 128 + 32 * g + kk; kap = kap < 0 ? 0 : (kap > L - 1 ? L - 1 : kap);
        const bf16_t* kp = projb + (size_t)((kap << dsh) + r) * PP + AK;
#pragma unroll
        for (int ks = 0; ks < 4; ++ks) kfr[g][ks] = *(const bf16x8_t*)(kp + ks * 16); }
    __builtin_amdgcn_sched_barrier(0);
    f32x16_t acc[5];
#pragma unroll
    for (int g = 0; g < 5; ++g) { f32x16_t a;
#pragma unroll
        for (int i = 0; i < 16; ++i) a[i] = 0.f;
#pragma unroll
        for (int ks = 0; ks < 4; ++ks) a = MFMA32(kfr[g][ks], qf[ks], a);
        acc[g] = a; }
    const bf16_t* vtb = (const bf16_t*)(p.ws + WS_VT) + (size_t)pat * 4 * 1024 * 1024 + ((size_t)((((b * 4 + h) << dsh) + r) * 64 + q)) * L;
    bf16x8_t vfr[10][2];
#pragma unroll
    for (int s = 0; s < 10; ++s) { int st = i0 - 128 + 16 * s + 8 * hf; st = st < 0 ? 0 : (st > L - 8 ? L - 8 : st);
#pragma unroll
        for (int dt = 0; dt < 2; ++dt) vfr[s][dt] = *(const bf16x8_t*)(vtb + (size_t)(dt * 32) * L + st); }
    __builtin_amdgcn_sched_barrier(0);
    float mx = -INFINITY;
    { int qv = q - 8 * hf; asm volatile("" : "+v"(qv));
      const int lb = (q > 128 - i0 ? q : 128 - i0) - 8 * hf, ub = 128 + qv;
#pragma unroll
      for (int g = 0; g < 5; ++g) {
#pragma unroll
        for (int i = 0; i < 16; ++i) { const int kc = 32 * g + 16 * (i >> 3) + (i & 7); const int t = min(kc - lb, ub - kc);
            const float v = t >= 0 ? acc[g][i] : -INFINITY; acc[g][i] = v; mx = fmaxf(mx, v); }
        __builtin_amdgcn_sched_barrier(0); } }
    mx = fmaxf(mx, __shfl_xor(mx, 32));
    float sum = 0.f; bf16x8_t pb[10];
#pragma unroll
    for (int g = 0; g < 5; ++g)
#pragma unroll
        for (int s = 0; s < 2; ++s) { float e[8];
#pragma unroll
            for (int j = 0; j < 8; ++j) { const float v = acc[g][8 * s + j]; const float ev = (v == -INFINITY) ? 0.f : __expf(v - mx); e[j] = ev; sum += ev; }
            u32x4 w; w.x = pk2(e[0], e[1]); w.y = pk2(e[2], e[3]); w.z = pk2(e[4], e[5]); w.w = pk2(e[6], e[7]); pb[2 * g + s] = __builtin_bit_cast(bf16x8_t, w); }
    sum += __shfl_xor(sum, 32);
    f32x16_t o[2];
#pragma unroll
    for (int dt = 0; dt < 2; ++dt)
#pragma unroll
        for (int i = 0; i < 16; ++i) o[dt][i] = 0.f;
#pragma unroll
    for (int s = 0; s < 10; ++s)
#pragma unroll
        for (int dt = 0; dt < 2; ++dt) o[dt] = MFMA32(vfr[s][dt], pb[s], o[dt]);
    const float inv = 1.0f / sum; const size_t tok = (size_t)(b * SEQ + tq);
    bf16_t* yo = (bf16_t*)(p.ws + WS_YCAT) + tok * DM + pat * 256 + h * 64 + 4 * hf;
#pragma unroll
    for (int dt = 0; dt < 2; ++dt)
#pragma unroll
        for (int i4 = 0; i4 < 4; ++i4) { u32x2 w; w.x = pk2(o[dt][4 * i4] * inv, o[dt][4 * i4 + 1] * inv); w.y = pk2(o[dt][4 * i4 + 2] * inv, o[dt][4 * i4 + 3] * inv); *(u32x2*)(yo + dt * 32 + 8 * i4) = w; }
    if (hf == 0) ((float*)(p.ws + WS_LSE))[((size_t)pat * M + tok) * 4 + h] = mx + __logf(sum);
}
DI void attn_combine(const Params& p, int gt, int NT) {
    bf16_t* yc = (bf16_t*)(p.ws + WS_YCAT); const float* lse = (const float*)(p.ws + WS_LSE);
    for (int i = gt; i < M * 32; i += NT) { const int tok = i >> 5, c8 = (i & 31) * 8, h = c8 >> 6;
        const float l0 = lse[((size_t)0 * M + tok) * 4 + h], l1 = lse[((size_t)1 * M + tok) * 4 + h], l2 = lse[((size_t)2 * M + tok) * 4 + h];
        const float mm = fmaxf(l0, fmaxf(l1, l2)); float w0 = __expf(l0 - mm), w1 = __expf(l1 - mm), w2 = __expf(l2 - mm); const float iz = 1.0f / (w0 + w1 + w2); w0 *= iz; w1 *= iz; w2 *= iz;
        bf16_t* pp = yc + (size_t)tok * DM + c8; float a[8], bq[8], c[8];
        unpack8(*(const u32x4*)pp, a); unpack8(*(const u32x4*)(pp + 256), bq); unpack8(*(const u32x4*)(pp + 512), c);
        u32x4 w; w.x = pk2(w0 * a[0] + w1 * bq[0] + w2 * c[0], w0 * a[1] + w1 * bq[1] + w2 * c[1]); w.y = pk2(w0 * a[2] + w1 * bq[2] + w2 * c[2], w0 * a[3] + w1 * bq[3] + w2 * c[3]);
        w.z = pk2(w0 * a[4] + w1 * bq[4] + w2 * c[4], w0 * a[5] + w1 * bq[5] + w2 * c[5]); w.w = pk2(w0 * a[6] + w1 * bq[6] + w2 * c[6], w0 * a[7] + w1 * bq[7] + w2 * c[7]);
        *(u32x4*)pp = w; }
}

DI void ssd_dt_acum(const Params& p, int l, int tok0, int g, LAS float* dts, LAS float* acs, int wave, int lane) {
    if (wave < 2) {
        const int h = 2 * g + wave; const bf16_t* proj = (const bf16_t*)(p.ws + WS_PROJ);
        const float bias = p.in[8][l * 4 + h], a = -__expf(p.in[9][l * 4 + h]);
        float d[2];
#pragma unroll
        for (int e = 0; e < 2; ++e) { const float raw = bf2f(proj[(size_t)(tok0 + 2 * lane + e) * PP + BDT + h]) + bias; d[e] = raw > 20.f ? raw : log1pf(__expf(raw)); }
        const float v0 = d[0] * a, v1 = d[1] * a; float s = v0 + v1;
#pragma unroll
        for (int off = 1; off < 64; off <<= 1) { const float t = __shfl_up(s, off); if (lane >= off) s += t; }
        dts[wave * 128 + 2 * lane] = d[0]; dts[wave * 128 + 2 * lane + 1] = d[1];
        acs[wave * 128 + 2 * lane] = s - v1; acs[wave * 128 + 2 * lane + 1] = s;
    }
}
template <bool TR> DI void stage_conv_v(const Params& p, int l, LAS bf16_t* dst, int ld, int tok0, int seqpos0, int choff, const LAS float* wsc, int tid) {
    const int cc = tid & 15, j0 = (tid >> 4) * 4;
    const bf16_t* src = (const bf16_t*)(p.ws + WS_PROJ) + (size_t)tok0 * PP + BX + choff + cc * 8;
    const float* cw = p.in[6] + (size_t)l * 4 * 768 + choff + cc * 8; const float* cb = p.in[7] + l * 768 + choff + cc * 8;
    float w[4][8], bias[8];
#pragma unroll
    for (int k = 0; k < 4; ++k) { const f32x4 a = *(const f32x4*)(cw + k * 768), b2 = *(const f32x4*)(cw + k * 768 + 4);
        w[k][0] = a[0]; w[k][1] = a[1]; w[k][2] = a[2]; w[k][3] = a[3]; w[k][4] = b2[0]; w[k][5] = b2[1]; w[k][6] = b2[2]; w[k][7] = b2[3]; }
    { const f32x4 a = *(const f32x4*)cb, b2 = *(const f32x4*)(cb + 4); bias[0] = a[0]; bias[1] = a[1]; bias[2] = a[2]; bias[3] = a[3]; bias[4] = b2[0]; bias[5] = b2[1]; bias[6] = b2[2]; bias[7] = b2[3]; }
    float x[7][8];
#pragma unroll
    for (int rr = 0; rr < 7; ++rr) { const int s = j0 - 3 + rr; u32x4 v = (u32x4){0u, 0u, 0u, 0u}; if (seqpos0 + s >= 0) v = *(const u32x4*)(src + (long)s * PP); unpack8(v, x[rr]); }
    float o[4][8];
#pragma unroll
    for (int r = 0; r < 4; ++r)
#pragma unroll
        for (int e = 0; e < 8; ++e) { float v = bias[e];
#pragma unroll
            for (int k = 0; k < 4; ++k) v += w[k][e] * x[r + k][e];
            v = silu_f(v); if (TR && wsc) v *= wsc[(((choff + cc * 8 + e) & 64) ? 128 : 0) + j0 + r]; o[r][e] = v; }
    if (!TR) {
#pragma unroll
        for (int r = 0; r < 4; ++r) { u32x4 wv; wv.x = pk2(o[r][0], o[r][1]); wv.y = pk2(o[r][2], o[r][3]); wv.z = pk2(o[r][4], o[r][5]); wv.w = pk2(o[r][6], o[r][7]); *(LAS u32x4*)(dst + (j0 + r) * ld + cc * 8) = wv; }
    } else {
#pragma unroll
        for (int e = 0; e < 8; ++e) { u32x2 wv; wv.x = pk2(o[0][e], o[1][e]); wv.y = pk2(o[2][e], o[3][e]); *(LAS u32x2*)(dst + (cc * 8 + e) * ld + j0) = wv; }
    }
}
typedef short bf16x8_t __attribute__((ext_vector_type(8)));
#define MFMA16(a, b, c) __builtin_amdgcn_mfma_f32_16x16x32_bf16((a), (b), (c), 0, 0, 0)
DI void ssd_states_mfma(const Params& p, int l, int b, int c, int g, LAS unsigned char* lds, int tid, int wave, int lane) {
    LAS bf16_t* XT = (LAS bf16_t*)lds; LAS bf16_t* BT = XT + 128 * 136;
    LAS float* dts = (LAS float*)(BT + 128 * 136); LAS float* acs = dts + 256; LAS float* wsc = acs + 256;
    const int tok0 = b * SEQ + c * 128;
    ssd_dt_acum(p, l, tok0, g, dts, acs, wave, lane);
    __syncthreads();
    if (tid < 256) { const int hh = tid >> 7, j = tid & 127; wsc[tid] = __expf(acs[hh * 128 + 127] - acs[hh * 128 + j]) * dts[hh * 128 + j]; }
    if (tid < 2) ((float*)(p.ws + WS_CDEC))[(b * 32 + c) * 4 + 2 * g + tid] = __expf(acs[tid * 128 + 127]);
    __syncthreads();
    stage_conv_v<true>(p, l, XT, 136, tok0, c * 128, g * 128, wsc, tid);
    stage_conv_v<true>(p, l, BT, 136, tok0, c * 128, 256 + g * 128, nullptr, tid);
    __syncthreads();
    const int fr = lane & 15, quad = lane >> 4, hh = wave >> 2, pt = wave & 3;
    bf16x8_t af[4];
#pragma unroll
    for (int ks = 0; ks < 4; ++ks) af[ks] = *(const LAS bf16x8_t*)(XT + (hh * 64 + pt * 16 + fr) * 136 + ks * 32 + quad * 8);
    float* dst = (float*)(p.ws + WS_SST) + ((size_t)((b * 32 + c) * 4 + 2 * g + hh)) * 8192 + (pt * 16 + quad * 4) * 128 + fr;
#pragma unroll
    for (int nt = 0; nt < 8; ++nt) { f32x4 acc = (f32x4){0.f, 0.f, 0.f, 0.f};
#pragma unroll
        for (int ks = 0; ks < 4; ++ks) { const bf16x8_t bfv = *(const LAS bf16x8_t*)(BT + (nt * 16 + fr) * 136 + ks * 32 + quad * 8); acc = MFMA16(af[ks], bfv, acc); }
#pragma unroll
        for (int jj = 0; jj < 4; ++jj) dst[jj * 128 + nt * 16] = acc[jj]; }
    __syncthreads();
}
DI void ssd_y_mfma(const Params& p, int l, int b, int c, int g, LAS unsigned char* lds, int tid, int wave, int lane) {
    LAS bf16_t* Cs = (LAS bf16_t*)lds; LAS bf16_t* Bs = Cs + 128 * 136; LAS bf16_t* XT = Bs + 128 * 136; LAS bf16_t* Pv = XT + 128 * 136;
    LAS float* dts = (LAS float*)(Pv + 128 * 136); LAS float* acs = dts + 256;
    const int tok0 = b * SEQ + c * 128; const bf16_t* proj = (const bf16_t*)(p.ws + WS_PROJ);
    ssd_dt_acum(p, l, tok0, g, dts, acs, wave, lane);
    stage_conv_v<false>(p, l, Cs, 136, tok0, c * 128, 512 + g * 128, nullptr, tid);
    stage_conv_v<false>(p, l, Bs, 136, tok0, c * 128, 256 + g * 128, nullptr, tid);
    stage_conv_v<true>(p, l, XT, 136, tok0, c * 128, g * 128, nullptr, tid);
    { const float* prev = (const float*)(p.ws + WS_SST) + ((size_t)((b * 32 + c) * 4 + 2 * g)) * 8192;
      for (int e = tid; e < 128 * 32; e += NTHR) { const int r = e >> 5, n4 = (e & 31) * 4; const f32x4 v = *(const f32x4*)(prev + r * 128 + n4);
          u32x2 w; w.x = pk2(v[0], v[1]); w.y = pk2(v[2], v[3]); *(LAS u32x2*)(Pv + r * 136 + n4) = w; } }
    __syncthreads();
    const int fr = lane & 15, quad = lane >> 4, i = wave * 16 + fr, smax = (wave * 16 + 15) >> 5;
    const int dq = 8 * quad - fr; const LAS float* acq = acs + 8 * quad; const LAS float* dtq = dts + 8 * quad;
    bf16x8_t cf[4];
#pragma unroll
    for (int ks = 0; ks < 4; ++ks) cf[ks] = *(const LAS bf16x8_t*)(Cs + i * 136 + ks * 32 + quad * 8);
    f32x4 cbt[4][2];
#pragma unroll
    for (int s = 0; s < 4; ++s)
#pragma unroll
        for (int u = 0; u < 2; ++u) { f32x4 a = (f32x4){0.f, 0.f, 0.f, 0.f};
            if (s <= smax) { const int j = 32 * s + 8 * (fr >> 2) + 4 * u + (fr & 3);
#pragma unroll
                for (int ks = 0; ks < 4; ++ks) { const bf16x8_t bfv = *(const LAS bf16x8_t*)(Bs + j * 136 + ks * 32 + quad * 8); a = MFMA16(bfv, cf[ks], a); } }
#pragma unroll
            for (int jj = 0; jj < 4; ++jj) a[jj] = (dq <= 16 * wave - 32 * s - 4 * u - jj) ? a[jj] : 0.f;
            cbt[s][u] = a; asm volatile("" ::: "memory"); }
    float y[2][4][4];
#pragma unroll
    for (int hh = 0; hh < 2; ++hh) {
        const float ai = acs[hh * 128 + i];
        f32x4 o[4], o2[4];
#pragma unroll
        for (int pt = 0; pt < 4; ++pt) { o[pt] = (f32x4){0.f, 0.f, 0.f, 0.f}; o2[pt] = (f32x4){0.f, 0.f, 0.f, 0.f}; }
#pragma unroll
        for (int s = 0; s < 4; ++s) if (s <= smax) { float e[8];
#pragma unroll
            for (int u = 0; u < 2; ++u)
#pragma unroll
                for (int jj = 0; jj < 4; ++jj) { const int jo = hh * 128 + 32 * s + 4 * u + jj;
                    e[u * 4 + jj] = cbt[s][u][jj] * __expf(fminf(ai - acq[jo], 0.f)) * dtq[jo]; }
            u32x4 w; w.x = pk2(e[0], e[1]); w.y = pk2(e[2], e[3]); w.z = pk2(e[4], e[5]); w.w = pk2(e[6], e[7]); const bf16x8_t pb = __builtin_bit_cast(bf16x8_t, w);
#pragma unroll
            for (int pt = 0; pt < 4; ++pt) { const bf16x8_t xf = *(const LAS bf16x8_t*)(XT + (hh * 64 + pt * 16 + fr) * 136 + 32 * s + 8 * quad); o[pt] = MFMA16(xf, pb, o[pt]); } asm volatile("" ::: "memory"); }
#pragma unroll
        for (int ks = 0; ks < 4; ++ks) {
#pragma unroll
            for (int pt = 0; pt < 4; ++pt) { const bf16x8_t pf = *(const LAS bf16x8_t*)(Pv + (hh * 64 + pt * 16 + fr) * 136 + ks * 32 + quad * 8); o2[pt] = MFMA16(pf, cf[ks], o2[pt]); }
            asm volatile("" ::: "memory"); }
        const float ea = __expf(ai);
#pragma unroll
        for (int pt = 0; pt < 4; ++pt)
#pragma unroll
            for (int jj = 0; jj < 4; ++jj) y[hh][pt][jj] = o[pt][jj] + ea * o2[pt][jj];
    }
    float s2 = 0.f;
#pragma unroll
    for (int hh = 0; hh < 2; ++hh) { const float dsk = p.in[10][l * 4 + 2 * g + hh];
#pragma unroll
        for (int pt = 0; pt < 4; ++pt) { const int ch = hh * 64 + pt * 16 + quad * 4;
            const u32x2 zw = *(const u32x2*)(proj + (size_t)(tok0 + i) * PP + BZ + g * 128 + ch);
            const float z4[4] = {lo16(zw.x), hi16(zw.x), lo16(zw.y), hi16(zw.y)};
#pragma unroll
            for (int jj = 0; jj < 4; ++jj) { const float xv = bf2f(XT[(ch + jj) * 136 + i]); const float v = (y[hh][pt][jj] + dsk * xv) * silu_f(z4[jj]); y[hh][pt][jj] = v; s2 += v * v; } } }
    s2 += __shfl_xor(s2, 16); s2 += __shfl_xor(s2, 32);
    const float rs = rsqrtf(s2 * (1.0f / 128.0f) + EPS);
    bf16_t* yo = (bf16_t*)(p.ws + WS_YCAT) + (size_t)(tok0 + i) * DM + 256 + g * 128;
#pragma unroll
    for (int hh = 0; hh < 2; ++hh)
#pragma unroll
        for (int pt = 0; pt < 4; ++pt) { const int ch = hh * 64 + pt * 16 + quad * 4; const f32x4 ng = *(const f32x4*)(p.in[11] + l * 256 + g * 128 + ch);
            u32x2 w; w.x = pk2(y[hh][pt][0] * rs * ng[0], y[hh][pt][1] * rs * ng[1]); w.y = pk2(y[hh][pt][2] * rs * ng[2], y[hh][pt][3] * rs * ng[3]); *(u32x2*)(yo + ch) = w; }
    __syncthreads();
}

DI void conv_unit(const Params& p, int l, int b, int s0, LAS unsigned char* lds, int tid, int wave, int lane) {
    LAS bf16_t* Hs = (LAS bf16_t*)lds;
    LAS float* Os = (LAS float*)(lds + 94 * 256 * 2);
    const bf16_t* proj = (const bf16_t*)(p.ws + WS_PROJ);
    for (int e = tid; e < 94 * 32; e += NTHR) { const int r = e >> 5, c8 = (e & 31) * 8; const int s = s0 - 30 + r;
        u32x4 v = (u32x4){0u, 0u, 0u, 0u};
        if (s >= 0) v = *(const u32x4*)(proj + (size_t)(b * SEQ + s) * PP + DV + c8);
        *(LAS u32x4*)(Hs + r * 256 + c8) = v; }
    __syncthreads();
    { const int ch = tid & 255, half = tid >> 8;
      const float* w = p.in[12] + (size_t)l * 31 * 256 + ch; const float bias = p.in[13][l * 256 + ch];
      float wr[31];
#pragma unroll
      for (int k = 0; k < 31; ++k) wr[k] = w[k * 256];
      for (int tt = 0; tt < 32; ++tt) { const int t = half * 32 + tt; float a = bias;
#pragma unroll
          for (int k = 0; k < 31; ++k) a += wr[k] * bf2f(Hs[(t + k) * 256 + ch]);
          Os[t * 256 + ch] = a; } }
    __syncthreads();
    const f32x4 lg = *(const f32x4*)(p.in[14] + l * 256 + lane * 4), lb = *(const f32x4*)(p.in[15] + l * 256 + lane * 4);
    bf16_t* ycat = (bf16_t*)(p.ws + WS_YCAT);
    for (int tt = 0; tt < 8; ++tt) { const int t = wave * 8 + tt; const f32x4 v = *(const LAS f32x4*)(Os + t * 256 + lane * 4);
        const float mean = wave_sum((v[0] + v[1]) + (v[2] + v[3])) * (1.0f / 256.0f);
        const f32x4 d = v - mean; const float var = wave_sum((d[0] * d[0] + d[1] * d[1]) + (d[2] * d[2] + d[3] * d[3])) * (1.0f / 256.0f);
        const float rs = rsqrtf(var + EPS); f32x4 o = d * rs * lg + lb;
        u32x2 w; w.x = pk2(silu_f(o[0]), silu_f(o[1])); w.y = pk2(silu_f(o[2]), silu_f(o[3]));
        *(u32x2*)(ycat + (size_t)(b * SEQ + s0 + t) * DM + 768 + lane * 4) = w; }
    __syncthreads();
}

DI void ret_states_mfma(const Params& p, int b, int c, int h, LAS unsigned char* lds, int tid, int wave, int lane) {
    LAS bf16_t* KT = (LAS bf16_t*)lds;
    const int tok0 = b * SEQ + c * 128; const bf16_t* proj = (const bf16_t*)(p.ws + WS_PROJ);
    const float lg = log2f(1.0f - exp2f(-5.0f - (float)h));
    { const int cc = tid & 7, j0 = (tid >> 3) * 2; float k0[8], k1[8];
      unpack8(*(const u32x4*)(proj + (size_t)(tok0 + j0) * PP + CK + h * 64 + cc * 8), k0); unpack8(*(const u32x4*)(proj + (size_t)(tok0 + j0 + 1) * PP + CK + h * 64 + cc * 8), k1);
      const float z0 = exp2f((float)(127 - j0) * lg), z1 = exp2f((float)(126 - j0) * lg);
#pragma unroll
      for (int e = 0; e < 8; ++e) *(LAS unsigned*)(KT + (cc * 8 + e) * 136 + j0) = pk2(k0[e] * z0, k1[e] * z1); }
    __syncthreads();
    const int fr = lane & 15, quad = lane >> 4, et = wave >> 1;
    const bf16_t* vtr = (const bf16_t*)(p.ws + WS_VT) + (size_t)12 * 1024 * 1024 + ((size_t)((b * 4 + h) * 64 + et * 16 + fr)) * SEQ + c * 128 + quad * 8;
    bf16x8_t vf[4];
#pragma unroll
    for (int ks = 0; ks < 4; ++ks) vf[ks] = *(const bf16x8_t*)(vtr + ks * 32);
    float* dst = (float*)(p.ws + WS_RST) + ((size_t)((b * 32 + c) * 4 + h)) * 4096 + (et * 16 + quad * 4) * 64 + fr;
#pragma unroll
    for (int d2 = 0; d2 < 2; ++d2) { const int dt = (wave & 1) * 2 + d2; f32x4 acc = (f32x4){0.f, 0.f, 0.f, 0.f};
#pragma unroll
        for (int ks = 0; ks < 4; ++ks) { const bf16x8_t kf = *(const LAS bf16x8_t*)(KT + (dt * 16 + fr) * 136 + ks * 32 + quad * 8); acc = MFMA16(vf[ks], kf, acc); }
#pragma unroll
        for (int jj = 0; jj < 4; ++jj) dst[jj * 64 + dt * 16] = acc[jj]; }
    __syncthreads();
}
DI void ret_y_tile32(const Params& p, int b, int c, int h, int I, int lane) {
    const int q = lane & 31, hf = lane >> 5, i = I * 32 + q;
    const int tok0 = b * SEQ + c * 128;
    const bf16_t* projb = (const bf16_t*)(p.ws + WS_PROJ) + (size_t)tok0 * PP + h * 64 + hf * 8;
    const float lg = log2f(1.0f - exp2f(-5.0f - (float)h));
    bf16x8_t qf[4];
#pragma unroll
    for (int ks = 0; ks < 4; ++ks) qf[ks] = *(const bf16x8_t*)(projb + (size_t)i * PP + CQ + ks * 16);
    const int kk = (q & 0x13) | ((q & 4) << 1) | ((q & 8) >> 1);
    bf16x8_t kfr[4][4];
#pragma unroll
    for (int g = 0; g < 4; ++g) if (g <= I) { const bf16_t* kp = projb + (size_t)(32 * g + kk) * PP + CK;
#pragma unroll
        for (int ks = 0; ks < 4; ++ks) kfr[g][ks] = *(const bf16x8_t*)(kp + ks * 16); }
    const float* prevT = (const float*)(p.ws + WS_RST) + ((size_t)((b * 32 + c) * 4 + h)) * 4096 + q * 64 + hf * 8;
    f32x4 pa[2][4], pc[2][4];
#pragma unroll
    for (int dt = 0; dt < 2; ++dt)
#pragma unroll
        for (int ks = 0; ks < 4; ++ks) { const float* pp = prevT + (dt * 32) * 64 + ks * 16; pa[dt][ks] = *(const f32x4*)pp; pc[dt][ks] = *(const f32x4*)(pp + 4); }
    __builtin_amdgcn_sched_barrier(0);
    f32x16_t acc[4];
#pragma unroll
    for (int g = 0; g < 4; ++g) { f32x16_t a;
#pragma unroll
        for (int x = 0; x < 16; ++x) a[x] = 0.f;
        if (g <= I) {
#pragma unroll
            for (int ks = 0; ks < 4; ++ks) a = MFMA32(kfr[g][ks], qf[ks], a); }
        acc[g] = a; }
    const bf16_t* vtr = (const bf16_t*)(p.ws + WS_VT) + (size_t)12 * 1024 * 1024 + ((size_t)((b * 4 + h) * 64 + q)) * SEQ + c * 128 + hf * 8;
    bf16x8_t vfr[8][2];
#pragma unroll
    for (int s = 0; s < 8; ++s) if ((s >> 1) <= I) {
#pragma unroll
        for (int dt = 0; dt < 2; ++dt) vfr[s][dt] = *(const bf16x8_t*)(vtr + (size_t)(dt * 32) * SEQ + 16 * s); }
    __builtin_amdgcn_sched_barrier(0);
    f32x16_t o[2], o2[2];
#pragma unroll
    for (int dt = 0; dt < 2; ++dt)
#pragma unroll
        for (int x = 0; x < 16; ++x) { o[dt][x] = 0.f; o2[dt][x] = 0.f; }
#pragma unroll
    for (int dt = 0; dt < 2; ++dt)
#pragma unroll
        for (int ks = 0; ks < 4; ++ks) { const f32x4 a = pa[dt][ks], b2 = pc[dt][ks];
            u32x4 w; w.x = pk2(a[0], a[1]); w.y = pk2(a[2], a[3]); w.z = pk2(b2[0], b2[1]); w.w = pk2(b2[2], b2[3]);
            o2[dt] = MFMA32(__builtin_bit_cast(bf16x8_t, w), qf[ks], o2[dt]); }
    { int qv = q - 8 * hf; asm volatile("" : "+v"(qv));
#pragma unroll
      for (int g = 0; g < 4; ++g) if (g <= I) {
#pragma unroll
        for (int s = 0; s < 2; ++s) { float e[8];
#pragma unroll
            for (int j = 0; j < 8; ++j) { const int dd = qv + (32 * (I - g) - 16 * s - j); e[j] = dd >= 0 ? acc[g][8 * s + j] * exp2f((float)dd * lg) : 0.f; }
            u32x4 w; w.x = pk2(e[0], e[1]); w.y = pk2(e[2], e[3]); w.z = pk2(e[4], e[5]); w.w = pk2(e[6], e[7]); const bf16x8_t pb = __builtin_bit_cast(bf16x8_t, w);
#pragma unroll
            for (int dt = 0; dt < 2; ++dt) o[dt] = MFMA32(vfr[2 * g + s][dt], pb, o[dt]); }
        __builtin_amdgcn_sched_barrier(0); } }
    const float xi = exp2f((float)(i + 1) * lg);
    float s2 = 0.f;
#pragma unroll
    for (int dt = 0; dt < 2; ++dt)
#pragma unroll
        for (int x = 0; x < 16; ++x) { const float v = o[dt][x] + xi * o2[dt][x]; o[dt][x] = v; s2 += v * v; }
    s2 += __shfl_xor(s2, 32);
    const float rs = rsqrtf(s2 * (1.0f / 64.0f) + EPS);
    const bf16_t* gp = (const bf16_t*)(p.ws + WS_PROJ) + (size_t)(tok0 + i) * PP + CG + h * 64 + 4 * hf;
    bf16_t* yo = (bf16_t*)(p.ws + WS_YCAT) + (size_t)(tok0 + i) * DM + 512 + h * 64 + 4 * hf;
#pragma unroll
    for (int dt = 0; dt < 2; ++dt)
#pragma unroll
        for (int i4 = 0; i4 < 4; ++i4) { const u32x2 gw2 = *(const u32x2*)(gp + dt * 32 + 8 * i4);
            u32x2 w; w.x = pk2(o[dt][4 * i4] * rs * silu_f(lo16(gw2.x)), o[dt][4 * i4 + 1] * rs * silu_f(hi16(gw2.x))); w.y = pk2(o[dt][4 * i4 + 2] * rs * silu_f(lo16(gw2.y)), o[dt][4 * i4 + 3] * rs * silu_f(hi16(gw2.y)));
            *(u32x2*)(yo + dt * 32 + 8 * i4) = w; }
}

DI void scan_phase(const Params& p, int gt, int NT) {
    float* sst = (float*)(p.ws + WS_SST); const float* cdec = (const float*)(p.ws + WS_CDEC);
    for (int i = gt; i < NB * 4 * 8192; i += NT) { const int b = i >> 15, rem = i & 32767, h = rem >> 13, pn = rem & 8191; float run = 0.f;
#pragma unroll
        for (int c = 0; c < 32; ++c) { const size_t idx = ((size_t)((b * 32 + c) * 4 + h)) * 8192 + pn; const float st = sst[idx]; sst[idx] = run; run = cdec[(b * 32 + c) * 4 + h] * run + st; } }
    float* rst = (float*)(p.ws + WS_RST);
    for (int i = gt; i < NB * 4 * 4096; i += NT) { const int b = i >> 14, rem = i & 16383, h = rem >> 12, de = rem & 4095; float run = 0.f;
        const float gc = exp2f(128.0f * log2f(1.0f - exp2f(-5.0f - (float)h)));
#pragma unroll
        for (int c = 0; c < 32; ++c) { const size_t idx = ((size_t)((b * 32 + c) * 4 + h)) * 4096 + de; const float st = rst[idx]; rst[idx] = run; run = gc * run + st; } }
}

#define SSB ((unsigned long long*)(ws + WS_SS))
#define XB ((bf16_t*)(ws + WS_XB))
#define YC ((bf16_t*)(ws + WS_YCAT))
#define PROJ ((bf16_t*)(ws + WS_PROJ))
#define HB ((bf16_t*)(ws + WS_H))
#define PE ((bf16_t*)(ws + WS_PE))

#define CAS4 __attribute__((address_space(4)))
#define RELOAD_P() const CAS4 Params* kp_ = (const CAS4 Params*)__builtin_amdgcn_kernarg_segment_ptr(); asm volatile("" : "+s"(kp_)); const Params& p = *(const Params*)kp_; unsigned char* ws = p.ws; (void)ws
#define FRESH_LANE(v) int v; asm volatile("v_mbcnt_lo_u32_b32 %0, -1, 0\n\tv_mbcnt_hi_u32_b32 %0, -1, %0" : "=v"(v))
#define RELOAD_IDS() RELOAD_P(); FRESH_LANE(lane_); const int lane = lane_, wave = wave_s, tid = wave_s * 64 + lane_; const int gw = blk * NWV + wave, gt = blk * NTHR + tid; (void)gw; (void)gt; (void)lane
#define GEMM_TID() ({ FRESH_LANE(l_); wave_s * 64 + l_; })
#define GBAR() do { ++nbar; asm volatile("s_waitcnt vmcnt(0)" ::: "memory"); __syncthreads(); { FRESH_LANE(l_); if (wave_s == 0 && l_ == 0) { RELOAD_P(); unsigned* bar = (unsigned*)(ws + WS_BAR); \
        if (nbar == 1u) {     \
            __builtin_amdgcn_fence(__ATOMIC_RELEASE, "agent"); asm volatile("s_waitcnt vmcnt(0)" ::: "memory"); \
            __hip_atomic_fetch_add(bar + 32, 1u, __ATOMIC_RELAXED, __HIP_MEMORY_SCOPE_AGENT); \
            while (__hip_atomic_load(bar + 32, __ATOMIC_RELAXED, __HIP_MEMORY_SCOPE_AGENT) < (unsigned)G) __builtin_amdgcn_s_sleep(1); \
        } else {              \
            const unsigned rnd = nbar - 1u; \
            const unsigned old = __hip_atomic_fetch_add(bar + 64 + 64 * xcc_s, 1u, __ATOMIC_RELAXED, __HIP_MEMORY_SCOPE_AGENT); \
            if (old + 1u == rnd * nloc_s) { __builtin_amdgcn_fence(__ATOMIC_RELEASE, "agent"); asm volatile("s_waitcnt vmcnt(0)" ::: "memory"); \
                __hip_atomic_fetch_add(bar, 1u, __ATOMIC_RELAXED, __HIP_MEMORY_SCOPE_AGENT); } \
            const unsigned target = rnd * nx_s; \
            while (__hip_atomic_load(bar, __ATOMIC_RELAXED, __HIP_MEMORY_SCOPE_AGENT) < target) __builtin_amdgcn_s_sleep(1); } \
        __builtin_amdgcn_fence(__ATOMIC_ACQUIRE, "agent"); asm volatile("s_waitcnt vmcnt(0)" ::: "memory"); } } __syncthreads(); \
        if (nbar == 1u) { RELOAD_P(); const unsigned* cn = (const unsigned*)(ws + WS_BAR) + 1536; unsigned nl = 1u, nxx = 0u; \
            for (unsigned j = 0; j < 16u; ++j) { const unsigned cj = __hip_atomic_load(cn + j, __ATOMIC_RELAXED, __HIP_MEMORY_SCOPE_AGENT); if (j == xcc_s) nl = cj; nxx += cj > 0u ? 1u : 0u; } \
            nloc_s = (unsigned)__builtin_amdgcn_readfirstlane((int)nl); nx_s = (unsigned)__builtin_amdgcn_readfirstlane((int)nxx); } \
    } while (0)
#define SS_IN (SSB + (l == 0 ? 0 : 3 * M))
#define SSA (SSB + (1 + 3 * l) * M)
#define SSBB (SSB + (2 + 3 * l) * M)
#define SSC (SSB + (3 + 3 * l) * M)
#ifdef PROBE_MASK
#define TIC() do { t0_ = __builtin_amdgcn_s_memrealtime(); } while (0)
#define TOC(ph) do { if ((PROBE_MASK >> (ph)) & 1) tacc += __builtin_amdgcn_s_memrealtime() - t0_; t0_ = __builtin_amdgcn_s_memrealtime(); } while (0)
#else
#define TIC() do { } while (0)
#define TOC(ph) do { } while (0)
#endif
template <int l> DI void run_layer(LAS unsigned char* lds, const int G, const int blk, const int NGW, const int NT, const int wave_s, unsigned& nbar, unsigned long long& tacc, unsigned long long& t0_, const unsigned xcc_s, unsigned& nloc_s, unsigned& nx_s) {

        { RELOAD_P(); pg8::Gemm g{l == 0 ? XB : (const bf16_t*)p.out, (const bf16_t*)(ws + WS_WIN), M, PN, DM};        pg8::StaticOrder S; S.init(M, PN, G, blk);
          pg8::EpiScale<0> E{PROJ, PP, SS_IN};
          pg8::gemm_phase<pg8::EpiScale<0>, pg8::StaticOrder, true, true>(lds, g, S, E, GEMM_TID()); }
        GBAR(); TOC(1);
        { RELOAD_IDS(); for (int t0 = blk; t0 < 256; t0 += G) { const int t = (G == 256) ? (((t0 & 7) << 5) | (t0 >> 3)) : t0; e1_tile(p, l, t, lds, tid, wave, lane); } }
        GBAR(); TOC(2);
        { RELOAD_IDS(); for (int u = blk; u < 256; u += G) ssd_states_mfma(p, l, u >> 6, (u >> 1) & 31, u & 1, lds, tid, wave, lane); }
        TOC(13);
        { RELOAD_IDS(); for (int u = blk; u < 512; u += G) ret_states_mfma(p, u >> 7, (u >> 2) & 31, u & 3, lds, tid, wave, lane); }
        TOC(14);
        { RELOAD_IDS(); for (int u = blk; u < 256; u += G) conv_unit(p, l, u >> 6, (u & 63) * 64, lds, tid, wave, lane); }
        TOC(15);
        { RELOAD_IDS(); for (int ub0 = blk; ub0 < 256; ub0 += G) { const int ub = (G == 256) ? (((ub0 & 7) << 5) | (ub0 >> 3)) : ub0; const int bh = ub >> 4, seg = ub & 15;
            for (int pat = 0; pat < 3; ++pat) {
                int r, i0;
                if (pat == 0) { r = 0; i0 = seg * 256 + wave * 32; }
                else if (pat == 1) { r = wave >> 1; i0 = seg * 64 + (wave & 1) * 32; }
                else { r = (seg & 1) * 8 + wave; i0 = (seg >> 1) * 32; }
                attn_tile32(p, bh >> 2, bh & 3, pat, r, i0, lane); } } }
        GBAR(); TOC(3);
        { RELOAD_IDS(); scan_phase(p, gt, NT); attn_combine(p, gt, NT); }
        GBAR(); TOC(4);
        { RELOAD_IDS(); for (int u = blk; u < 256; u += G) ssd_y_mfma(p, l, u >> 6, (u >> 1) & 31, u & 1, lds, tid, wave, lane); }
        TOC(16);
        { RELOAD_IDS(); for (int u0 = blk; u0 < 256; u0 += G) { const int u = u0 + 256 * (wave >> 2); ret_y_tile32(p, u >> 7, (u >> 2) & 31, u & 3, wave & 3, lane); } }
        GBAR(); TOC(5);
        { RELOAD_P(); pg8::Gemm g{YC, (const bf16_t*)(ws + WS_WOUT), M, DM, DM}; pg8::StaticOrder S; S.init(M, DM, G, blk);
          pg8::EpiRes<0, l == 0 ? 0 : 1, 0, 1> E{p.in[0], (const bf16_t*)p.out, nullptr, XB, SSA, DM, nullptr, nullptr};
          pg8::gemm_phase<pg8::EpiRes<0, l == 0 ? 0 : 1, 0, 1>, pg8::StaticOrder, true, true>(lds, g, S, E, GEMM_TID()); }
        GBAR(); TOC(6);
        { RELOAD_P(); pg8::Gemm g{XB, (const bf16_t*)(ws + WS_WUP), M, FF, DM}; pg8::StaticOrder S; S.init(M, FF, G, blk);
          pg8::EpiScale<1> E{HB, FF, SSA};
          pg8::gemm_phase<pg8::EpiScale<1>, pg8::StaticOrder, true, true>(lds, g, S, E, GEMM_TID()); }
        GBAR(); TOC(7);
        { RELOAD_P(); pg8::Gemm g{HB, (const bf16_t*)(ws + WS_WDOWN), M, DM, FF}; pg8::StaticOrder S; S.init(M, DM, G, blk);
          pg8::EpiRes<0, 1, 0, 1> E{nullptr, XB, nullptr, XB, SSBB, DM, nullptr, nullptr};
          pg8::gemm_phase<pg8::EpiRes<0, 1, 0, 1>, pg8::StaticOrder, true, true>(lds, g, S, E, GEMM_TID()); }
        GBAR(); TOC(8);
        if (l == 0) { RELOAD_IDS(); convert_weights(p, 1, 1, lds, blk, G, tid); __syncthreads(); }
        { RELOAD_P(); pg8::Gemm g{(const bf16_t*)(ws + (l ? WS_PB1 : WS_PB0)), (const bf16_t*)(ws + (l ? WS_WPLE1 : WS_WPLE0)), M, DM, PLE}; pg8::StaticOrder S; S.init(M, DM, G, blk);
          pg8::EpiPe E{PE, DM};
          pg8::gemm_phase<pg8::EpiPe, pg8::StaticOrder, true, true>(lds, g, S, E, GEMM_TID()); }
        { RELOAD_P(); pg8::Gemm g{XB, (const bf16_t*)(ws + (l ? WS_WGATE1 : WS_WGATE0)), M, DM, DM}; pg8::StaticOrder S; S.init(M, DM, G, blk);
          pg8::EpiRes<1, 1, l == 0 ? 0 : 1, l == 0 ? 1 : 0> E{nullptr, XB, p.out, (bf16_t*)p.out, SSC, DM, PE, SSBB};
          pg8::gemm_phase<pg8::EpiRes<1, 1, l == 0 ? 0 : 1, l == 0 ? 1 : 0>, pg8::StaticOrder, true, true>(lds, g, S, E, GEMM_TID()); }
        if (l == 0) { GBAR(); } TOC(9);
    }

__global__ void __launch_bounds__(NTHR, 2) fwd_kernel(Params p_unused) {
    extern __shared__ __attribute__((aligned(16))) unsigned char lds_raw[];
    LAS unsigned char* lds = (LAS unsigned char*)lds_raw;
    cg::grid_group grid = cg::this_grid();
    const int G = gridDim.x, blk = blockIdx.x;
    const int NGW = G * NWV, NT = G * NTHR;
    const int wave_s = __builtin_amdgcn_readfirstlane(threadIdx.x >> 6);
    unsigned nbar = 0; unsigned long long tacc = 0, t0_ = 0; (void)tacc; (void)t0_;
    const unsigned xcc_s = (unsigned)__builtin_amdgcn_s_getreg((3 << 11) | 20) & 0xFu;
    unsigned nloc_s = 1u, nx_s = 1u;
    TIC();
    { RELOAD_IDS();
    if (blk == 0) for (int i = tid; i < 2048; i += NTHR) ((unsigned*)(ws + WS_BAR))[i] = 0u;
    prologue(p, gw, NGW, lane); TOC(10);
    convert_weights(p, 0, 3, lds, blk, G, tid); TOC(11);
    convert_weights(p, 1, 2, lds, blk, G, tid); TOC(12); }
    grid.sync();
    { RELOAD_IDS(); if (tid == 0) __hip_atomic_fetch_add((unsigned*)(ws + WS_BAR) + 1536 + xcc_s, 1u, __ATOMIC_RELAXED, __HIP_MEMORY_SCOPE_AGENT); }
    TOC(0);

    run_layer<0>(lds, G, blk, NGW, NT, wave_s, nbar, tacc, t0_, xcc_s, nloc_s, nx_s);
    run_layer<1>(lds, G, blk, NGW, NT, wave_s, nbar, tacc, t0_, xcc_s, nloc_s, nx_s);
#ifdef PROBE_MASK
    { RELOAD_IDS(); if (blk == 0 && tid == 0) *(volatile float*)(ws + WS_BAR + 16384) = (float)tacc * PROBE_K; }
    GBAR();
    { RELOAD_IDS(); const float sc = 1.0f + __hip_atomic_load((float*)(ws + WS_BAR + 16384), __ATOMIC_RELAXED, __HIP_MEMORY_SCOPE_AGENT); for (int i = gt; i < M * DM; i += NT) p.out[i] *= sc; }
#endif
}

extern "C" void kernel_launch(void* const* d_in, const int* in_sizes, int n_in, void* d_out, int out_size, void* d_ws, size_t ws_size, hipStream_t stream) {
    static int grid = 0;
    if (grid == 0) {
        int dev = 0, cus = 0, per_cu = 0;
        hipGetDevice(&dev); hipDeviceGetAttribute(&cus, hipDeviceAttributeMultiprocessorCount, dev);
        if (hipFuncSetAttribute((const void*)fwd_kernel, hipFuncAttributeMaxDynamicSharedMemorySize, LDS_BYTES) != hipSuccess) { fprintf(stderr, "kernel_launch: hipFuncSetAttribute failed\n"); }
        if (hipOccupancyMaxActiveBlocksPerMultiprocessor(&per_cu, (const void*)fwd_kernel, NTHR, LDS_BYTES) != hipSuccess || per_cu < 1) { fprintf(stderr, "kernel_launch: occupancy query says %d\n", per_cu); per_cu = 1; }
        (void)hipGetLastError();
        grid = cus * (per_cu > 1 ? 1 : per_cu);
        if (n_in != 23 || ws_size < WS_END) { fprintf(stderr, "kernel_launch: unexpected n_in %d / ws %zu\n", n_in, ws_size); }
    }
    Params p{};
    for (int i = 0; i < 23; ++i) p.in[i] = (const float*)d_in[i];
    p.out = (float*)d_out; p.ws = (unsigned char*)d_ws;
    void* args[] = {&p};
    hipError_t e = hipLaunchCooperativeKernel((const void*)fwd_kernel, dim3(grid), dim3(NTHR), args, LDS_BYTES, stream);
    if (e != hipSuccess) fprintf(stderr, "cooperative launch failed: %s (grid %d)\n", hipGetErrorString(e), grid);
}
```
